# Optimizing an MI355X kernel written in HIP

```python
import math
import jax, jax.numpy as jnp
from jax import lax
import numpy as np

D_MODEL = 1024
BATCH = 2
SEQ = 8192
DEPTH = 1

CTX_LEN = 256
GRID_W = 64
MIX_W = D_MODEL
ATTN_W = MIX_W // 2
ATTN_HEAD_DIM = 64
ATTN_HEADS = ATTN_W // ATTN_HEAD_DIM
ATTN_KV_HEADS = ATTN_HEADS // 4
ATTN_GROUP = ATTN_HEADS // ATTN_KV_HEADS
ATTN_KV_W = ATTN_KV_HEADS * ATTN_HEAD_DIM
DN_W = MIX_W - ATTN_W
DN_HEAD_DIM = 128
DN_HEADS = DN_W // DN_HEAD_DIM
N_DIR = 2
CONV_K = 5
CHUNK = 64
Q_BLOCK = 128
D_FF = 4 * D_MODEL
N_MOD = 6
ROPE_THETA = 10000.0
NORM_EPS = 1e-6
IN_COLS = ATTN_W + 2 * ATTN_KV_W + 4 * DN_W + 2 * N_DIR * DN_HEADS

kernel_name = 'hybrid_attn_gdn_dit_block'


def _rms(x, w):
    xf = x.astype(jnp.float32)
    y = xf * lax.rsqrt(jnp.mean(xf * xf, axis=-1, keepdims=True) + NORM_EPS)
    return (y * w.astype(jnp.float32)).astype(x.dtype)


def _l2n(x):
    return x * lax.rsqrt(jnp.sum(x * x, axis=-1, keepdims=True) + NORM_EPS)


def _rope_axis(x, pos):
    half = x.shape[-1] // 2
    inv = ROPE_THETA ** (-jnp.arange(half, dtype=jnp.float32) / half)
    ang = pos.astype(jnp.float32)[:, None] * inv[None, :]
    cos = jnp.cos(ang)[None, :, None, :]
    sin = jnp.sin(ang)[None, :, None, :]
    x1, x2 = x[..., :half], x[..., half:]
    return jnp.concatenate([x1 * cos - x2 * sin, x2 * cos + x1 * sin], axis=-1)


def _rope_2d(x, row, col):
    xf = x.astype(jnp.float32)
    h = x.shape[-1] // 2
    y = jnp.concatenate([_rope_axis(xf[..., :h], row), _rope_axis(xf[..., h:], col)], axis=-1)
    return y.astype(x.dtype)


def _split_proj(p):
    widths = (ATTN_W, ATTN_KV_W, ATTN_KV_W, 3 * DN_W, DN_W, N_DIR * DN_HEADS, N_DIR * DN_HEADS)
    out, off = [], 0
    for wdt in widths:
        out.append(p[..., off:off + wdt])
        off += wdt
    return out


def _short_conv(x, w):
    y = lax.conv_general_dilated(
        x, w[:, None, :].astype(x.dtype), window_strides=(1,),
        padding=[(CONV_K // 2, CONV_K // 2)],
        dimension_numbers=('NWC', 'WIO', 'NWC'), feature_group_count=x.shape[-1])
    return jax.nn.silu(y)


def _gdn_gates(b_raw, a_raw, a_log, dt_bias):
    shp = b_raw.shape[:-1] + (N_DIR, DN_HEADS)
    beta = jax.nn.sigmoid(b_raw.astype(jnp.float32)).reshape(shp)
    g = -jnp.exp(a_log.astype(jnp.float32)) * jax.nn.softplus(
        a_raw.astype(jnp.float32).reshape(shp) + dt_bias.astype(jnp.float32))
    return beta, g


def _dir(a, d):
    return a[:, ::-1] if d == 1 else a


def _gdn_chunked(k, v, g, beta, s0, q=None):
    b, t, h, dk = k.shape
    n = t // CHUNK

    def chunks(a):
        a = a.reshape((b, n, CHUNK, h) + a.shape[3:])
        return jnp.moveaxis(jnp.moveaxis(a, 1, 0), 3, 2)

    kc, vc, bc = chunks(k), chunks(v), chunks(beta)
    gc = jnp.cumsum(chunks(g), axis=-1)
    idx = jnp.arange(CHUNK)
    incl = idx[:, None] >= idx[None, :]
    strict = idx[:, None] > idx[None, :]
    decay = jnp.exp(jnp.where(incl, gc[..., :, None] - gc[..., None, :], -jnp.inf))
    kb = kc * bc[..., None]
    lower = jnp.where(strict, jnp.einsum('nbhid,nbhjd->nbhij', kb, kc) * decay, 0.0)
    eye = jnp.eye(CHUNK, dtype=jnp.float32)
    t_inv = lax.linalg.triangular_solve(eye + lower, jnp.broadcast_to(eye, lower.shape),
                                        left_side=True, lower=True, unit_diagonal=True)
    u = t_inv @ (vc * bc[..., None])
    w = t_inv @ (kb * jnp.exp(gc)[..., None])
    g_last = gc[..., -1]
    k_dec = kc * jnp.exp(g_last[..., None] - gc)[..., None]
    xs = (u, w, k_dec, g_last)
    if q is not None:
        qs = chunks(q) * (dk ** -0.5)
        xs = xs + (qs * jnp.exp(gc)[..., None], jnp.einsum('nbhid,nbhjd->nbhij', qs, kc) * decay)

    def step(s, xs_i):
        u_i, w_i, kd_i, gl_i = xs_i[:4]
        v_new = u_i - jnp.einsum('bhcd,bhde->bhce', w_i, s)
        s_new = s * jnp.exp(gl_i)[..., None, None] + jnp.einsum('bhcd,bhce->bhde', kd_i, v_new)
        if q is None:
            return s_new, None
        qd_i, intra_i = xs_i[4:]
        o_i = jnp.einsum('bhcd,bhde->bhce', qd_i, s) + jnp.einsum('bhij,bhje->bhie', intra_i, v_new)
        return s_new, o_i

    s_final, o = lax.scan(step, s0, xs)
    if q is None:
        return None, s_final
    return o.transpose(1, 0, 3, 2, 4).reshape(b, t, h, v.shape[-1]), s_final


def _latent_attention(q, k_lat, v_lat, k_ctx, v_ctx):
    b, t, _, hd = q.shape
    k_all = jnp.concatenate([k_ctx, k_lat], axis=1)
    v_all = jnp.concatenate([v_ctx, v_lat], axis=1)
    n_blk = t // Q_BLOCK
    qb = q.reshape(b, n_blk, Q_BLOCK, ATTN_KV_HEADS, ATTN_GROUP, hd).transpose(1, 0, 2, 3, 4, 5)
    scale = hd ** -0.5

    def one_block(q_blk):
        s = jnp.einsum('bqkgd,bskd->bkgqs', q_blk, k_all).astype(jnp.float32) * scale
        p = jax.nn.softmax(s, axis=-1).astype(v_all.dtype)
        return jnp.einsum('bkgqs,bskd->bqkgd', p, v_all)

    o = lax.map(one_block, qb)
    return o.transpose(1, 0, 2, 3, 4, 5).reshape(b, t, ATTN_W)


def setup_inputs(seed: int = 0) -> dict:
    key = jax.random.key(seed)
    ks = jax.random.split(key, 20)
    f32 = jnp.float32

    def nrm(k, shape, scale):
        return jax.random.normal(k, shape, f32) * scale

    dt = jnp.exp(jax.random.uniform(ks[12], (DEPTH, N_DIR, DN_HEADS), f32,
                                    math.log(1e-3), math.log(1e-1)))
    return {
        'x': nrm(ks[0], (BATCH, SEQ, D_MODEL), 1.0),
        'c': nrm(ks[1], (BATCH, D_MODEL), 1.0),
        'ctx': nrm(ks[2], (BATCH, CTX_LEN, D_MODEL), 1.0),
        'c_ctx': nrm(ks[3], (D_MODEL,), 1.0),
        'w_mod': nrm(ks[4], (DEPTH, D_MODEL, N_MOD * D_MODEL), 0.5 * D_MODEL ** -0.5),
        'b_mod': nrm(ks[5], (DEPTH, N_MOD * D_MODEL), 0.01),
        'norm1_w': 1.0 + nrm(ks[6], (DEPTH, D_MODEL), 0.02),
        'w_in': nrm(ks[7], (DEPTH, D_MODEL, IN_COLS), D_MODEL ** -0.5),
        'q_norm_w': 1.0 + nrm(ks[8], (DEPTH, ATTN_HEAD_DIM), 0.02),
        'k_norm_w': 1.0 + nrm(ks[9], (DEPTH, ATTN_HEAD_DIM), 0.02),
        'conv_w': nrm(ks[10], (DEPTH, CONV_K, 3 * DN_W), CONV_K ** -0.5),
        'a_log': jnp.log(jax.random.uniform(ks[11], (DEPTH, N_DIR, DN_HEADS), f32, 1.0, 16.0)),
        'dt_bias': dt + jnp.log(-jnp.expm1(-dt)),
        'dn_norm_w': 1.0 + nrm(ks[13], (DEPTH, DN_HEAD_DIM), 0.02),
        'w_out': nrm(ks[14], (DEPTH, MIX_W, D_MODEL), MIX_W ** -0.5),
        'norm2_w': 1.0 + nrm(ks[15], (DEPTH, D_MODEL), 0.02),
        'w_mlp1': nrm(ks[16], (DEPTH, D_MODEL, D_FF), D_MODEL ** -0.5),
        'w_mlp2': nrm(ks[17], (DEPTH, D_FF, D_MODEL), D_FF ** -0.5),
    }


def reference(x, c, ctx, c_ctx, w_mod, b_mod, norm1_w, w_in, q_norm_w, k_norm_w, conv_w,
              a_log, dt_bias, dn_norm_w, w_out, norm2_w, w_mlp1, w_mlp2):
    f32 = jnp.float32
    b, t, _ = x.shape
    n_ctx = ctx.shape[1]
    rows = t // GRID_W
    row = jnp.repeat(jnp.arange(rows, dtype=jnp.int32), GRID_W, total_repeat_length=rows * GRID_W)
    col = jnp.arange(t, dtype=jnp.int32) % GRID_W
    silu_c = jax.nn.silu(c)
    silu_cc = jax.nn.silu(c_ctx)
    for l in range(DEPTH):
        mod = (silu_c @ w_mod[l] + b_mod[l]).reshape(b, N_MOD, D_MODEL)[:, :, None, :]
        sh1, sc1, g1, sh2, sc2, g2 = (mod[:, i] for i in range(N_MOD))
        mod_ctx = (silu_cc @ w_mod[l] + b_mod[l]).reshape(N_MOD, D_MODEL)

        h = _rms(x, norm1_w[l]) * (1.0 + sc1) + sh1
        hc = _rms(ctx, norm1_w[l]) * (1.0 + mod_ctx[1]) + mod_ctx[0]
        aq, ak, av, dqkv, dz, db, da = _split_proj(h @ w_in[l])
        _, cak, cav, cdqkv, _, cdb, cda = _split_proj(hc @ w_in[l])

        q_a = _rope_2d(_rms(aq.reshape(b, t, ATTN_HEADS, ATTN_HEAD_DIM), q_norm_w[l]), row, col)
        k_a = _rope_2d(_rms(ak.reshape(b, t, ATTN_KV_HEADS, ATTN_HEAD_DIM), k_norm_w[l]), row, col)
        v_a = av.reshape(b, t, ATTN_KV_HEADS, ATTN_HEAD_DIM)
        k_c = _rms(cak.reshape(b, n_ctx, ATTN_KV_HEADS, ATTN_HEAD_DIM), k_norm_w[l])
        v_c = cav.reshape(b, n_ctx, ATTN_KV_HEADS, ATTN_HEAD_DIM)
        o_attn = _latent_attention(q_a, k_a, v_a, k_c, v_c)

        qkv = _short_conv(dqkv, conv_w[l]).astype(f32).reshape(b, t, 3, DN_HEADS, DN_HEAD_DIM)
        dn_q, dn_k, dn_v = _l2n(qkv[:, :, 0]), _l2n(qkv[:, :, 1]), qkv[:, :, 2]
        kv_c = _short_conv(cdqkv[..., DN_W:], conv_w[l][:, DN_W:]).astype(f32)
        kv_c = kv_c.reshape(b, n_ctx, 2, DN_HEADS, DN_HEAD_DIM)
        ck, cv = _l2n(kv_c[:, :, 0]), kv_c[:, :, 1]
        beta, gdec = _gdn_gates(db, da, a_log[l], dt_bias[l])
        cbeta, cgdec = _gdn_gates(cdb, cda, a_log[l], dt_bias[l])
        s_zero = jnp.zeros((b, DN_HEADS, DN_HEAD_DIM, DN_HEAD_DIM), f32)
        o_dn = jnp.zeros((b, t, DN_HEADS, DN_HEAD_DIM), f32)
        for d in range(N_DIR):
            _, s_ctx = _gdn_chunked(_dir(ck, d), _dir(cv, d), _dir(cgdec[:, :, d], d),
                                    _dir(cbeta[:, :, d], d), s_zero)
            o_d, _ = _gdn_chunked(_dir(dn_k, d), _dir(dn_v, d), _dir(gdec[:, :, d], d),
                                  _dir(beta[:, :, d], d), s_ctx, q=_dir(dn_q, d))
            o_dn = o_dn + _dir(o_d, d)
        z = dz.astype(f32).reshape(b, t, DN_HEADS, DN_HEAD_DIM)
        o_dn = (_rms(o_dn, dn_norm_w[l]) * jax.nn.silu(z)).reshape(b, t, DN_W).astype(x.dtype)

        mixed = jnp.concatenate([o_attn, o_dn], axis=-1) @ w_out[l]
        x = x + g1 * mixed

        h2 = _rms(x, norm2_w[l]) * (1.0 + sc2) + sh2
        x = x + g2 * (jnp.square(jax.nn.relu(h2 @ w_mlp1[l])) @ w_mlp2[l])
    return x
```

```cpp
#include <hip/hip_runtime.h>
#include <hip/hip_cooperative_groups.h>
#include <stdint.h>
#include <cstdio>
namespace cg = cooperative_groups;

#ifndef ONE_LAUNCH
#define ONE_LAUNCH 1
#endif

typedef unsigned short u16;
typedef __bf16 bf2_t __attribute__((ext_vector_type(2)));
typedef float f2_t __attribute__((ext_vector_type(2)));
typedef short bf16x8 __attribute__((ext_vector_type(8)));
typedef float f32x4 __attribute__((ext_vector_type(4)));
typedef float f32x16 __attribute__((ext_vector_type(16)));
typedef unsigned u32x2 __attribute__((ext_vector_type(2)));
typedef unsigned u32x4 __attribute__((ext_vector_type(4)));

#define DI __device__ __forceinline__
DI unsigned pk2(float lo, float hi) { f2_t v = {lo, hi}; return __builtin_bit_cast(unsigned, __builtin_convertvector(v, bf2_t)); }
DI u16 f2bf(float x) { return (u16)(pk2(x, 0.f) & 0xffffu); }
DI float bf2f(u16 v) { return __uint_as_float(((unsigned)v) << 16); }
DI float bflo(unsigned v) { return __uint_as_float(v << 16); }
DI float bfhi(unsigned v) { return __uint_as_float(v & 0xffff0000u); }
DI bf16x8 mk8(unsigned a, unsigned b, unsigned c, unsigned d) { u32x4 v = {a, b, c, d}; return __builtin_bit_cast(bf16x8, v); }
DI bf16x8 mk8(u32x2 lo, u32x2 hi) { u32x4 v = {lo.x, lo.y, hi.x, hi.y}; return __builtin_bit_cast(bf16x8, v); }
#define MFMA16(a, b, c) __builtin_amdgcn_mfma_f32_16x16x32_bf16((a), (b), (c), 0, 0, 0)
#define MFMA32(a, b, c) __builtin_amdgcn_mfma_f32_32x32x16_bf16((a), (b), (c), 0, 0, 0)

constexpr int DM = 1024, NB = 2, SEQ = 8192, NLAT = NB * SEQ, CTXL = 256, NCTX = NB * CTXL, NROW = NLAT + NCTX;
constexpr int INC = 2832, INP = 3072, DFF = 4096, SKV = CTXL + SEQ;
constexpr int NCK = 132;
constexpr int NCU = NB * NCK * 4;
constexpr float EPS = 1e-6f;
constexpr float QSCALE = 0.125f * 1.4426950408889634f;

constexpr size_t OFF_WIN = 0;
constexpr size_t OFF_MOD = OFF_WIN + (size_t)INP * DM * 2;
constexpr size_t OFF_ROPE = OFF_MOD + 3 * 6144 * 4;
constexpr size_t OFF_MISC = OFF_ROPE + 128 * 16 * 8;
constexpr size_t OFF_H = OFF_MISC + 256;
constexpr size_t OFF_WOUT = OFF_H;
constexpr size_t OFF_WM1 = OFF_WOUT + (size_t)DM * DM * 2;
constexpr size_t OFF_WM2 = OFF_WM1 + (size_t)DFF * DM * 2;
constexpr size_t OFF_DQKV = OFF_H + (size_t)NROW * DM * 2;
constexpr size_t OFF_O01 = OFF_DQKV;
constexpr size_t OFF_H2 = OFF_DQKV;
constexpr size_t OFF_MIX = OFF_DQKV + (size_t)NROW * 1536 * 2;
constexpr size_t OFF_HID = OFF_MIX;
constexpr size_t OFF_K = OFF_MIX + (size_t)NLAT * DM * 2;
constexpr size_t OFF_VT = OFF_K + (size_t)NB * 2 * SKV * 64 * 2;
constexpr size_t OFF_GATE = OFF_VT + (size_t)NB * 2 * SKV * 64 * 2;
constexpr size_t OFF_QN = OFF_GATE + (size_t)NROW * 16 * 4;
constexpr size_t OFF_KNT = OFF_QN + (size_t)NCU * 8192 * 2;
constexpr size_t OFF_WNEG = OFF_KNT + (size_t)NCU * 8192 * 2;
constexpr size_t OFF_UT = OFF_WNEG + (size_t)2 * NCU * 8192 * 2;
constexpr size_t OFF_INTRA = OFF_UT + (size_t)2 * NCU * 8192 * 2;
constexpr size_t OFF_SCAL = OFF_INTRA + (size_t)2 * NCU * 4096 * 2;
constexpr size_t WS_END = OFF_SCAL + (size_t)2 * NCU * 192 * 4;
static_assert(OFF_HID + (size_t)NLAT * DFF * 2 <= WS_END, "hid overlay");
static_assert(WS_END + 3 * 16384 + 4 * 16384 * 8 * 4 <= (size_t)256 * 1024 * 1024, "ws budget");

constexpr int LDS_BYTES = 2 * 73728 + 16;
constexpr size_t OFF_BAR = WS_END;
constexpr size_t OFF_CUCNT = OFF_BAR + 16384;
constexpr size_t OFF_DONE = OFF_CUCNT + 16384;
constexpr size_t ZERO_BYTES = 16384 + 16384 + 256;
constexpr size_t OFF_LP = OFF_DONE + 256;
constexpr size_t WS_NEED = OFF_LP + (size_t)4 * NLAT * 8 * 4;


struct Params {
    const float *x, *c, *ctx, *c_ctx, *w_mod, *b_mod, *norm1_w, *w_in, *q_norm_w, *k_norm_w, *conv_w, *a_log, *dt_bias, *dn_norm_w, *w_out, *norm2_w, *w_mlp1, *w_mlp2;
    float* out; unsigned char* ws; int ph_lo, ph_hi;
};

DI void wconv_tile(const float* __restrict__ W, int K, int N, int Npad, u16* __restrict__ Wt, int tile, float* st) {
    const int ntn = Npad / 64, kt = tile / ntn, nt = tile % ntn, k0 = kt * 64, n0 = nt * 64;
    const int tid = (threadIdx.x & 255), c = tid & 63, r4 = tid >> 6;
    __syncthreads();
#pragma unroll 4
    for (int i = 0; i < 16; ++i) { const int k = i * 4 + r4, n = n0 + c; st[k * 65 + c] = (n < N) ? W[(size_t)(k0 + k) * N + n] : 0.f; }
    __syncthreads();
#pragma unroll
    for (int i = 0; i < 2; ++i) {
        const int idx = tid + 256 * i, n = idx >> 3, ch = idx & 7;
        float e[8];
#pragma unroll
        for (int j = 0; j < 8; ++j) e[j] = st[(8 * ch + j) * 65 + n];
        const u32x4 w = {pk2(e[0], e[1]), pk2(e[2], e[3]), pk2(e[4], e[5]), pk2(e[6], e[7])};
        *(u32x4*)(Wt + (size_t)(n0 + n) * K + k0 + 8 * ch) = w;
    }
}

template <class Epi>
DI void gemm_tile(const u16* __restrict__ A, int lda, const u16* __restrict__ Bt, int ldb, int K, int m0, int n0, unsigned char* lds, Epi&& epi) {
    const int tid = (threadIdx.x & 255), lane = tid & 63, wid = tid >> 6, wr = wid >> 1, wc = wid & 1, l15 = lane & 15, quad = lane >> 4;
    u16* As = (u16*)lds; u16* Bs = (u16*)(lds + 18432);
    f32x4 acc[4][4];
#pragma unroll
    for (int m = 0; m < 4; ++m)
#pragma unroll
        for (int n = 0; n < 4; ++n) acc[m][n] = (f32x4){0.f, 0.f, 0.f, 0.f};
    u32x4 ra[4], rb[4];
    const int lrow = tid >> 3, lcc = tid & 7;
    const u16* Ap = A + (size_t)(m0 + lrow) * lda + lcc * 8;
    const u16* Bp = Bt + (size_t)(n0 + lrow) * ldb + lcc * 8;
    const int nk = K / 64;
#pragma unroll
    for (int i = 0; i < 4; ++i) { ra[i] = *(const u32x4*)(Ap + (size_t)(32 * i) * lda); rb[i] = *(const u32x4*)(Bp + (size_t)(32 * i) * ldb); }
    __syncthreads();
#pragma unroll
    for (int i = 0; i < 4; ++i) { *(u32x4*)(As + (lrow + 32 * i) * 72 + lcc * 8) = ra[i]; *(u32x4*)(Bs + (lrow + 32 * i) * 72 + lcc * 8) = rb[i]; }
#pragma unroll
    for (int i = 0; i < 4; ++i) { ra[i] = *(const u32x4*)(Ap + (size_t)(32 * i) * lda + 64); rb[i] = *(const u32x4*)(Bp + (size_t)(32 * i) * ldb + 64); }
    __syncthreads();
    for (int kt = 0; kt < nk; ++kt) {
        const u16* Ac = As + (kt & 1) * 18432; const u16* Bc = Bs + (kt & 1) * 18432;
        if (kt + 1 < nk) {
            u16* An = As + ((kt + 1) & 1) * 18432; u16* Bn = Bs + ((kt + 1) & 1) * 18432;
#pragma unroll
            for (int i = 0; i < 4; ++i) { *(u32x4*)(An + (lrow + 32 * i) * 72 + lcc * 8) = ra[i]; *(u32x4*)(Bn + (lrow + 32 * i) * 72 + lcc * 8) = rb[i]; }
        }
        if (kt + 2 < nk) {
#pragma unroll
            for (int i = 0; i < 4; ++i) { ra[i] = *(const u32x4*)(Ap + (size_t)(32 * i) * lda + (kt + 2) * 64); rb[i] = *(const u32x4*)(Bp + (size_t)(32 * i) * ldb + (kt + 2) * 64); }
        }
#pragma unroll
        for (int ks = 0; ks < 2; ++ks) {
            bf16x8 af[4], bfr[4];
#pragma unroll
            for (int m = 0; m < 4; ++m) af[m] = *(const bf16x8*)(Ac + (64 * wr + 16 * m + l15) * 72 + 32 * ks + 8 * quad);
#pragma unroll
            for (int n = 0; n < 4; ++n) bfr[n] = *(const bf16x8*)(Bc + (64 * wc + 16 * n + l15) * 72 + 32 * ks + 8 * quad);
#pragma unroll
            for (int m = 0; m < 4; ++m)
#pragma unroll
                for (int n = 0; n < 4; ++n) acc[m][n] = MFMA16(bfr[n], af[m], acc[m][n]);
        }
        __syncthreads();
    }
    epi(acc, m0 + 64 * wr, n0 + 64 * wc, l15, quad);
}

DI float silu_f(float v) { return v / (1.f + __expf(-v)); }
DI int permpos(int c) { const int k = c & 31; return (c & ~31) | (8 * ((k & 15) >> 2) + 4 * (k >> 4) + (k & 3)); }
DI float wave_max(float v) {
#pragma unroll
    for (int o = 32; o > 0; o >>= 1) v = fmaxf(v, __shfl_xor(v, o));
    return v;
}
DI float wave_sum(float v) {
#pragma unroll
    for (int o = 32; o > 0; o >>= 1) v += __shfl_xor(v, o);
    return v;
}

template <class SrcF>
DI void norm_rows(SrcF srcf, int nrows, int row0, int rstride, const float* __restrict__ nw, const float* __restrict__ MOD, int shift_idx, int scale_idx, u16* __restrict__ dst, int lane) {
    f32x4 w[4], sh[4], sc[4]; int cur = -1;
    f32x4 v[4], nx[4];
    int r = row0;
    if (r < nrows) {
        const float* src = srcf(r);
#pragma unroll
        for (int i = 0; i < 4; ++i) nx[i] = *(const f32x4*)(src + 8 * lane + 512 * (i >> 1) + 4 * (i & 1));
    }
    for (; r < nrows; r += rstride) {
#pragma unroll
        for (int i = 0; i < 4; ++i) v[i] = nx[i];
        if (r + rstride < nrows) {
            const float* src = srcf(r + rstride);
#pragma unroll
            for (int i = 0; i < 4; ++i) nx[i] = *(const f32x4*)(src + 8 * lane + 512 * (i >> 1) + 4 * (i & 1));
        }
        const int which = r < NLAT ? (r >> 13) : 2;
        if (which != cur) {
            cur = which;
#pragma unroll
            for (int i = 0; i < 4; ++i) {
                const int c = 8 * lane + 512 * (i >> 1) + 4 * (i & 1);
                w[i] = *(const f32x4*)(nw + c); sh[i] = *(const f32x4*)(MOD + which * 6144 + shift_idx * 1024 + c); sc[i] = *(const f32x4*)(MOD + which * 6144 + scale_idx * 1024 + c);
                w[i] = w[i] * (sc[i] + 1.f);
            }
        }
        float ss = 0.f;
#pragma unroll
        for (int i = 0; i < 4; ++i) ss += v[i][0] * v[i][0] + v[i][1] * v[i][1] + v[i][2] * v[i][2] + v[i][3] * v[i][3];
        ss = wave_sum(ss);
        const float rinv = rsqrtf(ss * (1.f / 1024.f) + EPS);
#pragma unroll
        for (int i = 0; i < 2; ++i) {
            const f32x4 ya = v[2 * i] * rinv * w[2 * i] + sh[2 * i], yb = v[2 * i + 1] * rinv * w[2 * i + 1] + sh[2 * i + 1];
            u32x4 o = {pk2(ya[0], ya[1]), pk2(ya[2], ya[3]), pk2(yb[0], yb[1]), pk2(yb[2], yb[3])};
            *(u32x4*)(dst + (size_t)r * DM + 8 * lane + 512 * i) = o;
        }
    }
}

DI void gdn_prep_unit(const Params& p, int unit, unsigned char* lds) {
    int tid_in = (threadIdx.x & 255); asm volatile("" : "+v"(tid_in));
    const int tid = tid_in, lane = tid & 63, wid = tid >> 6, l15 = lane & 15, quad = lane >> 4;
    const int h = unit & 3, bc = unit >> 2, b = bc / NCK, ck = bc % NCK;
    const bool isctx = ck < 4;
    const int seqlen = isctx ? CTXL : SEQ;
    const int c0 = isctx ? ck * 64 : (ck - 4) * 64;
    const int rowbase = isctx ? (NLAT + b * CTXL) : b * SEQ;
    unsigned char* ws = p.ws;
    const u16* DQ = (const u16*)(ws + OFF_DQKV);
    const float* GT = (const float*)(ws + OFF_GATE);
    u16* Qs = (u16*)lds; u16* Ks = (u16*)(lds + 17408); float* stage = (float*)(lds + 34816);
    float* gs = (float*)(lds + 67840); float* gcs = (float*)(lds + 71936); float* rbs = (float*)(lds + 72448); float* rbe = (float*)(lds + 72960); float* rn = (float*)(lds + 73472);
    u16* QNg = (u16*)(ws + OFF_QN) + (size_t)unit * 8192;
    u16* KNTg = (u16*)(ws + OFF_KNT) + (size_t)unit * 8192;
    __syncthreads();
    {
        const int t = tid >> 2, q4 = tid & 3;
        *(f32x4*)(gs + t * 16 + q4 * 4) = *(const f32x4*)(GT + (size_t)(rowbase + c0 + t) * 16 + q4 * 4);
    }
    const int cch = tid & 127, th = tid >> 7;
    float* part = rbs;
    u32x4 rawreg[5];
    auto raw_fetch = [&](int wh) {
#pragma unroll
        for (int i = 0; i < 5; ++i) {
            const int idx = tid + 256 * i; const int row = idx >> 4, cc = idx & 15, s = c0 - 2 + row;
            u32x4 v = {0u, 0u, 0u, 0u};
            if (idx < 68 * 16 && s >= 0 && s < seqlen) v = *(const u32x4*)(DQ + (size_t)(rowbase + s) * 1536 + wh * 512 + h * 128 + cc * 8);
            rawreg[i] = v;
        }
    };
    raw_fetch(2);
#pragma unroll 1
    for (int wi = 0; wi < 3; ++wi) {
        const int which = wi == 0 ? 2 : wi - 1;
        if (isctx && wi == 1) continue;
        u16* raw = (wi == 0) ? Qs : Ks;
        __syncthreads();
#pragma unroll
        for (int i = 0; i < 5; ++i) {
            const int idx = tid + 256 * i;
            if (idx < 68 * 16) { const int row = idx >> 4, cc = idx & 15; *(u32x4*)(raw + row * 128 + cc * 8) = rawreg[i]; }
        }
        if (wi < 2) raw_fetch((isctx || wi == 1) ? 1 : 0);
        const int col = which * 512 + h * 128 + cch;
        const float w0 = p.conv_w[0 * 1536 + col], w1 = p.conv_w[1 * 1536 + col], w2 = p.conv_w[2 * 1536 + col], w3 = p.conv_w[3 * 1536 + col], w4 = p.conv_w[4 * 1536 + col];
        __syncthreads();
        float y[32];
        {
            const u16* rp = raw + (32 * th) * 128 + cch;
            float xa = bf2f(rp[0]), xb = bf2f(rp[128]), xc = bf2f(rp[256]), xd = bf2f(rp[384]);
#pragma unroll
            for (int i = 0; i < 32; ++i) {
                const float xe = bf2f(rp[(i + 4) * 128]);
                y[i] = silu_f(w0 * xa + w1 * xb + w2 * xc + w3 * xd + w4 * xe);
                xa = xb; xb = xc; xc = xd; xd = xe;
            }
        }
        if (which == 2) {
#pragma unroll
            for (int i = 0; i < 32; ++i) stage[(32 * th + i) * 129 + cch] = y[i];
        } else {
            float mine = 0.f;
#pragma unroll
            for (int i = 0; i < 32; ++i) { const float ssum = wave_sum(y[i] * y[i]); if (lane == i) mine = ssum; }
            if (lane < 32) part[wid * 32 + lane] = mine;
            __syncthreads();
            if (which == 0) {
#pragma unroll
                for (int i = 0; i < 32; ++i) {
                    const int t = 32 * th + i; const float rinv = rsqrtf(part[(2 * th) * 32 + i] + part[(2 * th + 1) * 32 + i] + EPS);
                    const u16 v = f2bf(y[i] * rinv); Qs[t * 136 + cch] = v; QNg[t * 128 + permpos(cch)] = v;
                }
            } else {
                unsigned pkd[16];
#pragma unroll
                for (int i = 0; i < 16; ++i) {
                    const int t = 32 * th + 2 * i;
                    const float r0 = rsqrtf(part[(2 * th) * 32 + 2 * i] + part[(2 * th + 1) * 32 + 2 * i] + EPS), r1 = rsqrtf(part[(2 * th) * 32 + 2 * i + 1] + part[(2 * th + 1) * 32 + 2 * i + 1] + EPS);
                    const unsigned v = pk2(y[2 * i] * r0, y[2 * i + 1] * r1); pkd[i] = v;
                    Ks[t * 136 + cch] = (u16)(v & 0xffffu); Ks[(t + 1) * 136 + cch] = (u16)(v >> 16);
                }
#pragma unroll
                for (int i = 0; i < 4; ++i) { u32x4 v = {pkd[2 * i], pkd[2 * i + 1], pkd[8 + 2 * i], pkd[8 + 2 * i + 1]}; *(u32x4*)(KNTg + cch * 64 + 32 * th + 8 * i) = v; }
            }
        }
    }
    __syncthreads();
    int unit_l = unit, tid_l = tid_in;
    asm volatile("" : "+s"(unit_l)); asm volatile("" : "+v"(tid_l));
    {
    const int unit = unit_l, tid = tid_l, lane = tid & 63, wid = tid >> 6, l15 = lane & 15, quad = lane >> 4;
    if (tid < 128) {
        const int d = tid >> 6, t = tid & 63; float s = 0.f;
        if (d == 0) { for (int u = 0; u <= t; ++u) s += gs[u * 16 + 8 + h]; }
        else        { for (int u = t; u < 64; ++u) s += gs[u * 16 + 12 + h]; }
        gcs[d * 64 + t] = s;
    }
    __syncthreads();
    if (tid < 128) {
        const int d = tid >> 6, t = tid & 63;
        const float gc = gcs[d * 64 + t], gl = gcs[d * 64 + (d ? 0 : 63)], be = gs[t * 16 + d * 4 + h];
        rbs[d * 64 + t] = be; rbe[d * 64 + t] = be * __expf(gc);
        float* SC = (float*)(ws + OFF_SCAL) + ((size_t)d * NCU + unit) * 192;
        SC[t] = __expf(gc) * 0.08838834764831845f; SC[64 + t] = __expf(gl - gc);
        if (t == 0) SC[128] = __expf(gl);
    }
    if (!isctx) {
        f32x4 QK[4];
#pragma unroll
        for (int n = 0; n < 4; ++n) QK[n] = (f32x4){0.f, 0.f, 0.f, 0.f};
#pragma unroll
        for (int ks = 0; ks < 4; ++ks) {
            const bf16x8 aq = *(const bf16x8*)(Qs + (16 * wid + l15) * 136 + 32 * ks + 8 * quad);
#pragma unroll
            for (int n = 0; n < 4; ++n) {
                const bf16x8 bb = *(const bf16x8*)(Ks + (16 * n + l15) * 136 + 32 * ks + 8 * quad);
                QK[n] = MFMA16(aq, bb, QK[n]);
            }
        }
#pragma unroll
        for (int d = 0; d < 2; ++d) {
            u16* INg = (u16*)(ws + OFF_INTRA) + ((size_t)d * NCU + unit) * 4096;
#pragma unroll
            for (int n = 0; n < 4; ++n)
#pragma unroll
                for (int r = 0; r < 4; ++r) {
                    const int i = 16 * wid + 4 * quad + r, j = 16 * n + l15;
                    const bool keep = d ? (j >= i) : (j <= i);
                    const float iv = keep ? QK[n][r] * 0.08838834764831845f * __expf(gcs[d * 64 + i] - gcs[d * 64 + j]) : 0.f;
                    INg[i * 64 + permpos(j)] = f2bf(iv);
                }
        }
    }
    __syncthreads();
    {
        f32x4 G[4];
#pragma unroll
        for (int n = 0; n < 4; ++n) G[n] = (f32x4){0.f, 0.f, 0.f, 0.f};
#pragma unroll
        for (int ks = 0; ks < 4; ++ks) {
            const bf16x8 ak = *(const bf16x8*)(Ks + (16 * wid + l15) * 136 + 32 * ks + 8 * quad);
#pragma unroll
            for (int n = 0; n < 4; ++n) {
                const bf16x8 bb = *(const bf16x8*)(Ks + (16 * n + l15) * 136 + 32 * ks + 8 * quad);
                G[n] = MFMA16(ak, bb, G[n]);
            }
        }
        const int dd = __builtin_amdgcn_readfirstlane(tid >> 7), cc = tid & 127;
        float xwp[64];
#pragma unroll
        for (int ip = 0; ip < 64; ++ip) xwp[ip] = 0.f;
        if (dd == 0) {
#pragma unroll
            for (int ip = 0; ip < 64; ++ip) xwp[ip] = bf2f(Ks[ip * 136 + cc]) * rbe[ip];
        } else {
#pragma unroll
            for (int ip = 0; ip < 64; ++ip) xwp[ip] = bf2f(Ks[(63 - ip) * 136 + cc]) * rbe[64 + 63 - ip];
        }
        asm volatile("" ::: "memory");
        __syncthreads();
        float* Ls0 = (float*)lds; float* Ls1 = (float*)(lds + 17408);
#pragma unroll
        for (int d = 0; d < 2; ++d)
#pragma unroll
            for (int n = 0; n < 4; ++n)
#pragma unroll
                for (int r = 0; r < 4; ++r) {
                    const int i = 16 * wid + 4 * quad + r, j = 16 * n + l15;
                    const int ip = d ? 63 - i : i, jp = d ? 63 - j : j;
                    if (jp < ip) (d ? Ls1 : Ls0)[ip * 64 + jp] = rbs[d * 64 + i] * G[n][r] * __expf(gcs[d * 64 + i] - gcs[d * 64 + j]);
                }
        __syncthreads();
        const float* Lsel = dd ? Ls1 : Ls0;
        f2_t x2[64];
#pragma unroll
        for (int ip = 0; ip < 64; ++ip) x2[ip] = (f2_t){0.f, xwp[ip]};
        if (dd == 0) {
#pragma unroll
            for (int ip = 0; ip < 64; ++ip) x2[ip].x = stage[ip * 129 + cc] * rbs[ip];
        } else {
#pragma unroll
            for (int ip = 0; ip < 64; ++ip) x2[ip].x = stage[(63 - ip) * 129 + cc] * rbs[64 + 63 - ip];
        }
        asm volatile("" ::: "memory");
#pragma unroll
        for (int ip = 0; ip < 64; ++ip) {
            f2_t a2 = x2[ip];
#pragma unroll
            for (int jp = 0; jp < ip; ++jp) { const float l = Lsel[ip * 64 + jp]; a2 -= x2[jp] * l; if ((jp & 7) == 7) asm volatile("" ::: "memory"); }
            x2[ip] = a2;
            asm volatile("" ::: "memory");
        }
        {
            int unit_o = unit, cc_o = cc; asm volatile("" : "+s"(unit_o)); asm volatile("" : "+v"(cc_o));
            u16* WNg = (u16*)(ws + OFF_WNEG) + ((size_t)dd * NCU + unit_o) * 8192 + permpos(cc_o);
#pragma unroll
            for (int ip = 0; ip < 1; ++ip) {}
            if (dd == 0) {
#pragma unroll
                for (int ip = 0; ip < 64; ++ip) { WNg[ip * 128] = f2bf(-x2[ip].y); if ((ip & 7) == 7) asm volatile("" ::: "memory"); }
            } else {
#pragma unroll
                for (int ip = 0; ip < 64; ++ip) { WNg[(63 - ip) * 128] = f2bf(-x2[ip].y); if ((ip & 7) == 7) asm volatile("" ::: "memory"); }
            }
            asm volatile("" ::: "memory");
            u16* UTg = (u16*)(ws + OFF_UT) + ((size_t)dd * NCU + unit_o) * 8192 + cc_o * 64;
            if (dd == 0) {
#pragma unroll
                for (int i = 0; i < 8; ++i) { u32x4 v = {pk2(x2[8 * i].x, x2[8 * i + 1].x), pk2(x2[8 * i + 2].x, x2[8 * i + 3].x), pk2(x2[8 * i + 4].x, x2[8 * i + 5].x), pk2(x2[8 * i + 6].x, x2[8 * i + 7].x)}; *(u32x4*)(UTg + 8 * i) = v; }
            } else {
#pragma unroll
                for (int i = 0; i < 8; ++i) { u32x4 v = {pk2(x2[63 - 8 * i].x, x2[62 - 8 * i].x), pk2(x2[61 - 8 * i].x, x2[60 - 8 * i].x), pk2(x2[59 - 8 * i].x, x2[58 - 8 * i].x), pk2(x2[57 - 8 * i].x, x2[56 - 8 * i].x)}; *(u32x4*)(UTg + 8 * i) = v; }
            }
        }
        __syncthreads();
    }
    }
}

DI void gdn_scan_block(const Params& p, int sb, unsigned char* lds0, unsigned char* lds1, int role) {
    const int tid = (threadIdx.x & 255), lane = tid & 63, wid = tid >> 6, l15 = lane & 15, quad = lane >> 4;
    const int chain = sb >> 1, half = sb & 1, b = chain >> 3, h = (chain >> 1) & 3, d = chain & 1, slice = half * 4 + wid;
    unsigned char* ws = p.ws;
    if (role == 1) {
        u32x4 pre[16]; float presc = 0.f;
        auto issue = [&](int step) {
            const int ck = d ? (step < 4 ? 3 - step : 135 - step) : step;
            const size_t cu = (size_t)(b * NCK + ck) * 4 + h, dcu = (size_t)d * NCU + cu;
            const u32x4* WN = (const u32x4*)(ws + OFF_WNEG + dcu * 16384);
            const u32x4* QN = (const u32x4*)(ws + OFF_QN + cu * 16384);
            const u32x4* KT = (const u32x4*)(ws + OFF_KNT + cu * 16384);
            const u32x4* IN = (const u32x4*)(ws + OFF_INTRA + dcu * 8192);
            const u32x4* UT = (const u32x4*)(ws + OFF_UT + dcu * 16384 + (size_t)half * 8192);
            const float* SC = (const float*)(ws + OFF_SCAL) + dcu * 192;
#pragma unroll
            for (int i = 0; i < 4; ++i) { pre[i] = WN[tid + 256 * i]; pre[4 + i] = QN[tid + 256 * i]; pre[8 + i] = KT[tid + 256 * i]; }
#pragma unroll
            for (int i = 0; i < 2; ++i) { pre[12 + i] = IN[tid + 256 * i]; pre[14 + i] = UT[tid + 256 * i]; }
            if (tid < 192) presc = SC[tid];
        };
        auto commit = [&](unsigned char* L) {
#pragma unroll
            for (int i = 0; i < 4; ++i) {
                const int r16 = (tid >> 4) + 16 * i, c16 = tid & 15;
                *(u32x4*)(L + r16 * 272 + c16 * 16) = pre[i];
                *(u32x4*)(L + 17408 + r16 * 272 + c16 * 16) = pre[4 + i];
                const int r8 = (tid >> 3) + 32 * i, c8 = tid & 7;
                *(u32x4*)(L + 34816 + r8 * 144 + c8 * 16) = pre[8 + i];
            }
#pragma unroll
            for (int i = 0; i < 2; ++i) {
                const int r8 = (tid >> 3) + 32 * i, c8 = tid & 7;
                *(u32x4*)(L + 53248 + r8 * 144 + c8 * 16) = pre[12 + i];
                *(u32x4*)(L + 62464 + r8 * 144 + c8 * 16) = pre[14 + i];
            }
            if (tid < 192) ((float*)(L + 71680))[tid] = presc;
        };
        issue(0); commit(lds0); issue(1);
        __syncthreads();
        for (int step = 0; step < NCK; ++step) {
            if (step + 1 < NCK) { commit(((step + 1) & 1) ? lds1 : lds0); if (step + 2 < NCK) issue(step + 2); }
            __syncthreads();
        }
        return;
    }
    f32x4 S[8];
#pragma unroll
    for (int i = 0; i < 8; ++i) S[i] = (f32x4){0.f, 0.f, 0.f, 0.f};
    u16* Og = (u16*)(ws + OFF_O01) + (size_t)d * NLAT * 512;
    __syncthreads();
    for (int step = 0; step < NCK; ++step) {
        const int ck = d ? (step < 4 ? 3 - step : 135 - step) : step;
        const bool isctx = ck < 4;
        const unsigned char* L = (step & 1) ? lds1 : lds0;
        const u16* WNl = (const u16*)L; const u16* QNl = (const u16*)(L + 17408); const u16* KTl = (const u16*)(L + 34816); const u16* INl = (const u16*)(L + 53248); const u16* UTl = (const u16*)(L + 62464); const float* SCl = (const float*)(L + 71680);
        bf16x8 Sb[4];
#pragma unroll
        for (int ks = 0; ks < 4; ++ks) Sb[ks] = mk8(pk2(S[2 * ks][0], S[2 * ks][1]), pk2(S[2 * ks][2], S[2 * ks][3]), pk2(S[2 * ks + 1][0], S[2 * ks + 1][1]), pk2(S[2 * ks + 1][2], S[2 * ks + 1][3]));
        f32x4 vn[4], o[4];
#pragma unroll
        for (int mt = 0; mt < 4; ++mt) {
            const u32x2 raw = *(const u32x2*)(UTl + (16 * wid + l15) * 72 + 16 * mt + 4 * quad);
            vn[mt] = (f32x4){bflo(raw.x), bfhi(raw.x), bflo(raw.y), bfhi(raw.y)};
#pragma unroll
            for (int ks = 0; ks < 4; ++ks) {
                const bf16x8 a = *(const bf16x8*)(WNl + (16 * mt + l15) * 136 + 32 * ks + 8 * quad);
                vn[mt] = MFMA16(a, Sb[ks], vn[mt]);
            }
        }
        if (!isctx) {
#pragma unroll
            for (int mt = 0; mt < 4; ++mt) {
                o[mt] = (f32x4){0.f, 0.f, 0.f, 0.f};
#pragma unroll
                for (int ks = 0; ks < 4; ++ks) {
                    const bf16x8 a = *(const bf16x8*)(QNl + (16 * mt + l15) * 136 + 32 * ks + 8 * quad);
                    o[mt] = MFMA16(a, Sb[ks], o[mt]);
                }
                const f32x4 qs = *(const f32x4*)(SCl + 16 * mt + 4 * quad);
                o[mt] = o[mt] * qs;
            }
        }
        bf16x8 vb[2], vsb[2];
        {
            f32x4 kc[4];
#pragma unroll
            for (int mt = 0; mt < 4; ++mt) kc[mt] = *(const f32x4*)(SCl + 64 + 16 * mt + 4 * quad);
#pragma unroll
            for (int k2 = 0; k2 < 2; ++k2) {
                const f32x4 a = vn[2 * k2], c = vn[2 * k2 + 1];
                vb[k2] = mk8(pk2(a[0], a[1]), pk2(a[2], a[3]), pk2(c[0], c[1]), pk2(c[2], c[3]));
                const f32x4 as = a * kc[2 * k2], cs = c * kc[2 * k2 + 1];
                vsb[k2] = mk8(pk2(as[0], as[1]), pk2(as[2], as[3]), pk2(cs[0], cs[1]), pk2(cs[2], cs[3]));
            }
        }
        const float egl = SCl[128];
#pragma unroll
        for (int st = 0; st < 8; ++st) {
            S[st] = S[st] * egl;
#pragma unroll
            for (int k2 = 0; k2 < 2; ++k2) {
                const bf16x8 a = *(const bf16x8*)(KTl + (16 * st + l15) * 72 + 32 * k2 + 8 * quad);
                S[st] = MFMA16(a, vsb[k2], S[st]);
            }
        }
        if (!isctx) {
            const int tok0 = b * SEQ + (ck - 4) * 64;
#pragma unroll
            for (int mt = 0; mt < 4; ++mt) {
#pragma unroll
                for (int k2 = 0; k2 < 2; ++k2) {
                    const bf16x8 a = *(const bf16x8*)(INl + (16 * mt + l15) * 72 + 32 * k2 + 8 * quad);
                    o[mt] = MFMA16(a, vb[k2], o[mt]);
                }
#pragma unroll
                for (int r = 0; r < 4; ++r) Og[(size_t)(tok0 + 16 * mt + 4 * quad + r) * 512 + h * 128 + 16 * slice + l15] = f2bf(o[mt][r]);
            }
        }
        __syncthreads();
    }
}

DI void attn_unit(const Params& p, int P, int half, unsigned char* lds, float Mb) {
    const int tid = (threadIdx.x & 255), lane = tid & 63, wid = tid >> 6, l31 = lane & 31, hh = lane >> 5;
    const int kh = P & 3, qb = 2 * ((P >> 2) & 63) + half, bk = P >> 8, b = bk >> 1, kvh = bk & 1, head = kvh * 4 + wid;
    unsigned char* ws = p.ws;
    const u16* MIX = (const u16*)(ws + OFF_MIX);
    constexpr int NT = SKV / 64 / 4;
    const u16* Kg = (const u16*)(ws + OFF_K) + (size_t)bk * SKV * 64 + (size_t)kh * NT * 64 * 64;
    const u16* Vg = (const u16*)(ws + OFF_VT) + (size_t)bk * 64 * SKV + (size_t)kh * NT * 64;
    u16* Kl = (u16*)lds; u16* Vl = (u16*)(lds + 36864);
    const int tokA = b * SEQ + qb * 64 + l31;
    const size_t qrowA = (size_t)tokA * DM + head * 64, qrowB = qrowA + (size_t)32 * DM;
    bf16x8 qfA[4], qfB[4];
#pragma unroll
    for (int ks = 0; ks < 4; ++ks) { qfA[ks] = *(const bf16x8*)(MIX + qrowA + 16 * ks + 8 * hh); qfB[ks] = *(const bf16x8*)(MIX + qrowB + 16 * ks + 8 * hh); }
    f32x16 o0A, o1A, laA, o0B, o1B, laB;
#pragma unroll
    for (int i = 0; i < 16; ++i) { o0A[i] = 0.f; o1A[i] = 0.f; laA[i] = 0.f; o0B[i] = 0.f; o1B[i] = 0.f; laB[i] = 0.f; }
    const bf16x8 ones = mk8(0x3f803f80u, 0x3f803f80u, 0x3f803f80u, 0x3f803f80u);
    int t5_ = (int)threadIdx.x; asm volatile("" : "+v"(t5_));
    const int lrow = t5_ >> 3, lcc = t5_ & 7;
    u32x4 rk, rv;
    rk = *(const u32x4*)(Kg + (size_t)lrow * 64 + lcc * 8); rv = *(const u32x4*)(Vg + (size_t)lrow * SKV + lcc * 8);
    __syncthreads();
    *(u32x4*)(Kl + lrow * 72 + lcc * 8) = rk; *(u32x4*)(Vl + lrow * 72 + lcc * 8) = rv;
    rk = *(const u32x4*)(Kg + (size_t)(64 + lrow) * 64 + lcc * 8); rv = *(const u32x4*)(Vg + (size_t)lrow * SKV + 64 + lcc * 8);
    __syncthreads();
    for (int kt = 0; kt < NT; ++kt) {
        const u16* Kc = Kl + (kt & 1) * 9216; const u16* Vc = Vl + (kt & 1) * 9216;
        if (kt + 1 < NT) {
            u16* Kn = Kl + ((kt + 1) & 1) * 9216; u16* Vn = Vl + ((kt + 1) & 1) * 9216;
            *(u32x4*)(Kn + lrow * 72 + lcc * 8) = rk; *(u32x4*)(Vn + lrow * 72 + lcc * 8) = rv;
        }
        if (kt + 2 < NT) { rk = *(const u32x4*)(Kg + (size_t)((kt + 2) * 64 + lrow) * 64 + lcc * 8); rv = *(const u32x4*)(Vg + (size_t)lrow * SKV + (kt + 2) * 64 + lcc * 8); }
#pragma unroll
        for (int sub = 0; sub < 2; ++sub) {
            f32x16 sA, sB;
#pragma unroll
            for (int i = 0; i < 16; ++i) { sA[i] = -Mb; sB[i] = -Mb; }
#pragma unroll
            for (int ks = 0; ks < 4; ++ks) {
                const bf16x8 kf = *(const bf16x8*)(Kc + (sub * 32 + l31) * 72 + 16 * ks + 8 * hh);
                sA = MFMA32(kf, qfA[ks], sA); sB = MFMA32(kf, qfB[ks], sB);
            }
#pragma unroll
            for (int i = 0; i < 16; ++i) { sA[i] = __builtin_amdgcn_exp2f(sA[i]); sB[i] = __builtin_amdgcn_exp2f(sB[i]); }
#pragma unroll
            for (int sp = 0; sp < 2; ++sp) {
                const bf16x8 pA = mk8(pk2(sA[8 * sp], sA[8 * sp + 1]), pk2(sA[8 * sp + 2], sA[8 * sp + 3]), pk2(sA[8 * sp + 4], sA[8 * sp + 5]), pk2(sA[8 * sp + 6], sA[8 * sp + 7]));
                const bf16x8 pB = mk8(pk2(sB[8 * sp], sB[8 * sp + 1]), pk2(sB[8 * sp + 2], sB[8 * sp + 3]), pk2(sB[8 * sp + 4], sB[8 * sp + 5]), pk2(sB[8 * sp + 6], sB[8 * sp + 7]));
                const u16* v0 = Vc + l31 * 72 + sub * 32 + 16 * sp + 4 * hh;
                const bf16x8 vf0 = mk8(*(const u32x2*)v0, *(const u32x2*)(v0 + 8));
                const bf16x8 vf1 = mk8(*(const u32x2*)(v0 + 32 * 72), *(const u32x2*)(v0 + 32 * 72 + 8));
                o0A = MFMA32(vf0, pA, o0A); o0B = MFMA32(vf0, pB, o0B); o1A = MFMA32(vf1, pA, o1A); o1B = MFMA32(vf1, pB, o1B);
                laA = MFMA32(ones, pA, laA); laB = MFMA32(ones, pB, laB);
            }
        }
        __syncthreads();
    }
    float* LP = (float*)(ws + OFF_LP) + (size_t)kh * NLAT * 8;
    if (hh == 0) { LP[(size_t)tokA * 8 + head] = laA[0]; LP[(size_t)(tokA + 32) * 8 + head] = laB[0]; }
    u16* OPA = (u16*)p.out + (size_t)kh * NLAT * 512 + (size_t)tokA * 512 + head * 64;
    u16* OPB = OPA + (size_t)32 * 512;
#pragma unroll
    for (int g = 0; g < 4; ++g) {
        { u32x2 w0 = {pk2(o0A[4 * g], o0A[4 * g + 1]), pk2(o0A[4 * g + 2], o0A[4 * g + 3])}; u32x2 w1 = {pk2(o1A[4 * g], o1A[4 * g + 1]), pk2(o1A[4 * g + 2], o1A[4 * g + 3])};
          *(u32x2*)(OPA + 8 * g + 4 * hh) = w0; *(u32x2*)(OPA + 32 + 8 * g + 4 * hh) = w1; }
        { u32x2 w0 = {pk2(o0B[4 * g], o0B[4 * g + 1]), pk2(o0B[4 * g + 2], o0B[4 * g + 3])}; u32x2 w1 = {pk2(o1B[4 * g], o1B[4 * g + 1]), pk2(o1B[4 * g + 2], o1B[4 * g + 3])};
          *(u32x2*)(OPB + 8 * g + 4 * hh) = w0; *(u32x2*)(OPB + 32 + 8 * g + 4 * hh) = w1; }
    }
}

namespace pg8 {
#define PG8_LAS __attribute__((address_space(3)))
typedef unsigned short bf16_t;
typedef short bf16x8 __attribute__((ext_vector_type(8)));
typedef float f32x4 __attribute__((ext_vector_type(4)));
typedef unsigned u32x4 __attribute__((ext_vector_type(4)));
constexpr int BM = 256, BK = 64, HALF = 128, HTB = HALF * BK * 2  , STAGE_BYTES = 8 * HTB, NXCD = 8, WGM = 8;

__host__ __device__ __forceinline__ int lds_byte(int r, int c) { const int st = (r >> 4) * 2 + (c >> 5), rr = r & 15, cc = c & 31, ob = rr * 64 + cc * 2; return st * 1024 + (ob ^ (((ob >> 9) & 1) << 5)); }
__host__ __device__ __forceinline__ void stage_rc(int b, int& R, int& C) { const int st = b / 1024, sb = b % 1024, swz = sb ^ (((sb >> 9) & 1) << 5); R = (st >> 1) * 16 + swz / 64; C = (st & 1) * 32 + (swz % 64) / 2; }
__host__ __device__ __forceinline__ int perm32(int rho) { const int n = rho >> 4, i = rho & 15; return 8 * (i >> 2) + 4 * n + (i & 3); }

struct Unit { int pm, pn; };
struct Gemm { const bf16_t* A; const bf16_t* Bt; int M, N, K; };

struct StaticOrder {
    int nM, nN, nwg, G, c;
    __host__ __device__ void init(int M, int N, int G_, int c_) { nM = M / BM; nN = N / BM; nwg = nM * nN; G = G_; c = c_; }
    __host__ __device__ bool next(int i, Unit& u) const {
        const long L = (long)i * G + c; if (L >= nwg) return false;
        int wgid = (int)L; { const int q = nwg / NXCD, r = nwg % NXCD, xcd = wgid % NXCD, off = wgid / NXCD; wgid = (xcd < r ? xcd * (q + 1) : r * (q + 1) + (xcd - r) * q) + off; }
        const int nig = WGM * nN, gid = wgid / nig, fm = gid * WGM, gsz = (nM - fm) < WGM ? (nM - fm) : WGM;
        u.pm = fm + ((wgid % nig) % gsz); u.pn = (wgid % nig) / gsz; return true;
    }
    __device__ __forceinline__ void a_ready(const Unit&) const {}
    __device__ __forceinline__ void done(const Unit&) const {}
};


template <class Epi, class Sched, bool ALIGN_EPI = false, bool SP2 = false>
__device__ __forceinline__ void gemm_phase(PG8_LAS unsigned char* lds, const Gemm g, const Sched& S, const Epi& E) {
    const int tid = threadIdx.x, wid = __builtin_amdgcn_readfirstlane(tid >> 6), lane = tid & 63, wr = wid >> 2, wc = wid & 3, fr = lane & 15, fq = lane >> 4;
    const int K = g.K, nt = K / BK;
    unsigned voffA[2], voffB[2];
#pragma unroll
    for (int i = 0; i < 2; ++i) { int R, C; stage_rc(tid * 16 + i * 8192, R, C); const int Rb = Epi::PERM ? ((R & ~31) + perm32(R & 31)) : R;
        voffA[i] = (unsigned)(R * K + C) * 2u; voffB[i] = (unsigned)(Rb * K + C) * 2u; }
    const size_t kstep = (size_t)(BK * 2);
    const size_t hstep = (size_t)HALF * K * 2;
    const size_t tstep = 2 * hstep;
    const unsigned ldsw = (unsigned)wid * 1024u;
    const int aoff = lds_byte(wr * 64 + fr, fq * 8), boff = lds_byte(wc * 32 + fr, fq * 8);
#define PG8_SA(b, h) (((b) * 2 + (h)) * HTB)
#define PG8_SB(b, h) ((4 + (b) * 2 + (h)) * HTB)
#define PG8_STAGE(bufoff, gbase, voff) do { _Pragma("unroll") for (int _i = 0; _i < 2; ++_i) \
        __builtin_amdgcn_global_load_lds((const unsigned*)((const char*)(gbase) + (voff)[_i]), (PG8_LAS unsigned*)(lds + (bufoff) + ldsw + _i * 8192), 16, 0, 0); } while (0)
#define PG8_LDA(dst, b, h) do { _Pragma("unroll") for (int m = 0; m < 4; ++m) _Pragma("unroll") for (int k = 0; k < 2; ++k) dst[m][k] = *(const PG8_LAS bf16x8*)(lds + PG8_SA(b, h) + aoff + m * 2048 + k * 1024); } while (0)
#define PG8_LDB(dst, b, h) do { _Pragma("unroll") for (int n = 0; n < 2; ++n) _Pragma("unroll") for (int k = 0; k < 2; ++k) dst[n][k] = *(const PG8_LAS bf16x8*)(lds + PG8_SB(b, h) + boff + n * 2048 + k * 1024); } while (0)
#define PG8_MMA(ai, bj, At, Bt) do { __builtin_amdgcn_s_setprio(1); _Pragma("unroll") for (int m = 0; m < 4; ++m) _Pragma("unroll") for (int n = 0; n < 2; ++n) _Pragma("unroll") for (int k = 0; k < 2; ++k) \
        acc[ai][bj][m][n] = __builtin_amdgcn_mfma_f32_16x16x32_bf16(Bt[n][k], At[m][k], acc[ai][bj][m][n], 0, 0, 0); __builtin_amdgcn_s_setprio(0); } while (0)
#define PG8_WAIT_V(n) asm volatile("s_waitcnt vmcnt(" #n ")" ::: "memory")
#define PG8_WAIT_L(n) asm volatile("s_waitcnt lgkmcnt(" #n ")" ::: "memory")
#define PG8_BAR __builtin_amdgcn_s_barrier()
#define PG8_SCHED __builtin_amdgcn_sched_barrier(0)
    Unit cur, nxt; int ui = 0;
    if (!S.next(0, cur)) return;
    f32x4 acc[2][2][4][2];
#pragma unroll
    for (int a = 0; a < 2; ++a)
#pragma unroll
        for (int b = 0; b < 2; ++b)
#pragma unroll
            for (int m = 0; m < 4; ++m)
#pragma unroll
                for (int n = 0; n < 2; ++n) acc[a][b][m][n] = (f32x4){0.f, 0.f, 0.f, 0.f};
    bf16x8 At[4][2], B0[2][2], B1[2][2];
    const char* cA = (const char*)g.A + (size_t)cur.pm * tstep; const char* cB = (const char*)g.Bt + (size_t)cur.pn * tstep;
    S.a_ready(cur);
    if constexpr (SP2) {
        PG8_STAGE(PG8_SB(0, 0), cB, voffB); PG8_STAGE(PG8_SB(0, 1), cB + hstep, voffB); PG8_STAGE(PG8_SA(0, 0), cA, voffA); PG8_STAGE(PG8_SA(0, 1), cA + hstep, voffA);
        if (wr == 1) PG8_BAR;
        PG8_WAIT_V(2); PG8_BAR;
        PG8_STAGE(PG8_SB(1, 0), cB + kstep, voffB); PG8_STAGE(PG8_SA(1, 0), cA + kstep, voffA); PG8_STAGE(PG8_SB(1, 1), cB + hstep + kstep, voffB);
        PG8_WAIT_V(6); PG8_BAR;
    } else {
        PG8_STAGE(PG8_SB(0, 0), cB, voffB); PG8_STAGE(PG8_SA(0, 0), cA, voffA); PG8_STAGE(PG8_SB(0, 1), cB + hstep, voffB); PG8_STAGE(PG8_SA(0, 1), cA + hstep, voffA);
        if (wr == 1) PG8_BAR;
        PG8_WAIT_V(4); PG8_BAR;
        PG8_STAGE(PG8_SB(1, 0), cB + kstep, voffB); PG8_STAGE(PG8_SA(1, 0), cA + kstep, voffA); PG8_STAGE(PG8_SB(1, 1), cB + hstep + kstep, voffB);
        PG8_WAIT_V(6); PG8_BAR;
    }
    for (;;) {
        const bool has_next = S.next(ui + 1, nxt);
        const char* nA = has_next ? (const char*)g.A + (size_t)nxt.pm * tstep : cA; const char* nB = has_next ? (const char*)g.Bt + (size_t)nxt.pn * tstep : cB;
        for (int t = 0; t < nt; t += 2) {
            const bool last = (t == nt - 2);
            const char* a1 = cA + (size_t)(t + 1) * kstep;
            const char* a2 = last ? nA : cA + (size_t)(t + 2) * kstep; const char* b2 = last ? nB : cB + (size_t)(t + 2) * kstep;
            const char* a3 = a2 + kstep; const char* b3 = b2 + kstep;
            if (last && has_next) S.a_ready(nxt);
            if constexpr (SP2) {
            PG8_LDB(B0, 0, 0); PG8_LDB(B1, 0, 1); PG8_SCHED; PG8_LDA(At, 0, 0); PG8_STAGE(PG8_SA(1, 1), a1 + hstep, voffA);
            PG8_WAIT_V(8); PG8_WAIT_L(0); PG8_BAR; PG8_MMA(0, 0, At, B0); PG8_MMA(0, 1, At, B1); PG8_BAR; PG8_SCHED;
            PG8_LDA(At, 0, 1); PG8_STAGE(PG8_SB(0, 0), b2, voffB); PG8_STAGE(PG8_SB(0, 1), b2 + hstep, voffB); PG8_STAGE(PG8_SA(0, 0), a2, voffA);
            PG8_WAIT_V(8); PG8_WAIT_L(0); PG8_BAR; PG8_MMA(1, 0, At, B0); PG8_MMA(1, 1, At, B1); PG8_BAR; PG8_SCHED;
            PG8_LDB(B0, 1, 0); PG8_LDB(B1, 1, 1); PG8_SCHED; PG8_LDA(At, 1, 0); PG8_STAGE(PG8_SA(0, 1), a2 + hstep, voffA);
            PG8_WAIT_V(8); PG8_WAIT_L(0); PG8_BAR; PG8_MMA(0, 0, At, B0); PG8_MMA(0, 1, At, B1); PG8_BAR; PG8_SCHED;
            PG8_LDA(At, 1, 1); PG8_STAGE(PG8_SB(1, 0), b3, voffB); PG8_STAGE(PG8_SB(1, 1), b3 + hstep, voffB); PG8_STAGE(PG8_SA(1, 0), a3, voffA);
            PG8_WAIT_V(8); PG8_WAIT_L(0); PG8_BAR; PG8_MMA(1, 0, At, B0); PG8_MMA(1, 1, At, B1); PG8_BAR; PG8_SCHED;
            } else {
            PG8_LDB(B0, 0, 0); PG8_SCHED; PG8_LDA(At, 0, 0); PG8_STAGE(PG8_SA(1, 1), a1 + hstep, voffA);
            PG8_WAIT_L(8); PG8_BAR; PG8_WAIT_L(0); PG8_MMA(0, 0, At, B0); PG8_BAR; PG8_SCHED;
            PG8_LDB(B1, 0, 1); PG8_STAGE(PG8_SB(0, 0), b2, voffB);
            PG8_BAR; PG8_WAIT_L(0); PG8_MMA(0, 1, At, B1); PG8_BAR;
            PG8_LDA(At, 0, 1); PG8_STAGE(PG8_SA(0, 0), a2, voffA);
            PG8_BAR; PG8_WAIT_L(0); PG8_MMA(1, 0, At, B0); PG8_BAR; PG8_SCHED;
            PG8_STAGE(PG8_SB(0, 1), b2 + hstep, voffB);
            PG8_WAIT_V(6); PG8_BAR; PG8_MMA(1, 1, At, B1); PG8_BAR;
            PG8_LDB(B0, 1, 0); PG8_SCHED; PG8_LDA(At, 1, 0); PG8_STAGE(PG8_SA(0, 1), a2 + hstep, voffA);
            PG8_WAIT_L(8); PG8_BAR; PG8_WAIT_L(0); PG8_MMA(0, 0, At, B0); PG8_BAR; PG8_SCHED;
            PG8_LDB(B1, 1, 1); PG8_STAGE(PG8_SB(1, 0), b3, voffB);
            PG8_BAR; PG8_WAIT_L(0); PG8_MMA(0, 1, At, B1); PG8_BAR;
            PG8_LDA(At, 1, 1); PG8_STAGE(PG8_SA(1, 0), a3, voffA);
            PG8_BAR; PG8_WAIT_L(0); PG8_MMA(1, 0, At, B0); PG8_BAR; PG8_SCHED;
            PG8_STAGE(PG8_SB(1, 1), b3 + hstep, voffB);
            PG8_WAIT_V(6); PG8_BAR; PG8_MMA(1, 1, At, B1); PG8_BAR;
            }
        }
        if constexpr (ALIGN_EPI) { if (wr == 0) PG8_BAR; }
        if constexpr (!Epi::AFTER_DRAIN) { E(acc, cur, wr, wc, fr, fq); S.done(cur); }
        if (!has_next) break;
#pragma unroll
        for (int a = 0; a < 2; ++a)
#pragma unroll
            for (int b = 0; b < 2; ++b)
#pragma unroll
                for (int m = 0; m < 4; ++m)
#pragma unroll
                    for (int n = 0; n < 2; ++n) acc[a][b][m][n] = (f32x4){0.f, 0.f, 0.f, 0.f};
        cur = nxt; cA = nA; cB = nB; ++ui;
        if constexpr (ALIGN_EPI) { if (wr == 1) PG8_BAR; }
    }
    PG8_WAIT_V(0);
    if constexpr (!ALIGN_EPI) { if (wr == 0) PG8_BAR; }
    PG8_BAR;
    if constexpr (Epi::AFTER_DRAIN) { E.fused(acc, cur, wr, wc, fr, fq, lds, wid, lane); S.done(cur); }
#undef PG8_SA
#undef PG8_SB
#undef PG8_STAGE
#undef PG8_LDA
#undef PG8_LDB
#undef PG8_MMA
#undef PG8_WAIT_V
#undef PG8_WAIT_L
#undef PG8_BAR
#undef PG8_SCHED
}

struct EpiRelu2 {
    static constexpr bool PERM = true, AFTER_DRAIN = false;
    bf16_t* O; int ldc;
    __device__ __forceinline__ void operator()(const f32x4 (&acc)[2][2][4][2], const Unit& u, int wr, int wc, int fr, int fq) const {
#pragma unroll
        for (int ai = 0; ai < 2; ++ai)
#pragma unroll
            for (int m = 0; m < 4; ++m) {
                bf16_t* rowp = O + (size_t)(u.pm * BM + ai * HALF + wr * 64 + m * 16 + fr) * ldc + u.pn * BM + wc * 32 + 8 * fq;
#pragma unroll
                for (int bj = 0; bj < 2; ++bj) {
                    f32x4 v0 = acc[ai][bj][m][0], v1 = acc[ai][bj][m][1];
#pragma unroll
                    for (int r = 0; r < 4; ++r) { const float a = fmaxf(v0[r], 0.f); v0[r] = a * a; const float c = fmaxf(v1[r], 0.f); v1[r] = c * c; }
                    u32x4 w = {::pk2(v0[0], v0[1]), ::pk2(v0[2], v0[3]), ::pk2(v1[0], v1[1]), ::pk2(v1[2], v1[3])};
                    *(u32x4*)(rowp + bj * HALF) = w;
                }
            }
    }
};
struct EpiGatedRes {
    static constexpr bool PERM = true, AFTER_DRAIN = false;
    const float* base; float* out; const float* gate; int gate_bstride; int ldc;
    __device__ __forceinline__ void operator()(const f32x4 (&acc)[2][2][4][2], const Unit& u, int wr, int wc, int fr, int fq) const {
        const float* g = gate + ((u.pm * BM) >> 13) * gate_bstride;
        const int col0 = u.pn * BM + wc * 32 + 8 * fq;
        f32x4 gv[2][2];
#pragma unroll
        for (int bj = 0; bj < 2; ++bj)
#pragma unroll
            for (int n = 0; n < 2; ++n) gv[bj][n] = *(const f32x4*)(g + col0 + bj * HALF + n * 4);
#pragma unroll
        for (int ai = 0; ai < 2; ++ai)
#pragma unroll
            for (int m = 0; m < 4; ++m) {
                const size_t off = (size_t)(u.pm * BM + ai * HALF + wr * 64 + m * 16 + fr) * ldc + col0;
#pragma unroll
                for (int bj = 0; bj < 2; ++bj)
#pragma unroll
                    for (int n = 0; n < 2; ++n) {
                        const f32x4 xv = *(const f32x4*)(base + off + bj * HALF + n * 4);
                        *(f32x4*)(out + off + bj * HALF + n * 4) = xv + gv[bj][n] * acc[ai][bj][m][n];
                    }
            }
    }
};
struct EpiInProj {
    static constexpr bool PERM = true, AFTER_DRAIN = false;
    bf16_t* MIX; bf16_t* Kb; bf16_t* Vt; bf16_t* DQ; float* GT; const float* a_log; const float* dt_bias;
    __device__ __forceinline__ void operator()(const f32x4 (&acc)[2][2][4][2], const Unit& u, int wr, int wc, int fr, int fq) const {
        const int pn = u.pn; const bool lat = u.pm < 64;
#pragma unroll
        for (int ai = 0; ai < 2; ++ai)
#pragma unroll
            for (int m = 0; m < 4; ++m) {
                const int gr = u.pm * BM + ai * HALF + wr * 64 + m * 16 + fr;
                int bb, kvpos;
                if (lat) { bb = gr >> 13; kvpos = 256 + (gr & 8191); } else { const int cr = gr - 16384; bb = cr >> 8; kvpos = cr & 255; }
#pragma unroll
                for (int bj = 0; bj < 2; ++bj) {
                    const int cl = bj * HALF + wc * 32 + 8 * fq;
                    const f32x4 v0 = acc[ai][bj][m][0], v1 = acc[ai][bj][m][1];
                    const u32x4 w = {::pk2(v0[0], v0[1]), ::pk2(v0[2], v0[3]), ::pk2(v1[0], v1[1]), ::pk2(v1[2], v1[3])};
                    if (pn < 2) { if (lat) *(u32x4*)(MIX + (size_t)gr * 1024 + pn * 256 + cl) = w; }
                    else if (pn == 2) {
                        if (bj == 0) { const int kvh = cl >> 6, d = cl & 63; *(u32x4*)(Kb + ((size_t)(bb * 2 + kvh) * 8448 + kvpos) * 64 + d) = w; }
                        else { const int c2 = cl - HALF, kvh = c2 >> 6, d = c2 & 63; bf16_t* vp = Vt + ((size_t)(bb * 2 + kvh) * 64 + d) * 8448 + kvpos;
#pragma unroll
                            for (int e = 0; e < 4; ++e) { vp[(2 * e) * 8448] = (bf16_t)(w[e] & 0xffffu); vp[(2 * e + 1) * 8448] = (bf16_t)(w[e] >> 16); } }
                    }
                    else if (pn < 9) *(u32x4*)(DQ + (size_t)gr * 1536 + (pn - 3) * 256 + cl) = w;
                    else { if (lat) *(u32x4*)(MIX + (size_t)gr * 1024 + 512 + (pn - 9) * 256 + cl) = w; }
                }
            }
    }
};
}

#define XB_TMO      128
#define XB_XCNT(j)  (256  + 64 * (j))
#define XB_XSUB(j)  (1280 + 64 * (j))
#define XB_XGEN(j)  (2304 + 64 * (j))
#define XB_TOP      3328
#define XB_TOPGEN   3392
#define XCD_BAR_WORDS 3456
#define XB_SPIN_CAP (1u << 22)
#define LAS __attribute__((address_space(3)))
DI unsigned xb_ld(unsigned* p)              { return __hip_atomic_load(p, __ATOMIC_RELAXED, __HIP_MEMORY_SCOPE_AGENT); }
DI unsigned xb_add(unsigned* p, unsigned v) { return __hip_atomic_fetch_add(p, v, __ATOMIC_RELAXED, __HIP_MEMORY_SCOPE_AGENT); }
DI unsigned xb_xcc_id() { return (unsigned)__builtin_amdgcn_s_getreg((3 << 11) | 20) & 0xFu; }
#define XB_SPIN(cond, bar) do { unsigned _sp = 0; while (cond) { __builtin_amdgcn_s_sleep(1); \
    if ((++_sp & 255u) == 0u) { if (xb_ld(&(bar)[XB_TMO])) break; if (_sp > XB_SPIN_CAP) { atomicAdd(&(bar)[XB_TMO], 1u); break; } } } } while (0)
struct XcdBarrier { unsigned* bar; unsigned x; volatile LAS unsigned* st; };
DI XcdBarrier xcd_barrier_post(unsigned* bar, volatile LAS unsigned* st) {
    XcdBarrier b; b.bar = bar; b.x = xb_xcc_id(); b.st = st;
    if (threadIdx.x == 0) (void)xb_add(&bar[XB_XCNT(b.x)], 1u);
    return b;
}
DI void xcd_barrier_complete(unsigned* bar, unsigned x, unsigned& nloc, unsigned& nx) {
    const unsigned G = gridDim.x * gridDim.y * gridDim.z;
    unsigned sum, cnt, mine, sp = 0u;
    for (;;) {
        sum = 0u; cnt = 0u; mine = 0u;
#pragma unroll
        for (unsigned j = 0; j < 16; ++j) { const unsigned c = xb_ld(&bar[XB_XCNT(j)]); sum += c; cnt += (c > 0u) ? 1u : 0u; mine = (j == x) ? c : mine; }
        if (sum == G) break;
        __builtin_amdgcn_s_sleep(1);
        if ((++sp & 255u) == 0u) { if (xb_ld(&bar[XB_TMO])) break; if (sp > XB_SPIN_CAP) { atomicAdd(&bar[XB_TMO], 1u); break; } }
    }
    nloc = mine > 0u ? mine : 1u; nx = cnt > 0u ? cnt : 1u;
}
DI void xcd_barrier(const XcdBarrier& b) {
    asm volatile("s_waitcnt vmcnt(0)" ::: "memory");
    __syncthreads();
    if (threadIdx.x == 0) {
        unsigned* bar = b.bar;
        __builtin_amdgcn_s_waitcnt(0);
        unsigned nloc = b.st[0], nx = b.st[1];
        if (nloc == 0u) { xcd_barrier_complete(bar, b.x, nloc, nx); b.st[0] = nloc; b.st[1] = nx; }
        const unsigned old = xb_add(&bar[XB_XSUB(b.x)], 1u);
        const unsigned gen = old / nloc;
        if (old + 1u == (gen + 1u) * nloc) {
            __builtin_amdgcn_fence(__ATOMIC_RELEASE, "agent");
            asm volatile("s_waitcnt vmcnt(0)" ::: "memory");
            const unsigned og = xb_add(&bar[XB_TOP], 1u);
            const unsigned tg = og / nx;
            if (og + 1u == (tg + 1u) * nx) xb_add(&bar[XB_TOPGEN], 1u);
            else XB_SPIN(xb_ld(&bar[XB_TOPGEN]) == tg, bar);
            __builtin_amdgcn_fence(__ATOMIC_ACQUIRE, "agent");
            xb_add(&bar[XB_XGEN(b.x)], 1u);
            asm volatile("s_waitcnt vmcnt(0)" ::: "memory");
        } else {
            XB_SPIN(xb_ld(&bar[XB_XGEN(b.x)]) == gen, bar);
            __builtin_amdgcn_fence(__ATOMIC_ACQUIRE, "agent");
            asm volatile("s_waitcnt vmcnt(0)" ::: "memory");
        }
    }
    __syncthreads();
}

__global__ void __launch_bounds__(512, 2) mega(Params p) {
    extern __shared__ __attribute__((aligned(16))) unsigned char lds_raw[];
    const int half = __builtin_amdgcn_readfirstlane(threadIdx.x >> 8);
    const int tid = threadIdx.x & 255, lane = tid & 63, wid = tid >> 6;
    const int nblk = gridDim.x * 2, bid = blockIdx.x * 2 + half;
    auto lwid = [&]() { int w_ = (int)((threadIdx.x & 255) >> 6); asm volatile("" : "+v"(w_)); return w_; };
    unsigned char* const lds_base = lds_raw; unsigned char* const lds = lds_raw + half * 73728;
    unsigned char* ws = p.ws;
    const int lo = p.ph_lo, hi = p.ph_hi;
#ifndef PH_MASK
#define PH_MASK 0x3ff
#endif
#define IN_PH(k) ((((PH_MASK) >> (k)) & 1) && lo <= (k) && (k) <= hi)
#define SEAM(k) do { if ((k) < hi) { xcd_barrier(xb); } } while (0)
    if (threadIdx.x < 4) ((volatile LAS unsigned*)(lds_base + 147456))[threadIdx.x] = 0u;
    __syncthreads();
    XcdBarrier xb = xcd_barrier_post((unsigned*)(ws + OFF_BAR), (volatile LAS unsigned*)(lds_base + 147456));
    if (hi > 1000) cg::this_grid().sync();
    float* MOD = (float*)(ws + OFF_MOD);
    int* CNT = (int*)(ws + OFF_MISC);

    if (IN_PH(0)) {
        constexpr int T_MOD = 96 * 4;
        for (int t = bid; t < T_MOD + 2; t += nblk) {
            if (t < T_MOD) {
                const int j = t >> 2, kq = t & 3; float* sv = (float*)lds; float* red = sv + 768;
                __syncthreads();
                for (int i = tid; i < 768; i += 256) { const int which = i >> 8, k = kq * 256 + (i & 255); const float cv = which < 2 ? p.c[which * 1024 + k] : p.c_ctx[k]; sv[i] = silu_f(cv); }
                __syncthreads();
                const int col = j * 64 + lane; float a0 = 0.f, a1 = 0.f, a2 = 0.f;
#pragma unroll 8
                for (int k = 64 * wid; k < 64 * wid + 64; ++k) { const float wv = p.w_mod[(size_t)(kq * 256 + k) * 6144 + col]; a0 += sv[k] * wv; a1 += sv[256 + k] * wv; a2 += sv[512 + k] * wv; }
                red[(wid * 3 + 0) * 64 + lane] = a0; red[(wid * 3 + 1) * 64 + lane] = a1; red[(wid * 3 + 2) * 64 + lane] = a2;
                __syncthreads();
                if (tid < 192) { const int which = tid >> 6, cl = tid & 63; float sacc = kq == 0 ? p.b_mod[j * 64 + cl] : 0.f; for (int w = 0; w < 4; ++w) sacc += red[(w * 3 + which) * 64 + cl]; atomicAdd(&MOD[which * 6144 + j * 64 + cl], sacc); }
            } else if (t == T_MOD) {
                f2_t* RT = (f2_t*)(ws + OFF_ROPE);
                for (int i = tid; i < 2048; i += 256) {
                    const int pos = i >> 4, j = i & 15;
                    const float inv = exp2f(-(float)j * 0.8304820237218406f);
                    const float ang = (float)pos * inv;
                    const float n = rintf(ang * 0.15915494309189535f);
                    float r = fmaf(-n, 6.28125f, ang); r = fmaf(-n, 1.9353071795864769e-3f, r);
                    RT[i] = (f2_t){cosf(r), sinf(r)};
                }
            } else { if (tid == 0) CNT[0] = 0; }
        }
        for (int t = bid; t < 16 * (INP / 64); t += nblk) wconv_tile(p.w_in, DM, INC, INP, (u16*)(ws + OFF_WIN), t, (float*)lds);
        SEAM(0);
    }
    if (IN_PH(1)) {
        u16* H = (u16*)(ws + OFF_H);
        norm_rows([&](int r) { return r < NLAT ? p.x + (size_t)r * DM : p.ctx + (size_t)(r - NLAT) * DM; }, NROW, bid * 4 + lwid(), nblk * 4, p.norm1_w, MOD, 0, 1, H, lane);
        SEAM(1);
    }
    if (IN_PH(2)) {
        pg8::Gemm g{(const u16*)(ws + OFF_H), (const u16*)(ws + OFF_WIN), NROW, 2816, DM}; pg8::StaticOrder S; S.init(NROW, 2816, (int)gridDim.x, (int)blockIdx.x);
        pg8::EpiInProj E{(u16*)(ws + OFF_MIX), (u16*)(ws + OFF_K), (u16*)(ws + OFF_VT), (u16*)(ws + OFF_DQKV), (float*)(ws + OFF_GATE), p.a_log, p.dt_bias};
        pg8::gemm_phase<pg8::EpiInProj, pg8::StaticOrder, true, true>((PG8_LAS unsigned char*)lds_base, g, S, E);
        {
            const u16* H = (const u16*)(ws + OFF_H); const u16* Wg = (const u16*)(ws + OFF_WIN) + (size_t)2816 * DM; float* GT = (float*)(ws + OFF_GATE);
            const int l15 = lane & 15, quad = lane >> 4;
            for (int rb = (int)blockIdx.x * 8 + (int)(threadIdx.x >> 6); rb < NROW / 16; rb += (int)gridDim.x * 8) {
                f32x4 acc = {0.f, 0.f, 0.f, 0.f};
                const u16* ap = H + (size_t)(rb * 16 + l15) * DM + 8 * quad; const u16* bp = Wg + (size_t)l15 * DM + 8 * quad;
#pragma unroll 8
                for (int ks = 0; ks < 32; ++ks) acc = MFMA16(*(const bf16x8*)(ap + 32 * ks), *(const bf16x8*)(bp + 32 * ks), acc);
                const int ci = l15;
#pragma unroll
                for (int r = 0; r < 4; ++r) {
                    const float x = acc[r]; float o;
                    if (ci < 8) o = 1.f / (1.f + __expf(-x));
                    else { const float xx = x + p.dt_bias[ci - 8]; const float sp = xx > 20.f ? xx : log1pf(__expf(xx)); o = -__expf(p.a_log[ci - 8]) * sp; }
                    GT[(size_t)(rb * 16 + 4 * quad + r) * 16 + ci] = o;
                }
            }
        }
        SEAM(2);
    }
    if (IN_PH(3)) {
        if (bid < 32) { gdn_prep_unit(p, ((bid >> 4) * NCK + ((bid >> 2) & 3)) * 4 + (bid & 3), lds); } else {
        {
            u16* MIX = (u16*)(ws + OFF_MIX); u16* Kb = (u16*)(ws + OFF_K); const f2_t* RT = (const f2_t*)(ws + OFF_ROPE);
            const int l8 = lane & 7, sub = lane >> 3;
            for (int it = (bid - 32) * 4 + wid; it < NLAT + (NB * 2 * SKV) / 8; it += (nblk - 32) * 4) {
                u16* ptr; int t; bool rope; const float* nw; float scale;
                if (it < NLAT) { ptr = MIX + (size_t)it * DM + sub * 64 + l8 * 8; t = it & (SEQ - 1); rope = true; nw = p.q_norm_w; scale = QSCALE; }
                else { const int j = (it - NLAT) * 8 + sub, bk = j / SKV, pos = j - bk * SKV; ptr = Kb + ((size_t)bk * SKV + pos) * 64 + l8 * 8; rope = pos >= CTXL; t = pos >= CTXL ? pos - CTXL : 0; nw = p.k_norm_w; scale = 1.f; }
                const u32x4 raw = *(const u32x4*)ptr;
                float y[8];
#pragma unroll
                for (int e = 0; e < 4; ++e) { y[2 * e] = bflo(raw[e]); y[2 * e + 1] = bfhi(raw[e]); }
                float ss = 0.f;
#pragma unroll
                for (int e = 0; e < 8; ++e) ss += y[e] * y[e];
                ss += __shfl_xor(ss, 1); ss += __shfl_xor(ss, 2); ss += __shfl_xor(ss, 4);
                const float rinv = rsqrtf(ss * (1.f / 64.f) + EPS);
                const f32x4 wa = *(const f32x4*)(nw + 8 * l8), wb = *(const f32x4*)(nw + 8 * l8 + 4);
                const int ppos = (l8 & 4) ? (t & 63) : (t >> 6); const float sgn = (l8 & 2) ? 1.f : -1.f;
#pragma unroll
                for (int e = 0; e < 8; ++e) {
                    const float v = y[e] * rinv * (e < 4 ? wa[e] : wb[e - 4]);
                    const float pv = __shfl_xor(v, 2);
                    const f2_t cs = RT[ppos * 16 + 8 * (l8 & 1) + e];
                    const float vr = v * cs.x + sgn * pv * cs.y;
                    y[e] = (rope ? vr : v) * scale;
                }
                const u32x4 w = {pk2(y[0], y[1]), pk2(y[2], y[3]), pk2(y[4], y[5]), pk2(y[6], y[7])};
                *(u32x4*)ptr = w;
            }
        }
        constexpr int T_WO = 16 * 16, T_W1 = 16 * 64, T_W2 = 64 * 16;
        for (int t = bid - 32; t < T_WO + T_W1 + T_W2; t += nblk - 32) {
            if (t < T_WO) wconv_tile(p.w_out, DM, DM, DM, (u16*)(ws + OFF_WOUT), t, (float*)lds);
            else if (t < T_WO + T_W1) wconv_tile(p.w_mlp1, DM, DFF, DFF, (u16*)(ws + OFF_WM1), t - T_WO, (float*)lds);
            else wconv_tile(p.w_mlp2, DFF, DM, DM, (u16*)(ws + OFF_WM2), t - T_WO - T_W1, (float*)lds);
        }
        }
        for (int j = bid; j < 1024; j += nblk) gdn_prep_unit(p, ((j >> 9) * NCK + 4 + ((j & 511) >> 2)) * 4 + (j & 3), lds);
        SEAM(3);
    }
    if (IN_PH(4)) {
        if (blockIdx.x < 32) {
            gdn_scan_block(p, (int)blockIdx.x, lds_base, lds_base + 73728, half);
        }
        float Mb;
        { const float a = wave_max(fabsf(p.q_norm_w[lane])), bq = wave_max(fabsf(p.k_norm_w[lane])); Mb = 8.f * a * bq * 1.4426950408889634f; }
        int* su = (int*)(lds_base + 147456 + 8);
        for (;;) {
            __syncthreads();
            if (threadIdx.x == 0) *su = atomicAdd(CNT, 2);
            __syncthreads();
            const int u0 = *su;
            if (u0 >= 2048) break;
            attn_unit(p, u0 >> 1, half, lds_base, Mb);
        }
        SEAM(4);
    }
    if (IN_PH(5)) {
        const u16* O0 = (const u16*)(ws + OFF_O01); const u16* O1 = O0 + (size_t)NLAT * 512; u16* MIX = (u16*)(ws + OFF_MIX);
        const int e0 = (8 * lane) & 127;
        const f32x4 nwa = *(const f32x4*)(p.dn_norm_w + e0), nwb = *(const f32x4*)(p.dn_norm_w + e0 + 4);
        {
            const u16* PP = (const u16*)p.out; const float* LL = (const float*)(ws + OFF_LP);
            for (int r = bid * 4 + lwid(); r < NLAT; r += nblk * 4) {
                const size_t off = (size_t)r * 512 + 8 * lane;
                float acc[8] = {0.f, 0.f, 0.f, 0.f, 0.f, 0.f, 0.f, 0.f}; float lsum = 0.f;
#pragma unroll
                for (int q = 0; q < 4; ++q) {
                    const u32x4 a = *(const u32x4*)(PP + (size_t)q * NLAT * 512 + off);
                    lsum += LL[(size_t)q * NLAT * 8 + (size_t)r * 8 + (lane >> 3)];
#pragma unroll
                    for (int i = 0; i < 4; ++i) { acc[2 * i] += bflo(a[i]); acc[2 * i + 1] += bfhi(a[i]); }
                }
                const float inv = 1.f / lsum;
                u32x4 w = {pk2(acc[0] * inv, acc[1] * inv), pk2(acc[2] * inv, acc[3] * inv), pk2(acc[4] * inv, acc[5] * inv), pk2(acc[6] * inv, acc[7] * inv)};
                *(u32x4*)(MIX + (size_t)r * DM + 8 * lane) = w;
            }
        }
        int r = bid * 4 + lwid(); const int rs = nblk * 4;
        u32x4 na = {0u, 0u, 0u, 0u}, nc = na, nz = na;
        if (r < NLAT) { na = *(const u32x4*)(O0 + (size_t)r * 512 + 8 * lane); nc = *(const u32x4*)(O1 + (size_t)r * 512 + 8 * lane); nz = *(const u32x4*)(MIX + (size_t)r * DM + 512 + 8 * lane); }
        for (; r < NLAT; r += rs) {
            const u32x4 a = na, c = nc, z = nz;
            if (r + rs < NLAT) { const int r2 = r + rs; na = *(const u32x4*)(O0 + (size_t)r2 * 512 + 8 * lane); nc = *(const u32x4*)(O1 + (size_t)r2 * 512 + 8 * lane); nz = *(const u32x4*)(MIX + (size_t)r2 * DM + 512 + 8 * lane); }
            float o[8], zz[8];
#pragma unroll
            for (int i = 0; i < 4; ++i) { o[2 * i] = bflo(a[i]) + bflo(c[i]); o[2 * i + 1] = bfhi(a[i]) + bfhi(c[i]); zz[2 * i] = bflo(z[i]); zz[2 * i + 1] = bfhi(z[i]); }
            float ss = 0.f;
#pragma unroll
            for (int i = 0; i < 8; ++i) ss += o[i] * o[i];
            ss += __shfl_xor(ss, 1); ss += __shfl_xor(ss, 2); ss += __shfl_xor(ss, 4); ss += __shfl_xor(ss, 8);
            const float rinv = rsqrtf(ss * (1.f / 128.f) + EPS);
            float y[8];
#pragma unroll
            for (int i = 0; i < 8; ++i) y[i] = o[i] * rinv * (i < 4 ? nwa[i] : nwb[i - 4]) * silu_f(zz[i]);
            u32x4 w = {pk2(y[0], y[1]), pk2(y[2], y[3]), pk2(y[4], y[5]), pk2(y[6], y[7])};
            *(u32x4*)(MIX + (size_t)r * DM + 512 + 8 * lane) = w;
        }
        SEAM(5);
    }
    if (IN_PH(6)) {
        pg8::Gemm g{(const u16*)(ws + OFF_MIX), (const u16*)(ws + OFF_WOUT), NLAT, DM, DM}; pg8::StaticOrder S; S.init(NLAT, DM, (int)gridDim.x, (int)blockIdx.x);
        pg8::EpiGatedRes E{p.x, p.out, MOD + 2 * 1024, 6144, DM};
        pg8::gemm_phase<pg8::EpiGatedRes, pg8::StaticOrder, true, true>((PG8_LAS unsigned char*)lds_base, g, S, E);
        SEAM(6);
    }
    if (IN_PH(7)) {
        u16* H2 = (u16*)(ws + OFF_H2);
        norm_rows([&](int r) { return (const float*)p.out + (size_t)r * DM; }, NLAT, bid * 4 + lwid(), nblk * 4, p.norm2_w, MOD, 3, 4, H2, lane);
        SEAM(7);
    }
    if (IN_PH(8)) {
        pg8::Gemm g{(const u16*)(ws + OFF_H2), (const u16*)(ws + OFF_WM1), NLAT, DFF, DM}; pg8::StaticOrder S; S.init(NLAT, DFF, (int)gridDim.x, (int)blockIdx.x);
        pg8::EpiRelu2 E{(u16*)(ws + OFF_HID), DFF};
        pg8::gemm_phase<pg8::EpiRelu2, pg8::StaticOrder, true, true>((PG8_LAS unsigned char*)lds_base, g, S, E);
        SEAM(8);
    }
    if (IN_PH(9)) {
        pg8::Gemm g{(const u16*)(ws + OFF_HID), (const u16*)(ws + OFF_WM2), NLAT, DM, DFF}; pg8::StaticOrder S; S.init(NLAT, DM, (int)gridDim.x, (int)blockIdx.x);
        pg8::EpiGatedRes E{p.out, p.out, MOD + 5 * 1024, 6144, DM};
        pg8::gemm_phase<pg8::EpiGatedRes, pg8::StaticOrder, true, true>((PG8_LAS unsigned char*)lds_base, g, S, E);
    }
}

extern "C" void kernel_launch(void* const* d_in, const int* in_sizes, int n_in, void* d_out, int out_size, void* d_ws, size_t ws_size, hipStream_t stream) {
    static int grid = 0;
    if (grid == 0) {
        if (ws_size < WS_NEED) { fprintf(stderr, "kernel_launch: workspace too small (%zu < %zu)\n", ws_size, (size_t)WS_END); grid = -1; return; }
        int dev = 0, cus = 0, per_cu = 0;
        hipGetDevice(&dev);
        hipDeviceGetAttribute(&cus, hipDeviceAttributeMultiprocessorCount, dev);
        hipFuncSetAttribute((const void*)mega, hipFuncAttributeMaxDynamicSharedMemorySize, LDS_BYTES);
        hipOccupancyMaxActiveBlocksPerMultiprocessor(&per_cu, (const void*)mega, 512, LDS_BYTES);
        if (per_cu < 1) per_cu = 1;
        if (per_cu > 1) per_cu = 1;
        grid = cus * per_cu;
        fprintf(stderr, "kernel_launch: cus %d per_cu %d grid %d ws %zu need %zu\n", cus, per_cu, grid, ws_size, (size_t)WS_END);
    }
    if (grid < 0) return;
    if (hipMemsetAsync((unsigned char*)d_ws + OFF_BAR, 0, ZERO_BYTES, stream) != hipSuccess) { fprintf(stderr, "kernel_launch: memset of barrier words failed\n"); return; }
    if (hipMemsetAsync((unsigned char*)d_ws + OFF_MOD, 0, 3 * 6144 * 4, stream) != hipSuccess) { fprintf(stderr, "kernel_launch: memset of MOD failed\n"); return; }
    Params p{};
    const float** pp = (const float**)&p;
    for (int i = 0; i < 18; ++i) pp[i] = (const float*)d_in[i];
    p.out = (float*)d_out; p.ws = (unsigned char*)d_ws;
#if ONE_LAUNCH
    p.ph_lo = 0; p.ph_hi = 9;
    void* args[] = {&p};
    hipError_t e = hipLaunchCooperativeKernel((const void*)mega, dim3(grid), dim3(512), args, LDS_BYTES, stream);
    if (e != hipSuccess) fprintf(stderr, "cooperative launch failed: %s (grid %d)\n", hipGetErrorString(e), grid);
#else
#ifndef DUP_PH
#define DUP_PH -1
#endif
    for (int ph = 0; ph <= 9; ++ph) {
        p.ph_lo = ph; p.ph_hi = ph;
        hipLaunchKernelGGL(mega, dim3(grid), dim3(512), LDS_BYTES, stream, p);
        if (ph == DUP_PH) hipLaunchKernelGGL(mega, dim3(grid), dim3(512), LDS_BYTES, stream, p);
    }
#endif
}
```

```cpp
#include <hip/hip_runtime.h>
#include <hip/hip_cooperative_groups.h>
#include <stdint.h>
#include <cstdio>
namespace cg = cooperative_groups;

#ifndef ONE_LAUNCH
#define ONE_LAUNCH 1
#endif

typedef unsigned short u16;
typedef __bf16 bf2_t __attribute__((ext_vector_type(2)));
typedef float f2_t __attribute__((ext_vector_type(2)));
typedef short bf16x8 __attribute__((ext_vector_type(8)));
typedef float f32x4 __attribute__((ext_vector_type(4)));
typedef float f32x16 __attribute__((ext_vector_type(16)));
typedef unsigned u32x2 __attribute__((ext_vector_type(2)));
typedef unsigned u32x4 __attribute__((ext_vector_type(4)));

#define DI __device__ __forceinline__
DI unsigned pk2(float lo, float hi) { f2_t v = {lo, hi}; return __builtin_bit_cast(unsigned, __builtin_convertvector(v, bf2_t)); }
DI u16 f2bf(float x) { return (u16)(pk2(x, 0.f) & 0xffffu); }
DI float bf2f(u16 v) { return __uint_as_float(((unsigned)v) << 16); }
DI float bflo(unsigned v) { return __uint_as_float(v << 16); }
DI float bfhi(unsigned v) { return __uint_as_float(v & 0xffff0000u); }
DI bf16x8 mk8(unsigned a, unsigned b, unsigned c, unsigned d) { u32x4 v = {a, b, c, d}; return __builtin_bit_cast(bf16x8, v); }
DI bf16x8 mk8(u32x2 lo, u32x2 hi) { u32x4 v = {lo.x, lo.y, hi.x, hi.y}; return __builtin_bit_cast(bf16x8, v); }
#define MFMA16(a, b, c) __builtin_amdgcn_mfma_f32_16x16x32_bf16((a), (b), (c), 0, 0, 0)
#define MFMA32(a, b, c) __builtin_amdgcn_mfma_f32_32x32x16_bf16((a), (b), (c), 0, 0, 0)

constexpr int DM = 1024, NB = 2, SEQ = 8192, NLAT = NB * SEQ, CTXL = 256, NCTX = NB * CTXL, NROW = NLAT + NCTX;
constexpr int INC = 2832, INP = 3072, DFF = 4096, SKV = CTXL + SEQ;
constexpr int NCK = 132;
constexpr int NCU = NB * NCK * 4;
constexpr float EPS = 1e-6f;
constexpr float QSCALE = 0.125f * 1.4426950408889634f;

constexpr size_t OFF_WIN = 0;
constexpr size_t OFF_MOD = OFF_WIN + (size_t)INP * DM * 2;
constexpr size_t OFF_ROPE = OFF_MOD + 3 * 6144 * 4;
constexpr size_t OFF_MISC = OFF_ROPE + 128 * 16 * 8;
constexpr size_t OFF_H = OFF_MISC + 256;
constexpr size_t OFF_WOUT = OFF_H;
constexpr size_t OFF_WM1 = OFF_WOUT + (size_t)DM * DM * 2;
constexpr size_t OFF_WM2 = OFF_WM1 + (size_t)DFF * DM * 2;
constexpr size_t OFF_DQKV = OFF_H + (size_t)NROW * DM * 2;
constexpr size_t OFF_O01 = OFF_DQKV;
constexpr size_t OFF_H2 = OFF_DQKV;
constexpr size_t OFF_MIX = OFF_DQKV + (size_t)NROW * 1536 * 2;
constexpr size_t OFF_HID = OFF_MIX;
constexpr size_t OFF_K = OFF_MIX + (size_t)NLAT * DM * 2;
constexpr size_t OFF_VT = OFF_K + (size_t)NB * 2 * SKV * 64 * 2;
constexpr size_t OFF_GATE = OFF_VT + (size_t)NB * 2 * SKV * 64 * 2;
constexpr size_t OFF_QN = OFF_GATE + (size_t)NROW * 16 * 4;
constexpr size_t OFF_KNT = OFF_QN + (size_t)NCU * 8192 * 2;
constexpr size_t OFF_WNEG = OFF_KNT + (size_t)NCU * 8192 * 2;
constexpr size_t OFF_UT = OFF_WNEG + (size_t)2 * NCU * 8192 * 2;
constexpr size_t OFF_INTRA = OFF_UT + (size_t)2 * NCU * 8192 * 2;
constexpr size_t OFF_SCAL = OFF_INTRA + (size_t)2 * NCU * 4096 * 2;
constexpr size_t WS_END = OFF_SCAL + (size_t)2 * NCU * 192 * 4;
static_assert(OFF_HID + (size_t)NLAT * DFF * 2 <= WS_END, "hid overlay");
static_assert(WS_END + 16384 + 3 * 6144 * 4 + 4 * 16384 * 8 * 4 <= (size_t)256 * 1024 * 1024, "ws budget");

constexpr int LDS_BYTES = 2 * 73728 + 16;
constexpr size_t OFF_BAR = WS_END;
constexpr size_t OFF_MODZ = OFF_BAR + 16384;
constexpr size_t ZERO_BYTES = 16384 + 3 * 6144 * 4;
constexpr size_t OFF_LP = OFF_MODZ + 3 * 6144 * 4;
constexpr size_t WS_NEED = OFF_LP + (size_t)4 * NLAT * 8 * 4;


struct Params {
    const float *x, *c, *ctx, *c_ctx, *w_mod, *b_mod, *norm1_w, *w_in, *q_norm_w, *k_norm_w, *conv_w, *a_log, *dt_bias, *dn_norm_w, *w_out, *norm2_w, *w_mlp1, *w_mlp2;
    float* out; unsigned char* ws; int ph_lo, ph_hi;
};

DI void wconv_tile(const float* __restrict__ W, int K, int N, int Npad, u16* __restrict__ Wt, int tile, float* st) {
    const int ntn = Npad / 64, kt = tile / ntn, nt = tile % ntn, k0 = kt * 64, n0 = nt * 64;
    const int tid = (threadIdx.x & 255), c = tid & 63, r4 = tid >> 6;
    __syncthreads();
#pragma unroll 4
    for (int i = 0; i < 16; ++i) { const int k = i * 4 + r4, n = n0 + c; st[k * 65 + c] = (n < N) ? W[(size_t)(k0 + k) * N + n] : 0.f; }
    __syncthreads();
#pragma unroll 4
    for (int i = 0; i < 16; ++i) { const int n = i * 4 + r4; Wt[(size_t)(n0 + n) * K + k0 + c] = f2bf(st[c * 65 + n]); }
}

template <class Epi>
DI void gemm_tile(const u16* __restrict__ A, int lda, const u16* __restrict__ Bt, int ldb, int K, int m0, int n0, unsigned char* lds, Epi&& epi) {
    const int tid = (threadIdx.x & 255), lane = tid & 63, wid = tid >> 6, wr = wid >> 1, wc = wid & 1, l15 = lane & 15, quad = lane >> 4;
    u16* As = (u16*)lds; u16* Bs = (u16*)(lds + 18432);
    f32x4 acc[4][4];
#pragma unroll
    for (int m = 0; m < 4; ++m)
#pragma unroll
        for (int n = 0; n < 4; ++n) acc[m][n] = (f32x4){0.f, 0.f, 0.f, 0.f};
    u32x4 ra[4], rb[4];
    const int lrow = tid >> 3, lcc = tid & 7;
    const u16* Ap = A + (size_t)(m0 + lrow) * lda + lcc * 8;
    const u16* Bp = Bt + (size_t)(n0 + lrow) * ldb + lcc * 8;
    const int nk = K / 64;
#pragma unroll
    for (int i = 0; i < 4; ++i) { ra[i] = *(const u32x4*)(Ap + (size_t)(32 * i) * lda); rb[i] = *(const u32x4*)(Bp + (size_t)(32 * i) * ldb); }
    __syncthreads();
#pragma unroll
    for (int i = 0; i < 4; ++i) { *(u32x4*)(As + (lrow + 32 * i) * 72 + lcc * 8) = ra[i]; *(u32x4*)(Bs + (lrow + 32 * i) * 72 + lcc * 8) = rb[i]; }
#pragma unroll
    for (int i = 0; i < 4; ++i) { ra[i] = *(const u32x4*)(Ap + (size_t)(32 * i) * lda + 64); rb[i] = *(const u32x4*)(Bp + (size_t)(32 * i) * ldb + 64); }
    __syncthreads();
    for (int kt = 0; kt < nk; ++kt) {
        const u16* Ac = As + (kt & 1) * 18432; const u16* Bc = Bs + (kt & 1) * 18432;
        if (kt + 1 < nk) {
            u16* An = As + ((kt + 1) & 1) * 18432; u16* Bn = Bs + ((kt + 1) & 1) * 18432;
#pragma unroll
            for (int i = 0; i < 4; ++i) { *(u32x4*)(An + (lrow + 32 * i) * 72 + lcc * 8) = ra[i]; *(u32x4*)(Bn + (lrow + 32 * i) * 72 + lcc * 8) = rb[i]; }
        }
        if (kt + 2 < nk) {
#pragma unroll
            for (int i = 0; i < 4; ++i) { ra[i] = *(const u32x4*)(Ap + (size_t)(32 * i) * lda + (kt + 2) * 64); rb[i] = *(const u32x4*)(Bp + (size_t)(32 * i) * ldb + (kt + 2) * 64); }
        }
#pragma unroll
        for (int ks = 0; ks < 2; ++ks) {
            bf16x8 af[4], bfr[4];
#pragma unroll
            for (int m = 0; m < 4; ++m) af[m] = *(const bf16x8*)(Ac + (64 * wr + 16 * m + l15) * 72 + 32 * ks + 8 * quad);
#pragma unroll
            for (int n = 0; n < 4; ++n) bfr[n] = *(const bf16x8*)(Bc + (64 * wc + 16 * n + l15) * 72 + 32 * ks + 8 * quad);
#pragma unroll
            for (int m = 0; m < 4; ++m)
#pragma unroll
                for (int n = 0; n < 4; ++n) acc[m][n] = MFMA16(bfr[n], af[m], acc[m][n]);
        }
        __syncthreads();
    }
    epi(acc, m0 + 64 * wr, n0 + 64 * wc, l15, quad);
}

DI float silu_f(float v) { return v / (1.f + __expf(-v)); }
DI int permpos(int c) { const int k = c & 31; return (c & ~31) | (8 * ((k & 15) >> 2) + 4 * (k >> 4) + (k & 3)); }
DI float wave_max(float v) {
#pragma unroll
    for (int o = 32; o > 0; o >>= 1) v = fmaxf(v, __shfl_xor(v, o));
    return v;
}
DI float wave_sum(float v) {
#pragma unroll
    for (int o = 32; o > 0; o >>= 1) v += __shfl_xor(v, o);
    return v;
}

template <class SrcF>
DI void norm_rows(SrcF srcf, int nrows, int row0, int rstride, const float* __restrict__ nw, const float* __restrict__ MOD, int shift_idx, int scale_idx, u16* __restrict__ dst, int lane) {
    f32x4 w[4], sh[4], sc[4]; int cur = -1;
    f32x4 v[4], nx[4];
    int r = row0;
    if (r < nrows) {
        const float* src = srcf(r);
#pragma unroll
        for (int i = 0; i < 4; ++i) nx[i] = *(const f32x4*)(src + 4 * lane + 256 * i);
    }
    for (; r < nrows; r += rstride) {
#pragma unroll
        for (int i = 0; i < 4; ++i) v[i] = nx[i];
        if (r + rstride < nrows) {
            const float* src = srcf(r + rstride);
#pragma unroll
            for (int i = 0; i < 4; ++i) nx[i] = *(const f32x4*)(src + 4 * lane + 256 * i);
        }
        const int which = r < NLAT ? (r >> 13) : 2;
        if (which != cur) {
            cur = which;
#pragma unroll
            for (int i = 0; i < 4; ++i) {
                const int c = 4 * lane + 256 * i;
                w[i] = *(const f32x4*)(nw + c); sh[i] = *(const f32x4*)(MOD + which * 6144 + shift_idx * 1024 + c); sc[i] = *(const f32x4*)(MOD + which * 6144 + scale_idx * 1024 + c);
                w[i] = w[i] * (sc[i] + 1.f);
            }
        }
        float ss = 0.f;
#pragma unroll
        for (int i = 0; i < 4; ++i) ss += v[i][0] * v[i][0] + v[i][1] * v[i][1] + v[i][2] * v[i][2] + v[i][3] * v[i][3];
        ss = wave_sum(ss);
        const float rinv = rsqrtf(ss * (1.f / 1024.f) + EPS);
#pragma unroll
        for (int i = 0; i < 4; ++i) {
            const f32x4 yv = v[i] * rinv * w[i] + sh[i];
            u32x2 o = {pk2(yv[0], yv[1]), pk2(yv[2], yv[3])};
            *(u32x2*)(dst + (size_t)r * DM + 4 * lane + 256 * i) = o;
        }
    }
}

DI void gdn_prep_unit(const Params& p, int unit, unsigned char* lds) {
    int tid_in = (threadIdx.x & 255); asm volatile("" : "+v"(tid_in));
    const int tid = tid_in, lane = tid & 63, wid = tid >> 6, l15 = lane & 15, quad = lane >> 4;
    const int h = unit & 3, bc = unit >> 2, b = bc / NCK, ck = bc % NCK;
    const bool isctx = ck < 4;
    const int seqlen = isctx ? CTXL : SEQ;
    const int c0 = isctx ? ck * 64 : (ck - 4) * 64;
    const int rowbase = isctx ? (NLAT + b * CTXL) : b * SEQ;
    unsigned char* ws = p.ws;
    const u16* DQ = (const u16*)(ws + OFF_DQKV);
    const float* GT = (const float*)(ws + OFF_GATE);
    u16* Qs = (u16*)lds; u16* Ks = (u16*)(lds + 17408); float* stage = (float*)(lds + 34816);
    float* gs = (float*)(lds + 67840); float* gcs = (float*)(lds + 71936); float* rbs = (float*)(lds + 72448); float* rbe = (float*)(lds + 72960); float* rn = (float*)(lds + 73472);
    u16* QNg = (u16*)(ws + OFF_QN) + (size_t)unit * 8192;
    u16* KNTg = (u16*)(ws + OFF_KNT) + (size_t)unit * 8192;
    __syncthreads();
    {
        const int t = tid >> 2, q4 = tid & 3;
        *(f32x4*)(gs + t * 16 + q4 * 4) = *(const f32x4*)(GT + (size_t)(rowbase + c0 + t) * 16 + q4 * 4);
    }
    const int cch = tid & 127, th = tid >> 7;
    float* part = rbs;
    u32x4 rawreg[5];
    auto raw_fetch = [&](int wh) {
#pragma unroll
        for (int i = 0; i < 5; ++i) {
            const int idx = tid + 256 * i; const int row = idx >> 4, cc = idx & 15, s = c0 - 2 + row;
            u32x4 v = {0u, 0u, 0u, 0u};
            if (idx < 68 * 16 && s >= 0 && s < seqlen) v = *(const u32x4*)(DQ + (size_t)(rowbase + s) * 1536 + wh * 512 + h * 128 + cc * 8);
            rawreg[i] = v;
        }
    };
    raw_fetch(2);
#pragma unroll 1
    for (int wi = 0; wi < 3; ++wi) {
        const int which = wi == 0 ? 2 : wi - 1;
        if (isctx && wi == 1) continue;
        u16* raw = (wi == 0) ? Qs : Ks;
        __syncthreads();
#pragma unroll
        for (int i = 0; i < 5; ++i) {
            const int idx = tid + 256 * i;
            if (idx < 68 * 16) { const int row = idx >> 4, cc = idx & 15; *(u32x4*)(raw + row * 128 + cc * 8) = rawreg[i]; }
        }
        if (wi < 2) raw_fetch((isctx || wi == 1) ? 1 : 0);
        const int col = which * 512 + h * 128 + cch;
        const float w0 = p.conv_w[0 * 1536 + col], w1 = p.conv_w[1 * 1536 + col], w2 = p.conv_w[2 * 1536 + col], w3 = p.conv_w[3 * 1536 + col], w4 = p.conv_w[4 * 1536 + col];
        __syncthreads();
        float y[32];
        {
            const u16* rp = raw + (32 * th) * 128 + cch;
            float xa = bf2f(rp[0]), xb = bf2f(rp[128]), xc = bf2f(rp[256]), xd = bf2f(rp[384]);
#pragma unroll
            for (int i = 0; i < 32; ++i) {
                const float xe = bf2f(rp[(i + 4) * 128]);
                y[i] = silu_f(w0 * xa + w1 * xb + w2 * xc + w3 * xd + w4 * xe);
                xa = xb; xb = xc; xc = xd; xd = xe;
            }
        }
        if (which == 2) {
#pragma unroll
            for (int i = 0; i < 32; ++i) stage[(32 * th + i) * 129 + cch] = y[i];
        } else {
            float mine = 0.f;
#pragma unroll
            for (int i = 0; i < 32; ++i) { const float ssum = wave_sum(y[i] * y[i]); if (lane == i) mine = ssum; }
            if (lane < 32) part[wid * 32 + lane] = mine;
            __syncthreads();
            if (which == 0) {
#pragma unroll
                for (int i = 0; i < 32; ++i) {
                    const int t = 32 * th + i; const float rinv = rsqrtf(part[(2 * th) * 32 + i] + part[(2 * th + 1) * 32 + i] + EPS);
                    const u16 v = f2bf(y[i] * rinv); Qs[t * 136 + cch] = v; QNg[t * 128 + permpos(cch)] = v;
                }
            } else {
                unsigned pkd[16];
#pragma unroll
                for (int i = 0; i < 16; ++i) {
                    const int t = 32 * th + 2 * i;
                    const float r0 = rsqrtf(part[(2 * th) * 32 + 2 * i] + part[(2 * th + 1) * 32 + 2 * i] + EPS), r1 = rsqrtf(part[(2 * th) * 32 + 2 * i + 1] + part[(2 * th + 1) * 32 + 2 * i + 1] + EPS);
                    const unsigned v = pk2(y[2 * i] * r0, y[2 * i + 1] * r1); pkd[i] = v;
                    Ks[t * 136 + cch] = (u16)(v & 0xffffu); Ks[(t + 1) * 136 + cch] = (u16)(v >> 16);
                }
#pragma unroll
                for (int i = 0; i < 4; ++i) { u32x4 v = {pkd[2 * i], pkd[2 * i + 1], pkd[8 + 2 * i], pkd[8 + 2 * i + 1]}; *(u32x4*)(KNTg + cch * 64 + 32 * th + 8 * i) = v; }
            }
        }
    }
    __syncthreads();
    int unit_l = unit, tid_l = tid_in;
    asm volatile("" : "+s"(unit_l)); asm volatile("" : "+v"(tid_l));
    {
    const int unit = unit_l, tid = tid_l, lane = tid & 63, wid = tid >> 6, l15 = lane & 15, quad = lane >> 4;
    if (tid < 128) {
        const int d = tid >> 6, t = tid & 63; float s = 0.f;
        if (d == 0) { for (int u = 0; u <= t; ++u) s += gs[u * 16 + 8 + h]; }
        else        { for (int u = t; u < 64; ++u) s += gs[u * 16 + 12 + h]; }
        gcs[d * 64 + t] = s;
    }
    __syncthreads();
    if (tid < 128) {
        const int d = tid >> 6, t = tid & 63;
        const float gc = gcs[d * 64 + t], gl = gcs[d * 64 + (d ? 0 : 63)], be = gs[t * 16 + d * 4 + h];
        rbs[d * 64 + t] = be; rbe[d * 64 + t] = be * __expf(gc);
        float* SC = (float*)(ws + OFF_SCAL) + ((size_t)d * NCU + unit) * 192;
        SC[t] = __expf(gc) * 0.08838834764831845f; SC[64 + t] = __expf(gl - gc);
        if (t == 0) SC[128] = __expf(gl);
    }
    if (!isctx) {
        f32x4 QK[4];
#pragma unroll
        for (int n = 0; n < 4; ++n) QK[n] = (f32x4){0.f, 0.f, 0.f, 0.f};
#pragma unroll
        for (int ks = 0; ks < 4; ++ks) {
            const bf16x8 aq = *(const bf16x8*)(Qs + (16 * wid + l15) * 136 + 32 * ks + 8 * quad);
#pragma unroll
            for (int n = 0; n < 4; ++n) {
                const bf16x8 bb = *(const bf16x8*)(Ks + (16 * n + l15) * 136 + 32 * ks + 8 * quad);
                QK[n] = MFMA16(aq, bb, QK[n]);
            }
        }
#pragma unroll
        for (int d = 0; d < 2; ++d) {
            u16* INg = (u16*)(ws + OFF_INTRA) + ((size_t)d * NCU + unit) * 4096;
#pragma unroll
            for (int n = 0; n < 4; ++n)
#pragma unroll
                for (int r = 0; r < 4; ++r) {
                    const int i = 16 * wid + 4 * quad + r, j = 16 * n + l15;
                    const bool keep = d ? (j >= i) : (j <= i);
                    const float iv = keep ? QK[n][r] * 0.08838834764831845f * __expf(gcs[d * 64 + i] - gcs[d * 64 + j]) : 0.f;
                    INg[i * 64 + permpos(j)] = f2bf(iv);
                }
        }
    }
    __syncthreads();
    {
        f32x4 G[4];
#pragma unroll
        for (int n = 0; n < 4; ++n) G[n] = (f32x4){0.f, 0.f, 0.f, 0.f};
#pragma unroll
        for (int ks = 0; ks < 4; ++ks) {
            const bf16x8 ak = *(const bf16x8*)(Ks + (16 * wid + l15) * 136 + 32 * ks + 8 * quad);
#pragma unroll
            for (int n = 0; n < 4; ++n) {
                const bf16x8 bb = *(const bf16x8*)(Ks + (16 * n + l15) * 136 + 32 * ks + 8 * quad);
                G[n] = MFMA16(ak, bb, G[n]);
            }
        }
        const int dd = __builtin_amdgcn_readfirstlane(tid >> 7), cc = tid & 127;
        float xwp[64];
#pragma unroll
        for (int ip = 0; ip < 64; ++ip) xwp[ip] = 0.f;
        if (dd == 0) {
#pragma unroll
            for (int ip = 0; ip < 64; ++ip) xwp[ip] = bf2f(Ks[ip * 136 + cc]) * rbe[ip];
        } else {
#pragma unroll
            for (int ip = 0; ip < 64; ++ip) xwp[ip] = bf2f(Ks[(63 - ip) * 136 + cc]) * rbe[64 + 63 - ip];
        }
        asm volatile("" ::: "memory");
        __syncthreads();
        float* Ls0 = (float*)lds; float* Ls1 = (float*)(lds + 17408);
#pragma unroll
        for (int d = 0; d < 2; ++d)
#pragma unroll
            for (int n = 0; n < 4; ++n)
#pragma unroll
                for (int r = 0; r < 4; ++r) {
                    const int i = 16 * wid + 4 * quad + r, j = 16 * n + l15;
                    const int ip = d ? 63 - i : i, jp = d ? 63 - j : j;
                    if (jp < ip) (d ? Ls1 : Ls0)[ip * 64 + jp] = rbs[d * 64 + i] * G[n][r] * __expf(gcs[d * 64 + i] - gcs[d * 64 + j]);
                }
        __syncthreads();
        const float* Lsel = dd ? Ls1 : Ls0;
        f2_t x2[64];
#pragma unroll
        for (int ip = 0; ip < 64; ++ip) x2[ip] = (f2_t){0.f, xwp[ip]};
        if (dd == 0) {
#pragma unroll
            for (int ip = 0; ip < 64; ++ip) x2[ip].x = stage[ip * 129 + cc] * rbs[ip];
        } else {
#pragma unroll
            for (int ip = 0; ip < 64; ++ip) x2[ip].x = stage[(63 - ip) * 129 + cc] * rbs[64 + 63 - ip];
        }
        asm volatile("" ::: "memory");
#pragma unroll
        for (int ip = 0; ip < 64; ++ip) {
            f2_t a2 = x2[ip];
#pragma unroll
            for (int jp = 0; jp < ip; ++jp) { const float l = Lsel[ip * 64 + jp]; a2 -= x2[jp] * l; if ((jp & 7) == 7) asm volatile("" ::: "memory"); }
            x2[ip] = a2;
            asm volatile("" ::: "memory");
        }
        {
            int unit_o = unit, cc_o = cc; asm volatile("" : "+s"(unit_o)); asm volatile("" : "+v"(cc_o));
            u16* WNg = (u16*)(ws + OFF_WNEG) + ((size_t)dd * NCU + unit_o) * 8192 + permpos(cc_o);
#pragma unroll
            for (int ip = 0; ip < 1; ++ip) {}
            if (dd == 0) {
#pragma unroll
                for (int ip = 0; ip < 64; ++ip) { WNg[ip * 128] = f2bf(-x2[ip].y); if ((ip & 7) == 7) asm volatile("" ::: "memory"); }
            } else {
#pragma unroll
                for (int ip = 0; ip < 64; ++ip) { WNg[(63 - ip) * 128] = f2bf(-x2[ip].y); if ((ip & 7) == 7) asm volatile("" ::: "memory"); }
            }
            asm volatile("" ::: "memory");
            u16* UTg = (u16*)(ws + OFF_UT) + ((size_t)dd * NCU + unit_o) * 8192 + cc_o * 64;
            if (dd == 0) {
#pragma unroll
                for (int i = 0; i < 8; ++i) { u32x4 v = {pk2(x2[8 * i].x, x2[8 * i + 1].x), pk2(x2[8 * i + 2].x, x2[8 * i + 3].x), pk2(x2[8 * i + 4].x, x2[8 * i + 5].x), pk2(x2[8 * i + 6].x, x2[8 * i + 7].x)}; *(u32x4*)(UTg + 8 * i) = v; }
            } else {
#pragma unroll
                for (int i = 0; i < 8; ++i) { u32x4 v = {pk2(x2[63 - 8 * i].x, x2[62 - 8 * i].x), pk2(x2[61 - 8 * i].x, x2[60 - 8 * i].x), pk2(x2[59 - 8 * i].x, x2[58 - 8 * i].x), pk2(x2[57 - 8 * i].x, x2[56 - 8 * i].x)}; *(u32x4*)(UTg + 8 * i) = v; }
            }
        }
        __syncthreads();
    }
    }
}

DI void gdn_scan_block(const Params& p, int sb, unsigned char* lds0, unsigned char* lds1, int role) {
    const int tid = (threadIdx.x & 255), lane = tid & 63, wid = tid >> 6, l15 = lane & 15, quad = lane >> 4;
    const int chain = sb >> 1, half = sb & 1, b = chain >> 3, h = (chain >> 1) & 3, d = chain & 1, slice = half * 4 + wid;
    unsigned char* ws = p.ws;
    if (role == 1) {
        u32x4 pre[16]; float presc = 0.f;
        auto issue = [&](int step) {
            const int ck = d ? (step < 4 ? 3 - step : 135 - step) : step;
            const size_t cu = (size_t)(b * NCK + ck) * 4 + h, dcu = (size_t)d * NCU + cu;
            const u32x4* WN = (const u32x4*)(ws + OFF_WNEG + dcu * 16384);
            const u32x4* QN = (const u32x4*)(ws + OFF_QN + cu * 16384);
            const u32x4* KT = (const u32x4*)(ws + OFF_KNT + cu * 16384);
            const u32x4* IN = (const u32x4*)(ws + OFF_INTRA + dcu * 8192);
            const u32x4* UT = (const u32x4*)(ws + OFF_UT + dcu * 16384 + (size_t)half * 8192);
            const float* SC = (const float*)(ws + OFF_SCAL) + dcu * 192;
#pragma unroll
            for (int i = 0; i < 4; ++i) { pre[i] = WN[tid + 256 * i]; pre[4 + i] = QN[tid + 256 * i]; pre[8 + i] = KT[tid + 256 * i]; }
#pragma unroll
            for (int i = 0; i < 2; ++i) { pre[12 + i] = IN[tid + 256 * i]; pre[14 + i] = UT[tid + 256 * i]; }
            if (tid < 192) presc = SC[tid];
        };
        auto commit = [&](unsigned char* L) {
#pragma unroll
            for (int i = 0; i < 4; ++i) {
                const int r16 = (tid >> 4) + 16 * i, c16 = tid & 15;
                *(u32x4*)(L + r16 * 272 + c16 * 16) = pre[i];
                *(u32x4*)(L + 17408 + r16 * 272 + c16 * 16) = pre[4 + i];
                const int r8 = (tid >> 3) + 32 * i, c8 = tid & 7;
                *(u32x4*)(L + 34816 + r8 * 144 + c8 * 16) = pre[8 + i];
            }
#pragma unroll
            for (int i = 0; i < 2; ++i) {
                const int r8 = (tid >> 3) + 32 * i, c8 = tid & 7;
                *(u32x4*)(L + 53248 + r8 * 144 + c8 * 16) = pre[12 + i];
                *(u32x4*)(L + 62464 + r8 * 144 + c8 * 16) = pre[14 + i];
            }
            if (tid < 192) ((float*)(L + 71680))[tid] = presc;
        };
        issue(0); commit(lds0); issue(1);
        __syncthreads();
        for (int step = 0; step < NCK; ++step) {
            if (step + 1 < NCK) { commit(((step + 1) & 1) ? lds1 : lds0); if (step + 2 < NCK) issue(step + 2); }
            __syncthreads();
        }
        return;
    }
    f32x4 S[8];
#pragma unroll
    for (int i = 0; i < 8; ++i) S[i] = (f32x4){0.f, 0.f, 0.f, 0.f};
    u16* Og = (u16*)(ws + OFF_O01) + (size_t)d * NLAT * 512;
    __syncthreads();
    for (int step = 0; step < NCK; ++step) {
        const int ck = d ? (step < 4 ? 3 - step : 135 - step) : step;
        const bool isctx = ck < 4;
        const unsigned char* L = (step & 1) ? lds1 : lds0;
        const u16* WNl = (const u16*)L; const u16* QNl = (const u16*)(L + 17408); const u16* KTl = (const u16*)(L + 34816); const u16* INl = (const u16*)(L + 53248); const u16* UTl = (const u16*)(L + 62464); const float* SCl = (const float*)(L + 71680);
        bf16x8 Sb[4];
#pragma unroll
        for (int ks = 0; ks < 4; ++ks) Sb[ks] = mk8(pk2(S[2 * ks][0], S[2 * ks][1]), pk2(S[2 * ks][2], S[2 * ks][3]), pk2(S[2 * ks + 1][0], S[2 * ks + 1][1]), pk2(S[2 * ks + 1][2], S[2 * ks + 1][3]));
        f32x4 vn[4], o[4];
#pragma unroll
        for (int mt = 0; mt < 4; ++mt) {
            const u32x2 raw = *(const u32x2*)(UTl + (16 * wid + l15) * 72 + 16 * mt + 4 * quad);
            vn[mt] = (f32x4){bflo(raw.x), bfhi(raw.x), bflo(raw.y), bfhi(raw.y)};
#pragma unroll
            for (int ks = 0; ks < 4; ++ks) {
                const bf16x8 a = *(const bf16x8*)(WNl + (16 * mt + l15) * 136 + 32 * ks + 8 * quad);
                vn[mt] = MFMA16(a, Sb[ks], vn[mt]);
            }
        }
        if (!isctx) {
#pragma unroll
            for (int mt = 0; mt < 4; ++mt) {
                o[mt] = (f32x4){0.f, 0.f, 0.f, 0.f};
#pragma unroll
                for (int ks = 0; ks < 4; ++ks) {
                    const bf16x8 a = *(const bf16x8*)(QNl + (16 * mt + l15) * 136 + 32 * ks + 8 * quad);
                    o[mt] = MFMA16(a, Sb[ks], o[mt]);
                }
                const f32x4 qs = *(const f32x4*)(SCl + 16 * mt + 4 * quad);
                o[mt] = o[mt] * qs;
            }
        }
        bf16x8 vb[2], vsb[2];
        {
            f32x4 kc[4];
#pragma unroll
            for (int mt = 0; mt < 4; ++mt) kc[mt] = *(const f32x4*)(SCl + 64 + 16 * mt + 4 * quad);
#pragma unroll
            for (int k2 = 0; k2 < 2; ++k2) {
                const f32x4 a = vn[2 * k2], c = vn[2 * k2 + 1];
                vb[k2] = mk8(pk2(a[0], a[1]), pk2(a[2], a[3]), pk2(c[0], c[1]), pk2(c[2], c[3]));
                const f32x4 as = a * kc[2 * k2], cs = c * kc[2 * k2 + 1];
                vsb[k2] = mk8(pk2(as[0], as[1]), pk2(as[2], as[3]), pk2(cs[0], cs[1]), pk2(cs[2], cs[3]));
            }
        }
        const float egl = SCl[128];
#pragma unroll
        for (int st = 0; st < 8; ++st) {
            S[st] = S[st] * egl;
#pragma unroll
            for (int k2 = 0; k2 < 2; ++k2) {
                const bf16x8 a = *(const bf16x8*)(KTl + (16 * st + l15) * 72 + 32 * k2 + 8 * quad);
                S[st] = MFMA16(a, vsb[k2], S[st]);
            }
        }
        if (!isctx) {
            const int tok0 = b * SEQ + (ck - 4) * 64;
#pragma unroll
            for (int mt = 0; mt < 4; ++mt) {
#pragma unroll
                for (int k2 = 0; k2 < 2; ++k2) {
                    const bf16x8 a = *(const bf16x8*)(INl + (16 * mt + l15) * 72 + 32 * k2 + 8 * quad);
                    o[mt] = MFMA16(a, vb[k2], o[mt]);
                }
#pragma unroll
                for (int r = 0; r < 4; ++r) Og[(size_t)(tok0 + 16 * mt + 4 * quad + r) * 512 + h * 128 + 16 * slice + l15] = f2bf(o[mt][r]);
            }
        }
        __syncthreads();
    }
}

DI void attn_unit(const Params& p, int P, int half, unsigned char* lds, float Mb) {
    const int tid = (threadIdx.x & 255), lane = tid & 63, wid = tid >> 6, l31 = lane & 31, hh = lane >> 5;
    const int kh = P & 3, qb = 2 * ((P >> 2) & 63) + half, bk = P >> 8, b = bk >> 1, kvh = bk & 1, head = kvh * 4 + wid;
    unsigned char* ws = p.ws;
    const u16* MIX = (const u16*)(ws + OFF_MIX);
    constexpr int NT = SKV / 64 / 4;
    const u16* Kg = (const u16*)(ws + OFF_K) + (size_t)bk * SKV * 64 + (size_t)kh * NT * 64 * 64;
    const u16* Vg = (const u16*)(ws + OFF_VT) + (size_t)bk * 64 * SKV + (size_t)kh * NT * 64;
    u16* Kl = (u16*)lds; u16* Vl = (u16*)(lds + 36864);
    const int tokA = b * SEQ + qb * 64 + l31;
    const size_t qrowA = (size_t)tokA * DM + head * 64, qrowB = qrowA + (size_t)32 * DM;
    bf16x8 qfA[4], qfB[4];
#pragma unroll
    for (int ks = 0; ks < 4; ++ks) { qfA[ks] = *(const bf16x8*)(MIX + qrowA + 16 * ks + 8 * hh); qfB[ks] = *(const bf16x8*)(MIX + qrowB + 16 * ks + 8 * hh); }
    f32x16 o0A, o1A, laA, o0B, o1B, laB;
#pragma unroll
    for (int i = 0; i < 16; ++i) { o0A[i] = 0.f; o1A[i] = 0.f; laA[i] = 0.f; o0B[i] = 0.f; o1B[i] = 0.f; laB[i] = 0.f; }
    const bf16x8 ones = mk8(0x3f803f80u, 0x3f803f80u, 0x3f803f80u, 0x3f803f80u);
    int t5_ = (int)threadIdx.x; asm volatile("" : "+v"(t5_));
    const int lrow = t5_ >> 3, lcc = t5_ & 7;
    u32x4 rk, rv;
    rk = *(const u32x4*)(Kg + (size_t)lrow * 64 + lcc * 8); rv = *(const u32x4*)(Vg + (size_t)lrow * SKV + lcc * 8);
    __syncthreads();
    *(u32x4*)(Kl + lrow * 72 + lcc * 8) = rk; *(u32x4*)(Vl + lrow * 72 + lcc * 8) = rv;
    rk = *(const u32x4*)(Kg + (size_t)(64 + lrow) * 64 + lcc * 8); rv = *(const u32x4*)(Vg + (size_t)lrow * SKV + 64 + lcc * 8);
    __syncthreads();
    for (int kt = 0; kt < NT; ++kt) {
        const u16* Kc = Kl + (kt & 1) * 9216; const u16* Vc = Vl + (kt & 1) * 9216;
        if (kt + 1 < NT) {
            u16* Kn = Kl + ((kt + 1) & 1) * 9216; u16* Vn = Vl + ((kt + 1) & 1) * 9216;
            *(u32x4*)(Kn + lrow * 72 + lcc * 8) = rk; *(u32x4*)(Vn + lrow * 72 + lcc * 8) = rv;
        }
        if (kt + 2 < NT) { rk = *(const u32x4*)(Kg + (size_t)((kt + 2) * 64 + lrow) * 64 + lcc * 8); rv = *(const u32x4*)(Vg + (size_t)lrow * SKV + (kt + 2) * 64 + lcc * 8); }
#pragma unroll
        for (int sub = 0; sub < 2; ++sub) {
            f32x16 sA, sB;
#pragma unroll
            for (int i = 0; i < 16; ++i) { sA[i] = -Mb; sB[i] = -Mb; }
#pragma unroll
            for (int ks = 0; ks < 4; ++ks) {
                const bf16x8 kf = *(const bf16x8*)(Kc + (sub * 32 + l31) * 72 + 16 * ks + 8 * hh);
                sA = MFMA32(kf, qfA[ks], sA); sB = MFMA32(kf, qfB[ks], sB);
            }
#pragma unroll
            for (int i = 0; i < 16; ++i) { sA[i] = __builtin_amdgcn_exp2f(sA[i]); sB[i] = __builtin_amdgcn_exp2f(sB[i]); }
#pragma unroll
            for (int sp = 0; sp < 2; ++sp) {
                const bf16x8 pA = mk8(pk2(sA[8 * sp], sA[8 * sp + 1]), pk2(sA[8 * sp + 2], sA[8 * sp + 3]), pk2(sA[8 * sp + 4], sA[8 * sp + 5]), pk2(sA[8 * sp + 6], sA[8 * sp + 7]));
                const bf16x8 pB = mk8(pk2(sB[8 * sp], sB[8 * sp + 1]), pk2(sB[8 * sp + 2], sB[8 * sp + 3]), pk2(sB[8 * sp + 4], sB[8 * sp + 5]), pk2(sB[8 * sp + 6], sB[8 * sp + 7]));
                const u16* v0 = Vc + l31 * 72 + sub * 32 + 16 * sp + 4 * hh;
                const bf16x8 vf0 = mk8(*(const u32x2*)v0, *(const u32x2*)(v0 + 8));
                const bf16x8 vf1 = mk8(*(const u32x2*)(v0 + 32 * 72), *(const u32x2*)(v0 + 32 * 72 + 8));
                o0A = MFMA32(vf0, pA, o0A); o0B = MFMA32(vf0, pB, o0B); o1A = MFMA32(vf1, pA, o1A); o1B = MFMA32(vf1, pB, o1B);
                laA = MFMA32(ones, pA, laA); laB = MFMA32(ones, pB, laB);
            }
        }
        __syncthreads();
    }
    float* LP = (float*)(ws + OFF_LP) + (size_t)kh * NLAT * 8;
    if (hh == 0) { LP[(size_t)tokA * 8 + head] = laA[0]; LP[(size_t)(tokA + 32) * 8 + head] = laB[0]; }
    u16* OPA = (u16*)p.out + (size_t)kh * NLAT * 512 + (size_t)tokA * 512 + head * 64;
    u16* OPB = OPA + (size_t)32 * 512;
#pragma unroll
    for (int g = 0; g < 4; ++g) {
        { u32x2 w0 = {pk2(o0A[4 * g], o0A[4 * g + 1]), pk2(o0A[4 * g + 2], o0A[4 * g + 3])}; u32x2 w1 = {pk2(o1A[4 * g], o1A[4 * g + 1]), pk2(o1A[4 * g + 2], o1A[4 * g + 3])};
          *(u32x2*)(OPA + 8 * g + 4 * hh) = w0; *(u32x2*)(OPA + 32 + 8 * g + 4 * hh) = w1; }
        { u32x2 w0 = {pk2(o0B[4 * g], o0B[4 * g + 1]), pk2(o0B[4 * g + 2], o0B[4 * g + 3])}; u32x2 w1 = {pk2(o1B[4 * g], o1B[4 * g + 1]), pk2(o1B[4 * g + 2], o1B[4 * g + 3])};
          *(u32x2*)(OPB + 8 * g + 4 * hh) = w0; *(u32x2*)(OPB + 32 + 8 * g + 4 * hh) = w1; }
    }
}

namespace pg8 {
#define PG8_LAS __attribute__((address_space(3)))
typedef unsigned short bf16_t;
typedef short bf16x8 __attribute__((ext_vector_type(8)));
typedef float f32x4 __attribute__((ext_vector_type(4)));
typedef unsigned u32x4 __attribute__((ext_vector_type(4)));
constexpr int BM = 256, BK = 64, HALF = 128, HTB = HALF * BK * 2  , STAGE_BYTES = 8 * HTB, NXCD = 8, WGM = 8;

__host__ __device__ __forceinline__ int lds_byte(int r, int c) { const int st = (r >> 4) * 2 + (c >> 5), rr = r & 15, cc = c & 31, ob = rr * 64 + cc * 2; return st * 1024 + (ob ^ (((ob >> 9) & 1) << 5)); }
__host__ __device__ __forceinline__ void stage_rc(int b, int& R, int& C) { const int st = b / 1024, sb = b % 1024, swz = sb ^ (((sb >> 9) & 1) << 5); R = (st >> 1) * 16 + swz / 64; C = (st & 1) * 32 + (swz % 64) / 2; }
__host__ __device__ __forceinline__ int perm32(int rho) { const int n = rho >> 4, i = rho & 15; return 8 * (i >> 2) + 4 * n + (i & 3); }

struct Unit { int pm, pn; };
struct Gemm { const bf16_t* A; const bf16_t* Bt; int M, N, K; };

struct StaticOrder {
    int nM, nN, nwg, G, c;
    __host__ __device__ void init(int M, int N, int G_, int c_) { nM = M / BM; nN = N / BM; nwg = nM * nN; G = G_; c = c_; }
    __host__ __device__ bool next(int i, Unit& u) const {
        const long L = (long)i * G + c; if (L >= nwg) return false;
        int wgid = (int)L; { const int q = nwg / NXCD, r = nwg % NXCD, xcd = wgid % NXCD, off = wgid / NXCD; wgid = (xcd < r ? xcd * (q + 1) : r * (q + 1) + (xcd - r) * q) + off; }
        const int nig = WGM * nN, gid = wgid / nig, fm = gid * WGM, gsz = (nM - fm) < WGM ? (nM - fm) : WGM;
        u.pm = fm + ((wgid % nig) % gsz); u.pn = (wgid % nig) / gsz; return true;
    }
    __device__ __forceinline__ void a_ready(const Unit&) const {}
    __device__ __forceinline__ void done(const Unit&) const {}
};


template <class Epi, class Sched, bool ALIGN_EPI = false, bool SP2 = false>
__device__ __forceinline__ void gemm_phase(PG8_LAS unsigned char* lds, const Gemm g, const Sched& S, const Epi& E) {
    const int tid = threadIdx.x, wid = __builtin_amdgcn_readfirstlane(tid >> 6), lane = tid & 63, wr = wid >> 2, wc = wid & 3, fr = lane & 15, fq = lane >> 4;
    const int K = g.K, nt = K / BK;
    unsigned voffA[2], voffB[2];
#pragma unroll
    for (int i = 0; i < 2; ++i) { int R, C; stage_rc(tid * 16 + i * 8192, R, C); const int Rb = Epi::PERM ? ((R & ~31) + perm32(R & 31)) : R;
        voffA[i] = (unsigned)(R * K + C) * 2u; voffB[i] = (unsigned)(Rb * K + C) * 2u; }
    const size_t kstep = (size_t)(BK * 2);
    const size_t hstep = (size_t)HALF * K * 2;
    const size_t tstep = 2 * hstep;
    const unsigned ldsw = (unsigned)wid * 1024u;
    const int aoff = lds_byte(wr * 64 + fr, fq * 8), boff = lds_byte(wc * 32 + fr, fq * 8);
#define PG8_SA(b, h) (((b) * 2 + (h)) * HTB)
#define PG8_SB(b, h) ((4 + (b) * 2 + (h)) * HTB)
#define PG8_STAGE(bufoff, gbase, voff) do { _Pragma("unroll") for (int _i = 0; _i < 2; ++_i) \
        __builtin_amdgcn_global_load_lds((const unsigned*)((const char*)(gbase) + (voff)[_i]), (PG8_LAS unsigned*)(lds + (bufoff) + ldsw + _i * 8192), 16, 0, 0); } while (0)
#define PG8_LDA(dst, b, h) do { _Pragma("unroll") for (int m = 0; m < 4; ++m) _Pragma("unroll") for (int k = 0; k < 2; ++k) dst[m][k] = *(const PG8_LAS bf16x8*)(lds + PG8_SA(b, h) + aoff + m * 2048 + k * 1024); } while (0)
#define PG8_LDB(dst, b, h) do { _Pragma("unroll") for (int n = 0; n < 2; ++n) _Pragma("unroll") for (int k = 0; k < 2; ++k) dst[n][k] = *(const PG8_LAS bf16x8*)(lds + PG8_SB(b, h) + boff + n * 2048 + k * 1024); } while (0)
#define PG8_MMA(ai, bj, At, Bt) do { __builtin_amdgcn_s_setprio(1); _Pragma("unroll") for (int m = 0; m < 4; ++m) _Pragma("unroll") for (int n = 0; n < 2; ++n) _Pragma("unroll") for (int k = 0; k < 2; ++k) \
        acc[ai][bj][m][n] = __builtin_amdgcn_mfma_f32_16x16x32_bf16(Bt[n][k], At[m][k], acc[ai][bj][m][n], 0, 0, 0); __builtin_amdgcn_s_setprio(0); } while (0)
#define PG8_WAIT_V(n) asm volatile("s_waitcnt vmcnt(" #n ")" ::: "memory")
#define PG8_WAIT_L(n) asm volatile("s_waitcnt lgkmcnt(" #n ")" ::: "memory")
#define PG8_BAR __builtin_amdgcn_s_barrier()
#define PG8_SCHED __builtin_amdgcn_sched_barrier(0)
    Unit cur, nxt; int ui = 0;
    if (!S.next(0, cur)) return;
    f32x4 acc[2][2][4][2];
#pragma unroll
    for (int a = 0; a < 2; ++a)
#pragma unroll
        for (int b = 0; b < 2; ++b)
#pragma unroll
            for (int m = 0; m < 4; ++m)
#pragma unroll
                for (int n = 0; n < 2; ++n) acc[a][b][m][n] = (f32x4){0.f, 0.f, 0.f, 0.f};
    bf16x8 At[4][2], B0[2][2], B1[2][2];
    const char* cA = (const char*)g.A + (size_t)cur.pm * tstep; const char* cB = (const char*)g.Bt + (size_t)cur.pn * tstep;
    S.a_ready(cur);
    if constexpr (SP2) {
        PG8_STAGE(PG8_SB(0, 0), cB, voffB); PG8_STAGE(PG8_SB(0, 1), cB + hstep, voffB); PG8_STAGE(PG8_SA(0, 0), cA, voffA); PG8_STAGE(PG8_SA(0, 1), cA + hstep, voffA);
        if (wr == 1) PG8_BAR;
        PG8_WAIT_V(2); PG8_BAR;
        PG8_STAGE(PG8_SB(1, 0), cB + kstep, voffB); PG8_STAGE(PG8_SA(1, 0), cA + kstep, voffA); PG8_STAGE(PG8_SB(1, 1), cB + hstep + kstep, voffB);
        PG8_WAIT_V(6); PG8_BAR;
    } else {
        PG8_STAGE(PG8_SB(0, 0), cB, voffB); PG8_STAGE(PG8_SA(0, 0), cA, voffA); PG8_STAGE(PG8_SB(0, 1), cB + hstep, voffB); PG8_STAGE(PG8_SA(0, 1), cA + hstep, voffA);
        if (wr == 1) PG8_BAR;
        PG8_WAIT_V(4); PG8_BAR;
        PG8_STAGE(PG8_SB(1, 0), cB + kstep, voffB); PG8_STAGE(PG8_SA(1, 0), cA + kstep, voffA); PG8_STAGE(PG8_SB(1, 1), cB + hstep + kstep, voffB);
        PG8_WAIT_V(6); PG8_BAR;
    }
    for (;;) {
        const bool has_next = S.next(ui + 1, nxt);
        const char* nA = has_next ? (const char*)g.A + (size_t)nxt.pm * tstep : cA; const char* nB = has_next ? (const char*)g.Bt + (size_t)nxt.pn * tstep : cB;
        for (int t = 0; t < nt; t += 2) {
            const bool last = (t == nt - 2);
            const char* a1 = cA + (size_t)(t + 1) * kstep;
            const char* a2 = last ? nA : cA + (size_t)(t + 2) * kstep; const char* b2 = last ? nB : cB + (size_t)(t + 2) * kstep;
            const char* a3 = a2 + kstep; const char* b3 = b2 + kstep;
            if (last && has_next) S.a_ready(nxt);
            if constexpr (SP2) {
            PG8_LDB(B0, 0, 0); PG8_LDB(B1, 0, 1); PG8_SCHED; PG8_LDA(At, 0, 0); PG8_STAGE(PG8_SA(1, 1), a1 + hstep, voffA);
            PG8_WAIT_V(8); PG8_WAIT_L(0); PG8_BAR; PG8_MMA(0, 0, At, B0); PG8_MMA(0, 1, At, B1); PG8_BAR; PG8_SCHED;
            PG8_LDA(At, 0, 1); PG8_STAGE(PG8_SB(0, 0), b2, voffB); PG8_STAGE(PG8_SB(0, 1), b2 + hstep, voffB); PG8_STAGE(PG8_SA(0, 0), a2, voffA);
            PG8_WAIT_V(8); PG8_WAIT_L(0); PG8_BAR; PG8_MMA(1, 0, At, B0); PG8_MMA(1, 1, At, B1); PG8_BAR; PG8_SCHED;
            PG8_LDB(B0, 1, 0); PG8_LDB(B1, 1, 1); PG8_SCHED; PG8_LDA(At, 1, 0); PG8_STAGE(PG8_SA(0, 1), a2 + hstep, voffA);
            PG8_WAIT_V(8); PG8_WAIT_L(0); PG8_BAR; PG8_MMA(0, 0, At, B0); PG8_MMA(0, 1, At, B1); PG8_BAR; PG8_SCHED;
            PG8_LDA(At, 1, 1); PG8_STAGE(PG8_SB(1, 0), b3, voffB); PG8_STAGE(PG8_SB(1, 1), b3 + hstep, voffB); PG8_STAGE(PG8_SA(1, 0), a3, voffA);
            PG8_WAIT_V(8); PG8_WAIT_L(0); PG8_BAR; PG8_MMA(1, 0, At, B0); PG8_MMA(1, 1, At, B1); PG8_BAR; PG8_SCHED;
            } else {
            PG8_LDB(B0, 0, 0); PG8_SCHED; PG8_LDA(At, 0, 0); PG8_STAGE(PG8_SA(1, 1), a1 + hstep, voffA);
            PG8_WAIT_L(8); PG8_BAR; PG8_WAIT_L(0); PG8_MMA(0, 0, At, B0); PG8_BAR; PG8_SCHED;
            PG8_LDB(B1, 0, 1); PG8_STAGE(PG8_SB(0, 0), b2, voffB);
            PG8_BAR; PG8_WAIT_L(0); PG8_MMA(0, 1, At, B1); PG8_BAR;
            PG8_LDA(At, 0, 1); PG8_STAGE(PG8_SA(0, 0), a2, voffA);
            PG8_BAR; PG8_WAIT_L(0); PG8_MMA(1, 0, At, B0); PG8_BAR; PG8_SCHED;
            PG8_STAGE(PG8_SB(0, 1), b2 + hstep, voffB);
            PG8_WAIT_V(6); PG8_BAR; PG8_MMA(1, 1, At, B1); PG8_BAR;
            PG8_LDB(B0, 1, 0); PG8_SCHED; PG8_LDA(At, 1, 0); PG8_STAGE(PG8_SA(0, 1), a2 + hstep, voffA);
            PG8_WAIT_L(8); PG8_BAR; PG8_WAIT_L(0); PG8_MMA(0, 0, At, B0); PG8_BAR; PG8_SCHED;
            PG8_LDB(B1, 1, 1); PG8_STAGE(PG8_SB(1, 0), b3, voffB);
            PG8_BAR; PG8_WAIT_L(0); PG8_MMA(0, 1, At, B1); PG8_BAR;
            PG8_LDA(At, 1, 1); PG8_STAGE(PG8_SA(1, 0), a3, voffA);
            PG8_BAR; PG8_WAIT_L(0); PG8_MMA(1, 0, At, B0); PG8_BAR; PG8_SCHED;
            PG8_STAGE(PG8_SB(1, 1), b3 + hstep, voffB);
            PG8_WAIT_V(6); PG8_BAR; PG8_MMA(1, 1, At, B1); PG8_BAR;
            }
        }
        if constexpr (ALIGN_EPI) { if (wr == 0) PG8_BAR; }
        if constexpr (!Epi::AFTER_DRAIN) { E(acc, cur, wr, wc, fr, fq); S.done(cur); }
        if (!has_next) break;
#pragma unroll
        for (int a = 0; a < 2; ++a)
#pragma unroll
            for (int b = 0; b < 2; ++b)
#pragma unroll
                for (int m = 0; m < 4; ++m)
#pragma unroll
                    for (int n = 0; n < 2; ++n) acc[a][b][m][n] = (f32x4){0.f, 0.f, 0.f, 0.f};
        cur = nxt; cA = nA; cB = nB; ++ui;
        if constexpr (ALIGN_EPI) { if (wr == 1) PG8_BAR; }
    }
    PG8_WAIT_V(0);
    if constexpr (!ALIGN_EPI) { if (wr == 0) PG8_BAR; }
    PG8_BAR;
    if constexpr (Epi::AFTER_DRAIN) { E.fused(acc, cur, wr, wc, fr, fq, lds, wid, lane); S.done(cur); }
#undef PG8_SA
#undef PG8_SB
#undef PG8_STAGE
#undef PG8_LDA
#undef PG8_LDB
#undef PG8_MMA
#undef PG8_WAIT_V
#undef PG8_WAIT_L
#undef PG8_BAR
#undef PG8_SCHED
}

struct EpiRelu2 {
    static constexpr bool PERM = true, AFTER_DRAIN = false;
    bf16_t* O; int ldc;
    __device__ __forceinline__ void operator()(const f32x4 (&acc)[2][2][4][2], const Unit& u, int wr, int wc, int fr, int fq) const {
#pragma unroll
        for (int ai = 0; ai < 2; ++ai)
#pragma unroll
            for (int m = 0; m < 4; ++m) {
                bf16_t* rowp = O + (size_t)(u.pm * BM + ai * HALF + wr * 64 + m * 16 + fr) * ldc + u.pn * BM + wc * 32 + 8 * fq;
#pragma unroll
                for (int bj = 0; bj < 2; ++bj) {
                    f32x4 v0 = acc[ai][bj][m][0], v1 = acc[ai][bj][m][1];
#pragma unroll
                    for (int r = 0; r < 4; ++r) { const float a = fmaxf(v0[r], 0.f); v0[r] = a * a; const float c = fmaxf(v1[r], 0.f); v1[r] = c * c; }
                    u32x4 w = {::pk2(v0[0], v0[1]), ::pk2(v0[2], v0[3]), ::pk2(v1[0], v1[1]), ::pk2(v1[2], v1[3])};
                    *(u32x4*)(rowp + bj * HALF) = w;
                }
            }
    }
};
struct EpiGatedRes {
    static constexpr bool PERM = true, AFTER_DRAIN = false;
    const float* base; float* out; const float* gate; int gate_bstride; int ldc;
    __device__ __forceinline__ void operator()(const f32x4 (&acc)[2][2][4][2], const Unit& u, int wr, int wc, int fr, int fq) const {
        const float* g = gate + ((u.pm * BM) >> 13) * gate_bstride;
        const int col0 = u.pn * BM + wc * 32 + 8 * fq;
        f32x4 gv[2][2];
#pragma unroll
        for (int bj = 0; bj < 2; ++bj)
#pragma unroll
            for (int n = 0; n < 2; ++n) gv[bj][n] = *(const f32x4*)(g + col0 + bj * HALF + n * 4);
#pragma unroll
        for (int ai = 0; ai < 2; ++ai)
#pragma unroll
            for (int m = 0; m < 4; ++m) {
                const size_t off = (size_t)(u.pm * BM + ai * HALF + wr * 64 + m * 16 + fr) * ldc + col0;
#pragma unroll
                for (int bj = 0; bj < 2; ++bj)
#pragma unroll
                    for (int n = 0; n < 2; ++n) {
                        const f32x4 xv = *(const f32x4*)(base + off + bj * HALF + n * 4);
                        *(f32x4*)(out + off + bj * HALF + n * 4) = xv + gv[bj][n] * acc[ai][bj][m][n];
                    }
            }
    }
};
struct EpiInProj {
    static constexpr bool PERM = true, AFTER_DRAIN = false;
    bf16_t* MIX; bf16_t* Kb; bf16_t* Vt; bf16_t* DQ; float* GT; const float* a_log; const float* dt_bias;
    __device__ __forceinline__ void operator()(const f32x4 (&acc)[2][2][4][2], const Unit& u, int wr, int wc, int fr, int fq) const {
        const int pn = u.pn; const bool lat = u.pm < 64;
#pragma unroll
        for (int ai = 0; ai < 2; ++ai)
#pragma unroll
            for (int m = 0; m < 4; ++m) {
                const int gr = u.pm * BM + ai * HALF + wr * 64 + m * 16 + fr;
                int bb, kvpos;
                if (lat) { bb = gr >> 13; kvpos = 256 + (gr & 8191); } else { const int cr = gr - 16384; bb = cr >> 8; kvpos = cr & 255; }
#pragma unroll
                for (int bj = 0; bj < 2; ++bj) {
                    const int cl = bj * HALF + wc * 32 + 8 * fq;
                    const f32x4 v0 = acc[ai][bj][m][0], v1 = acc[ai][bj][m][1];
                    const u32x4 w = {::pk2(v0[0], v0[1]), ::pk2(v0[2], v0[3]), ::pk2(v1[0], v1[1]), ::pk2(v1[2], v1[3])};
                    if (pn < 2) { if (lat) *(u32x4*)(MIX + (size_t)gr * 1024 + pn * 256 + cl) = w; }
                    else if (pn == 2) {
                        if (bj == 0) { const int kvh = cl >> 6, d = cl & 63; *(u32x4*)(Kb + ((size_t)(bb * 2 + kvh) * 8448 + kvpos) * 64 + d) = w; }
                        else { const int c2 = cl - HALF, kvh = c2 >> 6, d = c2 & 63; bf16_t* vp = Vt + ((size_t)(bb * 2 + kvh) * 64 + d) * 8448 + kvpos;
#pragma unroll
                            for (int e = 0; e < 4; ++e) { vp[(2 * e) * 8448] = (bf16_t)(w[e] & 0xffffu); vp[(2 * e + 1) * 8448] = (bf16_t)(w[e] >> 16); } }
                    }
                    else if (pn < 9) *(u32x4*)(DQ + (size_t)gr * 1536 + (pn - 3) * 256 + cl) = w;
                    else { if (lat) *(u32x4*)(MIX + (size_t)gr * 1024 + 512 + (pn - 9) * 256 + cl) = w; }
                }
            }
    }
};
}

#define XB_TMO      128
#define XB_XCNT(j)  (256  + 64 * (j))
#define XB_XSUB(j)  (1280 + 64 * (j))
#define XB_XGEN(j)  (2304 + 64 * (j))
#define XB_TOP      3328
#define XB_TOPGEN   3392
#define XCD_BAR_WORDS 3456
#define XB_SPIN_CAP (1u << 22)
#define LAS __attribute__((address_space(3)))
DI unsigned xb_ld(unsigned* p)              { return __hip_atomic_load(p, __ATOMIC_RELAXED, __HIP_MEMORY_SCOPE_AGENT); }
DI unsigned xb_add(unsigned* p, unsigned v) { return __hip_atomic_fetch_add(p, v, __ATOMIC_RELAXED, __HIP_MEMORY_SCOPE_AGENT); }
DI unsigned xb_xcc_id() { return (unsigned)__builtin_amdgcn_s_getreg((3 << 11) | 20) & 0xFu; }
#define XB_SPIN(cond, bar) do { unsigned _sp = 0; while (cond) { __builtin_amdgcn_s_sleep(1); \
    if ((++_sp & 255u) == 0u) { if (xb_ld(&(bar)[XB_TMO])) break; if (_sp > XB_SPIN_CAP) { atomicAdd(&(bar)[XB_TMO], 1u); break; } } } } while (0)
struct XcdBarrier { unsigned* bar; unsigned x; volatile LAS unsigned* st; };
DI XcdBarrier xcd_barrier_post(unsigned* bar, volatile LAS unsigned* st) {
    XcdBarrier b; b.bar = bar; b.x = xb_xcc_id(); b.st = st;
    if (threadIdx.x == 0) (void)xb_add(&bar[XB_XCNT(b.x)], 1u);
    return b;
}
DI void xcd_barrier_complete(unsigned* bar, unsigned x, unsigned& nloc, unsigned& nx) {
    const unsigned G = gridDim.x * gridDim.y * gridDim.z;
    unsigned sum, cnt, mine, sp = 0u;
    for (;;) {
        sum = 0u; cnt = 0u; mine = 0u;
#pragma unroll
        for (unsigned j = 0; j < 16; ++j) { const unsigned c = xb_ld(&bar[XB_XCNT(j)]); sum += c; cnt += (c > 0u) ? 1u : 0u; mine = (j == x) ? c : mine; }
        if (sum == G) break;
        __builtin_amdgcn_s_sleep(1);
        if ((++sp & 255u) == 0u) { if (xb_ld(&bar[XB_TMO])) break; if (sp > XB_SPIN_CAP) { atomicAdd(&bar[XB_TMO], 1u); break; } }
    }
    nloc = mine > 0u ? mine : 1u; nx = cnt > 0u ? cnt : 1u;
}
DI void xcd_barrier(const XcdBarrier& b) {
    asm volatile("s_waitcnt vmcnt(0)" ::: "memory");
    __syncthreads();
    if (threadIdx.x == 0) {
        unsigned* bar = b.bar;
        __builtin_amdgcn_s_waitcnt(0);
        unsigned nloc = b.st[0], nx = b.st[1];
        if (nloc == 0u) { xcd_barrier_complete(bar, b.x, nloc, nx); b.st[0] = nloc; b.st[1] = nx; }
        const unsigned old = xb_add(&bar[XB_XSUB(b.x)], 1u);
        const unsigned gen = old / nloc;
        if (old + 1u == (gen + 1u) * nloc) {
            __builtin_amdgcn_fence(__ATOMIC_RELEASE, "agent");
            asm volatile("s_waitcnt vmcnt(0)" ::: "memory");
            const unsigned og = xb_add(&bar[XB_TOP], 1u);
            const unsigned tg = og / nx;
            if (og + 1u == (tg + 1u) * nx) xb_add(&bar[XB_TOPGEN], 1u);
            else XB_SPIN(xb_ld(&bar[XB_TOPGEN]) == tg, bar);
            __builtin_amdgcn_fence(__ATOMIC_ACQUIRE, "agent");
            xb_add(&bar[XB_XGEN(b.x)], 1u);
            asm volatile("s_waitcnt vmcnt(0)" ::: "memory");
        } else {
            XB_SPIN(xb_ld(&bar[XB_XGEN(b.x)]) == gen, bar);
            __builtin_amdgcn_fence(__ATOMIC_ACQUIRE, "agent");
            asm volatile("s_waitcnt vmcnt(0)" ::: "memory");
        }
    }
    __syncthreads();
}

__global__ void __launch_bounds__(512, 2) mega(Params p) {
    extern __shared__ __attribute__((aligned(16))) unsigned char lds_raw[];
    const int half = __builtin_amdgcn_readfirstlane(threadIdx.x >> 8);
    const int tid = threadIdx.x & 255, lane = tid & 63, wid = tid >> 6;
    const int nblk = gridDim.x * 2, bid = blockIdx.x * 2 + half;
    auto lwid = [&]() { int w_ = (int)((threadIdx.x & 255) >> 6); asm volatile("" : "+v"(w_)); return w_; };
    unsigned char* const lds_base = lds_raw; unsigned char* const lds = lds_raw + half * 73728;
    unsigned char* ws = p.ws;
    const int lo = p.ph_lo, hi = p.ph_hi;
#ifndef PH_MASK
#define PH_MASK 0x3ff
#endif
#define IN_PH(k) ((((PH_MASK) >> (k)) & 1) && lo <= (k) && (k) <= hi)
#define SEAM(k) do { if ((k) < hi) { xcd_barrier(xb); } } while (0)
    if (threadIdx.x < 4) ((volatile LAS unsigned*)(lds_base + 147456))[threadIdx.x] = 0u;
    __syncthreads();
    XcdBarrier xb = xcd_barrier_post((unsigned*)(ws + OFF_BAR), (volatile LAS unsigned*)(lds_base + 147456));
    if (hi > 1000) cg::this_grid().sync();
    float* MOD = (float*)(ws + OFF_MODZ);
    int* CNT = (int*)(ws + OFF_MISC);

    if (IN_PH(0)) {
        constexpr int T_MOD = 96 * 4;
        for (int t = bid; t < T_MOD + 2; t += nblk) {
            if (t < T_MOD) {
                const int j = t >> 2, kq = t & 3; float* sv = (float*)lds; float* red = sv + 768;
                __syncthreads();
                for (int i = tid; i < 768; i += 256) { const int which = i >> 8, k = kq * 256 + (i & 255); const float cv = which < 2 ? p.c[which * 1024 + k] : p.c_ctx[k]; sv[i] = silu_f(cv); }
                __syncthreads();
                const int col = j * 64 + lane; float a0 = 0.f, a1 = 0.f, a2 = 0.f;
#pragma unroll 8
                for (int k = 64 * wid; k < 64 * wid + 64; ++k) { const float wv = p.w_mod[(size_t)(kq * 256 + k) * 6144 + col]; a0 += sv[k] * wv; a1 += sv[256 + k] * wv; a2 += sv[512 + k] * wv; }
                red[(wid * 3 + 0) * 64 + lane] = a0; red[(wid * 3 + 1) * 64 + lane] = a1; red[(wid * 3 + 2) * 64 + lane] = a2;
                __syncthreads();
                if (tid < 192) { const int which = tid >> 6, cl = tid & 63; float sacc = kq == 0 ? p.b_mod[j * 64 + cl] : 0.f; for (int w = 0; w < 4; ++w) sacc += red[(w * 3 + which) * 64 + cl]; atomicAdd(&MOD[which * 6144 + j * 64 + cl], sacc); }
            } else if (t == T_MOD) {
                f2_t* RT = (f2_t*)(ws + OFF_ROPE);
                for (int i = tid; i < 2048; i += 256) {
                    const int pos = i >> 4, j = i & 15;
                    const float inv = exp2f(-(float)j * 0.8304820237218406f);
                    const float ang = (float)pos * inv;
                    const float n = rintf(ang * 0.15915494309189535f);
                    float r = fmaf(-n, 6.28125f, ang); r = fmaf(-n, 1.9353071795864769e-3f, r);
                    RT[i] = (f2_t){cosf(r), sinf(r)};
                }
            } else { if (tid == 0) CNT[0] = 0; }
        }
        for (int t = bid; t < 16 * (INP / 64); t += nblk) wconv_tile(p.w_in, DM, INC, INP, (u16*)(ws + OFF_WIN), t, (float*)lds);
        SEAM(0);
    }
    if (IN_PH(1)) {
        u16* H = (u16*)(ws + OFF_H);
        norm_rows([&](int r) { return r < NLAT ? p.x + (size_t)r * DM : p.ctx + (size_t)(r - NLAT) * DM; }, NROW, bid * 4 + lwid(), nblk * 4, p.norm1_w, MOD, 0, 1, H, lane);
        SEAM(1);
    }
    if (IN_PH(2)) {
        pg8::Gemm g{(const u16*)(ws + OFF_H), (const u16*)(ws + OFF_WIN), NROW, 2816, DM}; pg8::StaticOrder S; S.init(NROW, 2816, (int)gridDim.x, (int)blockIdx.x);
        pg8::EpiInProj E{(u16*)(ws + OFF_MIX), (u16*)(ws + OFF_K), (u16*)(ws + OFF_VT), (u16*)(ws + OFF_DQKV), (float*)(ws + OFF_GATE), p.a_log, p.dt_bias};
        pg8::gemm_phase<pg8::EpiInProj, pg8::StaticOrder, true, true>((PG8_LAS unsigned char*)lds_base, g, S, E);
        {
            const u16* H = (const u16*)(ws + OFF_H); const u16* Wg = (const u16*)(ws + OFF_WIN) + (size_t)2816 * DM; float* GT = (float*)(ws + OFF_GATE);
            const int l15 = lane & 15, quad = lane >> 4;
            for (int rb = (int)blockIdx.x * 8 + (int)(threadIdx.x >> 6); rb < NROW / 16; rb += (int)gridDim.x * 8) {
                f32x4 acc = {0.f, 0.f, 0.f, 0.f};
                const u16* ap = H + (size_t)(rb * 16 + l15) * DM + 8 * quad; const u16* bp = Wg + (size_t)l15 * DM + 8 * quad;
#pragma unroll 8
                for (int ks = 0; ks < 32; ++ks) acc = MFMA16(*(const bf16x8*)(ap + 32 * ks), *(const bf16x8*)(bp + 32 * ks), acc);
                const int ci = l15;
#pragma unroll
                for (int r = 0; r < 4; ++r) {
                    const float x = acc[r]; float o;
                    if (ci < 8) o = 1.f / (1.f + __expf(-x));
                    else { const float xx = x + p.dt_bias[ci - 8]; const float sp = xx > 20.f ? xx : log1pf(__expf(xx)); o = -__expf(p.a_log[ci - 8]) * sp; }
                    GT[(size_t)(rb * 16 + 4 * quad + r) * 16 + ci] = o;
                }
            }
        }
        SEAM(2);
    }
    if (IN_PH(3)) {
        if (bid < 32) { gdn_prep_unit(p, ((bid >> 4) * NCK + ((bid >> 2) & 3)) * 4 + (bid & 3), lds); } else {
        {
            u16* MIX = (u16*)(ws + OFF_MIX); u16* Kb = (u16*)(ws + OFF_K); const f2_t* RT = (const f2_t*)(ws + OFF_ROPE);
            const int l8 = lane & 7, sub = lane >> 3;
            for (int it = (bid - 32) * 4 + wid; it < NLAT + (NB * 2 * SKV) / 8; it += (nblk - 32) * 4) {
                u16* ptr; int t; bool rope; const float* nw; float scale;
                if (it < NLAT) { ptr = MIX + (size_t)it * DM + sub * 64 + l8 * 8; t = it & (SEQ - 1); rope = true; nw = p.q_norm_w; scale = QSCALE; }
                else { const int j = (it - NLAT) * 8 + sub, bk = j / SKV, pos = j - bk * SKV; ptr = Kb + ((size_t)bk * SKV + pos) * 64 + l8 * 8; rope = pos >= CTXL; t = pos >= CTXL ? pos - CTXL : 0; nw = p.k_norm_w; scale = 1.f; }
                const u32x4 raw = *(const u32x4*)ptr;
                float y[8];
#pragma unroll
                for (int e = 0; e < 4; ++e) { y[2 * e] = bflo(raw[e]); y[2 * e + 1] = bfhi(raw[e]); }
                float ss = 0.f;
#pragma unroll
                for (int e = 0; e < 8; ++e) ss += y[e] * y[e];
                ss += __shfl_xor(ss, 1); ss += __shfl_xor(ss, 2); ss += __shfl_xor(ss, 4);
                const float rinv = rsqrtf(ss * (1.f / 64.f) + EPS);
                const f32x4 wa = *(const f32x4*)(nw + 8 * l8), wb = *(const f32x4*)(nw + 8 * l8 + 4);
                const int ppos = (l8 & 4) ? (t & 63) : (t >> 6); const float sgn = (l8 & 2) ? 1.f : -1.f;
#pragma unroll
                for (int e = 0; e < 8; ++e) {
                    const float v = y[e] * rinv * (e < 4 ? wa[e] : wb[e - 4]);
                    const float pv = __shfl_xor(v, 2);
                    const f2_t cs = RT[ppos * 16 + 8 * (l8 & 1) + e];
                    const float vr = v * cs.x + sgn * pv * cs.y;
                    y[e] = (rope ? vr : v) * scale;
                }
                const u32x4 w = {pk2(y[0], y[1]), pk2(y[2], y[3]), pk2(y[4], y[5]), pk2(y[6], y[7])};
                *(u32x4*)ptr = w;
            }
        }
        constexpr int T_WO = 16 * 16, T_W1 = 16 * 64, T_W2 = 64 * 16;
        for (int t = bid - 32; t < T_WO + T_W1 + T_W2; t += nblk - 32) {
            if (t < T_WO) wconv_tile(p.w_out, DM, DM, DM, (u16*)(ws + OFF_WOUT), t, (float*)lds);
            else if (t < T_WO + T_W1) wconv_tile(p.w_mlp1, DM, DFF, DFF, (u16*)(ws + OFF_WM1), t - T_WO, (float*)lds);
            else wconv_tile(p.w_mlp2, DFF, DM, DM, (u16*)(ws + OFF_WM2), t - T_WO - T_W1, (float*)lds);
        }
        }
        for (int j = bid; j < 1024; j += nblk) gdn_prep_unit(p, ((j >> 9) * NCK + 4 + ((j & 511) >> 2)) * 4 + (j & 3), lds);
        SEAM(3);
    }
    if (IN_PH(4)) {
        if (blockIdx.x < 32) {
            gdn_scan_block(p, (int)blockIdx.x, lds_base, lds_base + 73728, half);
        }
        float Mb;
        { const float a = wave_max(fabsf(p.q_norm_w[lane])), bq = wave_max(fabsf(p.k_norm_w[lane])); Mb = 8.f * a * bq * 1.4426950408889634f; }
        int* su = (int*)(lds_base + 147456 + 8);
        for (;;) {
            __syncthreads();
            if (threadIdx.x == 0) *su = atomicAdd(CNT, 2);
            __syncthreads();
            const int u0 = *su;
            if (u0 >= 2048) break;
            attn_unit(p, u0 >> 1, half, lds_base, Mb);
        }
        SEAM(4);
    }
    if (IN_PH(5)) {
        const u16* O0 = (const u16*)(ws + OFF_O01); const u16* O1 = O0 + (size_t)NLAT * 512; u16* MIX = (u16*)(ws + OFF_MIX);
        const int e0 = (8 * lane) & 127;
        const f32x4 nwa = *(const f32x4*)(p.dn_norm_w + e0), nwb = *(const f32x4*)(p.dn_norm_w + e0 + 4);
        {
            const u16* PP = (const u16*)p.out; const float* LL = (const float*)(ws + OFF_LP);
            for (int r = bid * 4 + lwid(); r < NLAT; r += nblk * 4) {
                const size_t off = (size_t)r * 512 + 8 * lane;
                float acc[8] = {0.f, 0.f, 0.f, 0.f, 0.f, 0.f, 0.f, 0.f}; float lsum = 0.f;
#pragma unroll
                for (int q = 0; q < 4; ++q) {
                    const u32x4 a = *(const u32x4*)(PP + (size_t)q * NLAT * 512 + off);
                    lsum += LL[(size_t)q * NLAT * 8 + (size_t)r * 8 + (lane >> 3)];
#pragma unroll
                    for (int i = 0; i < 4; ++i) { acc[2 * i] += bflo(a[i]); acc[2 * i + 1] += bfhi(a[i]); }
                }
                const float inv = 1.f / lsum;
                u32x4 w = {pk2(acc[0] * inv, acc[1] * inv), pk2(acc[2] * inv, acc[3] * inv), pk2(acc[4] * inv, acc[5] * inv), pk2(acc[6] * inv, acc[7] * inv)};
                *(u32x4*)(MIX + (size_t)r * DM + 8 * lane) = w;
            }
        }
        int r = bid * 4 + lwid(); const int rs = nblk * 4;
        u32x4 na = {0u, 0u, 0u, 0u}, nc = na, nz = na;
        if (r < NLAT) { na = *(const u32x4*)(O0 + (size_t)r * 512 + 8 * lane); nc = *(const u32x4*)(O1 + (size_t)r * 512 + 8 * lane); nz = *(const u32x4*)(MIX + (size_t)r * DM + 512 + 8 * lane); }
        for (; r < NLAT; r += rs) {
            const u32x4 a = na, c = nc, z = nz;
            if (r + rs < NLAT) { const int r2 = r + rs; na = *(const u32x4*)(O0 + (size_t)r2 * 512 + 8 * lane); nc = *(const u32x4*)(O1 + (size_t)r2 * 512 + 8 * lane); nz = *(const u32x4*)(MIX + (size_t)r2 * DM + 512 + 8 * lane); }
            float o[8], zz[8];
#pragma unroll
            for (int i = 0; i < 4; ++i) { o[2 * i] = bflo(a[i]) + bflo(c[i]); o[2 * i + 1] = bfhi(a[i]) + bfhi(c[i]); zz[2 * i] = bflo(z[i]); zz[2 * i + 1] = bfhi(z[i]); }
            float ss = 0.f;
#pragma unroll
            for (int i = 0; i < 8; ++i) ss += o[i] * o[i];
            ss += __shfl_xor(ss, 1); ss += __shfl_xor(ss, 2); ss += __shfl_xor(ss, 4); ss += __shfl_xor(ss, 8);
            const float rinv = rsqrtf(ss * (1.f / 128.f) + EPS);
            float y[8];
#pragma unroll
            for (int i = 0; i < 8; ++i) y[i] = o[i] * rinv * (i < 4 ? nwa[i] : nwb[i - 4]) * silu_f(zz[i]);
            u32x4 w = {pk2(y[0], y[1]), pk2(y[2], y[3]), pk2(y[4], y[5]), pk2(y[6], y[7])};
            *(u32x4*)(MIX + (size_t)r * DM + 512 + 8 * lane) = w;
        }
        SEAM(5);
    }
    if (IN_PH(6)) {
        pg8::Gemm g{(const u16*)(ws + OFF_MIX), (const u16*)(ws + OFF_WOUT), NLAT, DM, DM}; pg8::StaticOrder S; S.init(NLAT, DM, (int)gridDim.x, (int)blockIdx.x);
        pg8::EpiGatedRes E{p.x, p.out, MOD + 2 * 1024, 6144, DM};
        pg8::gemm_phase<pg8::EpiGatedRes, pg8::StaticOrder, true, true>((PG8_LAS unsigned char*)lds_base, g, S, E);
        SEAM(6);
    }
    if (IN_PH(7)) {
        u16* H2 = (u16*)(ws + OFF_H2);
        norm_rows([&](int r) { return (const float*)p.out + (size_t)r * DM; }, NLAT, bid * 4 + lwid(), nblk * 4, p.norm2_w, MOD, 3, 4, H2, lane);
        SEAM(7);
    }
    if (IN_PH(8)) {
        pg8::Gemm g{(const u16*)(ws + OFF_H2), (const u16*)(ws + OFF_WM1), NLAT, DFF, DM}; pg8::StaticOrder S; S.init(NLAT, DFF, (int)gridDim.x, (int)blockIdx.x);
        pg8::EpiRelu2 E{(u16*)(ws + OFF_HID), DFF};
        pg8::gemm_phase<pg8::EpiRelu2, pg8::StaticOrder, true, true>((PG8_LAS unsigned char*)lds_base, g, S, E);
        SEAM(8);
    }
    if (IN_PH(9)) {
        pg8::Gemm g{(const u16*)(ws + OFF_HID), (const u16*)(ws + OFF_WM2), NLAT, DM, DFF}; pg8::StaticOrder S; S.init(NLAT, DM, (int)gridDim.x, (int)blockIdx.x);
        pg8::EpiGatedRes E{p.out, p.out, MOD + 5 * 1024, 6144, DM};
        pg8::gemm_phase<pg8::EpiGatedRes, pg8::StaticOrder, true, true>((PG8_LAS unsigned char*)lds_base, g, S, E);
    }
}

extern "C" void kernel_launch(void* const* d_in, const int* in_sizes, int n_in, void* d_out, int out_size, void* d_ws, size_t ws_size, hipStream_t stream) {
    static int grid = 0;
    if (grid == 0) {
        if (ws_size < WS_NEED) { fprintf(stderr, "kernel_launch: workspace too small (%zu < %zu)\n", ws_size, (size_t)WS_END); grid = -1; return; }
        int dev = 0, cus = 0, per_cu = 0;
        hipGetDevice(&dev);
        hipDeviceGetAttribute(&cus, hipDeviceAttributeMultiprocessorCount, dev);
        hipFuncSetAttribute((const void*)mega, hipFuncAttributeMaxDynamicSharedMemorySize, LDS_BYTES);
        hipOccupancyMaxActiveBlocksPerMultiprocessor(&per_cu, (const void*)mega, 512, LDS_BYTES);
        if (per_cu < 1) per_cu = 1;
        if (per_cu > 1) per_cu = 1;
        grid = cus * per_cu;
        fprintf(stderr, "kernel_launch: cus %d per_cu %d grid %d ws %zu need %zu\n", cus, per_cu, grid, ws_size, (size_t)WS_END);
    }
    if (grid < 0) return;
    if (hipMemsetAsync((unsigned char*)d_ws + OFF_BAR, 0, ZERO_BYTES, stream) != hipSuccess) { fprintf(stderr, "kernel_launch: memset of barrier words failed\n"); return; }
    Params p{};
    const float** pp = (const float**)&p;
    for (int i = 0; i < 18; ++i) pp[i] = (const float*)d_in[i];
    p.out = (float*)d_out; p.ws = (unsigned char*)d_ws;
#if ONE_LAUNCH
    p.ph_lo = 0; p.ph_hi = 9;
    void* args[] = {&p};
    hipError_t e = hipLaunchCooperativeKernel((const void*)mega, dim3(grid), dim3(512), args, LDS_BYTES, stream);
    if (e != hipSuccess) fprintf(stderr, "cooperative launch failed: %s (grid %d)\n", hipGetErrorString(e), grid);
#else
#ifndef DUP_PH
#define DUP_PH -1
#endif
    for (int ph = 0; ph <= 9; ++ph) {
        p.ph_lo = ph; p.ph_hi = ph;
        hipLaunchKernelGGL(mega, dim3(grid), dim3(512), LDS_BYTES, stream, p);
        if (ph == DUP_PH) hipLaunchKernelGGL(mega, dim3(grid), dim3(512), LDS_BYTES, stream, p);
    }
#endif
}
```

```cpp
#include <hip/hip_runtime.h>
#include <hip/hip_cooperative_groups.h>
#include <stdint.h>
#include <cstdio>
namespace cg = cooperative_groups;

#ifndef ONE_LAUNCH
#define ONE_LAUNCH 1
#endif

typedef unsigned short u16;
typedef __bf16 bf2_t __attribute__((ext_vector_type(2)));
typedef float f2_t __attribute__((ext_vector_type(2)));
typedef short bf16x8 __attribute__((ext_vector_type(8)));
typedef float f32x4 __attribute__((ext_vector_type(4)));
typedef float f32x16 __attribute__((ext_vector_type(16)));
typedef unsigned u32x2 __attribute__((ext_vector_type(2)));
typedef unsigned u32x4 __attribute__((ext_vector_type(4)));

#define DI __device__ __forceinline__
DI unsigned pk2(float lo, float hi) { f2_t v = {lo, hi}; return __builtin_bit_cast(unsigned, __builtin_convertvector(v, bf2_t)); }
DI u16 f2bf(float x) { return (u16)(pk2(x, 0.f) & 0xffffu); }
DI float bf2f(u16 v) { return __uint_as_float(((unsigned)v) << 16); }
DI float bflo(unsigned v) { return __uint_as_float(v << 16); }
DI float bfhi(unsigned v) { return __uint_as_float(v & 0xffff0000u); }
DI bf16x8 mk8(unsigned a, unsigned b, unsigned c, unsigned d) { u32x4 v = {a, b, c, d}; return __builtin_bit_cast(bf16x8, v); }
DI bf16x8 mk8(u32x2 lo, u32x2 hi) { u32x4 v = {lo.x, lo.y, hi.x, hi.y}; return __builtin_bit_cast(bf16x8, v); }
#define MFMA16(a, b, c) __builtin_amdgcn_mfma_f32_16x16x32_bf16((a), (b), (c), 0, 0, 0)
#define MFMA32(a, b, c) __builtin_amdgcn_mfma_f32_32x32x16_bf16((a), (b), (c), 0, 0, 0)

constexpr int DM = 1024, NB = 2, SEQ = 8192, NLAT = NB * SEQ, CTXL = 256, NCTX = NB * CTXL, NROW = NLAT + NCTX;
constexpr int INC = 2832, INP = 3072, DFF = 4096, SKV = CTXL + SEQ;
constexpr int NCK = 132;
constexpr int NCU = NB * NCK * 4;
constexpr float EPS = 1e-6f;
constexpr float QSCALE = 0.125f * 1.4426950408889634f;

constexpr size_t OFF_WIN = 0;
constexpr size_t OFF_MOD = OFF_WIN + (size_t)INP * DM * 2;
constexpr size_t OFF_ROPE = OFF_MOD + 3 * 6144 * 4;
constexpr size_t OFF_MISC = OFF_ROPE + 128 * 16 * 8;
constexpr size_t OFF_H = OFF_MISC + 256;
constexpr size_t OFF_WOUT = OFF_H;
constexpr size_t OFF_WM1 = OFF_WOUT + (size_t)DM * DM * 2;
constexpr size_t OFF_WM2 = OFF_WM1 + (size_t)DFF * DM * 2;
constexpr size_t OFF_DQKV = OFF_H + (size_t)NROW * DM * 2;
constexpr size_t OFF_O01 = OFF_DQKV;
constexpr size_t OFF_H2 = OFF_DQKV;
constexpr size_t OFF_MIX = OFF_DQKV + (size_t)NROW * 1536 * 2;
constexpr size_t OFF_HID = OFF_MIX;
constexpr size_t OFF_K = OFF_MIX + (size_t)NLAT * DM * 2;
constexpr size_t OFF_VT = OFF_K + (size_t)NB * 2 * SKV * 64 * 2;
constexpr size_t OFF_GATE = OFF_VT + (size_t)NB * 2 * SKV * 64 * 2;
constexpr size_t OFF_QN = OFF_GATE + (size_t)NROW * 16 * 4;
constexpr size_t OFF_KNT = OFF_QN + (size_t)NCU * 8192 * 2;
constexpr size_t OFF_WNEG = OFF_KNT + (size_t)NCU * 8192 * 2;
constexpr size_t OFF_UT = OFF_WNEG + (size_t)2 * NCU * 8192 * 2;
constexpr size_t OFF_INTRA = OFF_UT + (size_t)2 * NCU * 8192 * 2;
constexpr size_t OFF_SCAL = OFF_INTRA + (size_t)2 * NCU * 4096 * 2;
constexpr size_t WS_END = OFF_SCAL + (size_t)2 * NCU * 192 * 4;
static_assert(OFF_HID + (size_t)NLAT * DFF * 2 <= WS_END, "hid overlay");
static_assert(WS_END + 16384 + 3 * 6144 * 4 + 4 * 16384 * 8 * 4 <= (size_t)256 * 1024 * 1024, "ws budget");

constexpr int LDS_BYTES = 2 * 73728 + 16;
constexpr size_t OFF_BAR = WS_END;
constexpr size_t OFF_MODZ = OFF_BAR + 16384;
constexpr size_t ZERO_BYTES = 16384 + 3 * 6144 * 4;
constexpr size_t OFF_LP = OFF_MODZ + 3 * 6144 * 4;
constexpr size_t WS_NEED = OFF_LP + (size_t)4 * NLAT * 8 * 4;


struct Params {
    const float *x, *c, *ctx, *c_ctx, *w_mod, *b_mod, *norm1_w, *w_in, *q_norm_w, *k_norm_w, *conv_w, *a_log, *dt_bias, *dn_norm_w, *w_out, *norm2_w, *w_mlp1, *w_mlp2;
    float* out; unsigned char* ws; int ph_lo, ph_hi;
};

DI void wconv_tile(const float* __restrict__ W, int K, int N, int Npad, u16* __restrict__ Wt, int tile, float* st) {
    const int ntn = Npad / 64, kt = tile / ntn, nt = tile % ntn, k0 = kt * 64, n0 = nt * 64;
    const int tid = (threadIdx.x & 255), c = tid & 63, r4 = tid >> 6;
    __syncthreads();
#pragma unroll 4
    for (int i = 0; i < 16; ++i) { const int k = i * 4 + r4, n = n0 + c; st[k * 65 + c] = (n < N) ? W[(size_t)(k0 + k) * N + n] : 0.f; }
    __syncthreads();
#pragma unroll 4
    for (int i = 0; i < 16; ++i) { const int n = i * 4 + r4; Wt[(size_t)(n0 + n) * K + k0 + c] = f2bf(st[c * 65 + n]); }
}

template <class Epi>
DI void gemm_tile(const u16* __restrict__ A, int lda, const u16* __restrict__ Bt, int ldb, int K, int m0, int n0, unsigned char* lds, Epi&& epi) {
    const int tid = (threadIdx.x & 255), lane = tid & 63, wid = tid >> 6, wr = wid >> 1, wc = wid & 1, l15 = lane & 15, quad = lane >> 4;
    u16* As = (u16*)lds; u16* Bs = (u16*)(lds + 18432);
    f32x4 acc[4][4];
#pragma unroll
    for (int m = 0; m < 4; ++m)
#pragma unroll
        for (int n = 0; n < 4; ++n) acc[m][n] = (f32x4){0.f, 0.f, 0.f, 0.f};
    u32x4 ra[4], rb[4];
    const int lrow = tid >> 3, lcc = tid & 7;
    const u16* Ap = A + (size_t)(m0 + lrow) * lda + lcc * 8;
    const u16* Bp = Bt + (size_t)(n0 + lrow) * ldb + lcc * 8;
    const int nk = K / 64;
#pragma unroll
    for (int i = 0; i < 4; ++i) { ra[i] = *(const u32x4*)(Ap + (size_t)(32 * i) * lda); rb[i] = *(const u32x4*)(Bp + (size_t)(32 * i) * ldb); }
    __syncthreads();
#pragma unroll
    for (int i = 0; i < 4; ++i) { *(u32x4*)(As + (lrow + 32 * i) * 72 + lcc * 8) = ra[i]; *(u32x4*)(Bs + (lrow + 32 * i) * 72 + lcc * 8) = rb[i]; }
#pragma unroll
    for (int i = 0; i < 4; ++i) { ra[i] = *(const u32x4*)(Ap + (size_t)(32 * i) * lda + 64); rb[i] = *(const u32x4*)(Bp + (size_t)(32 * i) * ldb + 64); }
    __syncthreads();
    for (int kt = 0; kt < nk; ++kt) {
        const u16* Ac = As + (kt & 1) * 18432; const u16* Bc = Bs + (kt & 1) * 18432;
        if (kt + 1 < nk) {
            u16* An = As + ((kt + 1) & 1) * 18432; u16* Bn = Bs + ((kt + 1) & 1) * 18432;
#pragma unroll
            for (int i = 0; i < 4; ++i) { *(u32x4*)(An + (lrow + 32 * i) * 72 + lcc * 8) = ra[i]; *(u32x4*)(Bn + (lrow + 32 * i) * 72 + lcc * 8) = rb[i]; }
        }
        if (kt + 2 < nk) {
#pragma unroll
            for (int i = 0; i < 4; ++i) { ra[i] = *(const u32x4*)(Ap + (size_t)(32 * i) * lda + (kt + 2) * 64); rb[i] = *(const u32x4*)(Bp + (size_t)(32 * i) * ldb + (kt + 2) * 64); }
        }
#pragma unroll
        for (int ks = 0; ks < 2; ++ks) {
            bf16x8 af[4], bfr[4];
#pragma unroll
            for (int m = 0; m < 4; ++m) af[m] = *(const bf16x8*)(Ac + (64 * wr + 16 * m + l15) * 72 + 32 * ks + 8 * quad);
#pragma unroll
            for (int n = 0; n < 4; ++n) bfr[n] = *(const bf16x8*)(Bc + (64 * wc + 16 * n + l15) * 72 + 32 * ks + 8 * quad);
#pragma unroll
            for (int m = 0; m < 4; ++m)
#pragma unroll
                for (int n = 0; n < 4; ++n) acc[m][n] = MFMA16(bfr[n], af[m], acc[m][n]);
        }
        __syncthreads();
    }
    epi(acc, m0 + 64 * wr, n0 + 64 * wc, l15, quad);
}

DI float silu_f(float v) { return v / (1.f + __expf(-v)); }
DI int permpos(int c) { const int k = c & 31; return (c & ~31) | (8 * ((k & 15) >> 2) + 4 * (k >> 4) + (k & 3)); }
DI float wave_max(float v) {
#pragma unroll
    for (int o = 32; o > 0; o >>= 1) v = fmaxf(v, __shfl_xor(v, o));
    return v;
}
DI float wave_sum(float v) {
#pragma unroll
    for (int o = 32; o > 0; o >>= 1) v += __shfl_xor(v, o);
    return v;
}

template <class SrcF>
DI void norm_rows(SrcF srcf, int nrows, int row0, int rstride, const float* __restrict__ nw, const float* __restrict__ MOD, int shift_idx, int scale_idx, u16* __restrict__ dst, int lane) {
    f32x4 w[4], sh[4], sc[4]; int cur = -1;
    f32x4 v[4], nx[4];
    int r = row0;
    if (r < nrows) {
        const float* src = srcf(r);
#pragma unroll
        for (int i = 0; i < 4; ++i) nx[i] = *(const f32x4*)(src + 4 * lane + 256 * i);
    }
    for (; r < nrows; r += rstride) {
#pragma unroll
        for (int i = 0; i < 4; ++i) v[i] = nx[i];
        if (r + rstride < nrows) {
            const float* src = srcf(r + rstride);
#pragma unroll
            for (int i = 0; i < 4; ++i) nx[i] = *(const f32x4*)(src + 4 * lane + 256 * i);
        }
        const int which = r < NLAT ? (r >> 13) : 2;
        if (which != cur) {
            cur = which;
#pragma unroll
            for (int i = 0; i < 4; ++i) {
                const int c = 4 * lane + 256 * i;
                w[i] = *(const f32x4*)(nw + c); sh[i] = *(const f32x4*)(MOD + which * 6144 + shift_idx * 1024 + c); sc[i] = *(const f32x4*)(MOD + which * 6144 + scale_idx * 1024 + c);
                w[i] = w[i] * (sc[i] + 1.f);
            }
        }
        float ss = 0.f;
#pragma unroll
        for (int i = 0; i < 4; ++i) ss += v[i][0] * v[i][0] + v[i][1] * v[i][1] + v[i][2] * v[i][2] + v[i][3] * v[i][3];
        ss = wave_sum(ss);
        const float rinv = rsqrtf(ss * (1.f / 1024.f) + EPS);
#pragma unroll
        for (int i = 0; i < 4; ++i) {
            const f32x4 yv = v[i] * rinv * w[i] + sh[i];
            u32x2 o = {pk2(yv[0], yv[1]), pk2(yv[2], yv[3])};
            *(u32x2*)(dst + (size_t)r * DM + 4 * lane + 256 * i) = o;
        }
    }
}

DI void gdn_prep_unit(const Params& p, int unit, unsigned char* lds) {
    int tid_in = (threadIdx.x & 255); asm volatile("" : "+v"(tid_in));
    const int tid = tid_in, lane = tid & 63, wid = tid >> 6, l15 = lane & 15, quad = lane >> 4;
    const int h = unit & 3, bc = unit >> 2, b = bc / NCK, ck = bc % NCK;
    const bool isctx = ck < 4;
    const int seqlen = isctx ? CTXL : SEQ;
    const int c0 = isctx ? ck * 64 : (ck - 4) * 64;
    const int rowbase = isctx ? (NLAT + b * CTXL) : b * SEQ;
    unsigned char* ws = p.ws;
    const u16* DQ = (const u16*)(ws + OFF_DQKV);
    const float* GT = (const float*)(ws + OFF_GATE);
    u16* Qs = (u16*)lds; u16* Ks = (u16*)(lds + 17408); float* stage = (float*)(lds + 34816);
    float* gs = (float*)(lds + 67840); float* gcs = (float*)(lds + 71936); float* rbs = (float*)(lds + 72448); float* rbe = (float*)(lds + 72960); float* rn = (float*)(lds + 73472);
    u16* QNg = (u16*)(ws + OFF_QN) + (size_t)unit * 8192;
    u16* KNTg = (u16*)(ws + OFF_KNT) + (size_t)unit * 8192;
    __syncthreads();
    {
        const int t = tid >> 2, q4 = tid & 3;
        *(f32x4*)(gs + t * 16 + q4 * 4) = *(const f32x4*)(GT + (size_t)(rowbase + c0 + t) * 16 + q4 * 4);
    }
    const int cch = tid & 127, th = tid >> 7;
    float* part = rbs;
    u32x4 rawreg[5];
    auto raw_fetch = [&](int wh) {
#pragma unroll
        for (int i = 0; i < 5; ++i) {
            const int idx = tid + 256 * i; const int row = idx >> 4, cc = idx & 15, s = c0 - 2 + row;
            u32x4 v = {0u, 0u, 0u, 0u};
            if (idx < 68 * 16 && s >= 0 && s < seqlen) v = *(const u32x4*)(DQ + (size_t)(rowbase + s) * 1536 + wh * 512 + h * 128 + cc * 8);
            rawreg[i] = v;
        }
    };
    raw_fetch(2);
#pragma unroll 1
    for (int wi = 0; wi < 3; ++wi) {
        const int which = wi == 0 ? 2 : wi - 1;
        if (isctx && wi == 1) continue;
        u16* raw = (wi == 0) ? Qs : Ks;
        __syncthreads();
#pragma unroll
        for (int i = 0; i < 5; ++i) {
            const int idx = tid + 256 * i;
            if (idx < 68 * 16) { const int row = idx >> 4, cc = idx & 15; *(u32x4*)(raw + row * 128 + cc * 8) = rawreg[i]; }
        }
        if (wi < 2) raw_fetch((isctx || wi == 1) ? 1 : 0);
        const int col = which * 512 + h * 128 + cch;
        const float w0 = p.conv_w[0 * 1536 + col], w1 = p.conv_w[1 * 1536 + col], w2 = p.conv_w[2 * 1536 + col], w3 = p.conv_w[3 * 1536 + col], w4 = p.conv_w[4 * 1536 + col];
        __syncthreads();
        float y[32];
        {
            const u16* rp = raw + (32 * th) * 128 + cch;
            float xa = bf2f(rp[0]), xb = bf2f(rp[128]), xc = bf2f(rp[256]), xd = bf2f(rp[384]);
#pragma unroll
            for (int i = 0; i < 32; ++i) {
                const float xe = bf2f(rp[(i + 4) * 128]);
                y[i] = silu_f(w0 * xa + w1 * xb + w2 * xc + w3 * xd + w4 * xe);
                xa = xb; xb = xc; xc = xd; xd = xe;
            }
        }
        if (which == 2) {
#pragma unroll
            for (int i = 0; i < 32; ++i) stage[(32 * th + i) * 129 + cch] = y[i];
        } else {
            float mine = 0.f;
#pragma unroll
            for (int i = 0; i < 32; ++i) { const float ssum = wave_sum(y[i] * y[i]); if (lane == i) mine = ssum; }
            if (lane < 32) part[wid * 32 + lane] = mine;
            __syncthreads();
            if (which == 0) {
#pragma unroll
                for (int i = 0; i < 32; ++i) {
                    const int t = 32 * th + i; const float rinv = rsqrtf(part[(2 * th) * 32 + i] + part[(2 * th + 1) * 32 + i] + EPS);
                    const u16 v = f2bf(y[i] * rinv); Qs[t * 136 + cch] = v; QNg[t * 128 + permpos(cch)] = v;
                }
            } else {
                unsigned pkd[16];
#pragma unroll
                for (int i = 0; i < 16; ++i) {
                    const int t = 32 * th + 2 * i;
                    const float r0 = rsqrtf(part[(2 * th) * 32 + 2 * i] + part[(2 * th + 1) * 32 + 2 * i] + EPS), r1 = rsqrtf(part[(2 * th) * 32 + 2 * i + 1] + part[(2 * th + 1) * 32 + 2 * i + 1] + EPS);
                    const unsigned v = pk2(y[2 * i] * r0, y[2 * i + 1] * r1); pkd[i] = v;
                    Ks[t * 136 + cch] = (u16)(v & 0xffffu); Ks[(t + 1) * 136 + cch] = (u16)(v >> 16);
                }
#pragma unroll
                for (int i = 0; i < 4; ++i) { u32x4 v = {pkd[2 * i], pkd[2 * i + 1], pkd[8 + 2 * i], pkd[8 + 2 * i + 1]}; *(u32x4*)(KNTg + cch * 64 + 32 * th + 8 * i) = v; }
            }
        }
    }
    __syncthreads();
    int unit_l = unit, tid_l = tid_in;
    asm volatile("" : "+s"(unit_l)); asm volatile("" : "+v"(tid_l));
    {
    const int unit = unit_l, tid = tid_l, lane = tid & 63, wid = tid >> 6, l15 = lane & 15, quad = lane >> 4;
    if (tid < 128) {
        const int d = tid >> 6, t = tid & 63; float s = 0.f;
        if (d == 0) { for (int u = 0; u <= t; ++u) s += gs[u * 16 + 8 + h]; }
        else        { for (int u = t; u < 64; ++u) s += gs[u * 16 + 12 + h]; }
        gcs[d * 64 + t] = s;
    }
    __syncthreads();
    if (tid < 128) {
        const int d = tid >> 6, t = tid & 63;
        const float gc = gcs[d * 64 + t], gl = gcs[d * 64 + (d ? 0 : 63)], be = gs[t * 16 + d * 4 + h];
        rbs[d * 64 + t] = be; rbe[d * 64 + t] = be * __expf(gc);
        float* SC = (float*)(ws + OFF_SCAL) + ((size_t)d * NCU + unit) * 192;
        SC[t] = __expf(gc) * 0.08838834764831845f; SC[64 + t] = __expf(gl - gc);
        if (t == 0) SC[128] = __expf(gl);
    }
    if (!isctx) {
        f32x4 QK[4];
#pragma unroll
        for (int n = 0; n < 4; ++n) QK[n] = (f32x4){0.f, 0.f, 0.f, 0.f};
#pragma unroll
        for (int ks = 0; ks < 4; ++ks) {
            const bf16x8 aq = *(const bf16x8*)(Qs + (16 * wid + l15) * 136 + 32 * ks + 8 * quad);
#pragma unroll
            for (int n = 0; n < 4; ++n) {
                const bf16x8 bb = *(const bf16x8*)(Ks + (16 * n + l15) * 136 + 32 * ks + 8 * quad);
                QK[n] = MFMA16(aq, bb, QK[n]);
            }
        }
#pragma unroll
        for (int d = 0; d < 2; ++d) {
            u16* INg = (u16*)(ws + OFF_INTRA) + ((size_t)d * NCU + unit) * 4096;
#pragma unroll
            for (int n = 0; n < 4; ++n)
#pragma unroll
                for (int r = 0; r < 4; ++r) {
                    const int i = 16 * wid + 4 * quad + r, j = 16 * n + l15;
                    const bool keep = d ? (j >= i) : (j <= i);
                    const float iv = keep ? QK[n][r] * 0.08838834764831845f * __expf(gcs[d * 64 + i] - gcs[d * 64 + j]) : 0.f;
                    INg[i * 64 + permpos(j)] = f2bf(iv);
                }
        }
    }
    __syncthreads();
    {
        f32x4 G[4];
#pragma unroll
        for (int n = 0; n < 4; ++n) G[n] = (f32x4){0.f, 0.f, 0.f, 0.f};
#pragma unroll
        for (int ks = 0; ks < 4; ++ks) {
            const bf16x8 ak = *(const bf16x8*)(Ks + (16 * wid + l15) * 136 + 32 * ks + 8 * quad);
#pragma unroll
            for (int n = 0; n < 4; ++n) {
                const bf16x8 bb = *(const bf16x8*)(Ks + (16 * n + l15) * 136 + 32 * ks + 8 * quad);
                G[n] = MFMA16(ak, bb, G[n]);
            }
        }
        const int dd = __builtin_amdgcn_readfirstlane(tid >> 7), cc = tid & 127;
        float xwp[64];
#pragma unroll
        for (int ip = 0; ip < 64; ++ip) xwp[ip] = 0.f;
        if (dd == 0) {
#pragma unroll
            for (int ip = 0; ip < 64; ++ip) xwp[ip] = bf2f(Ks[ip * 136 + cc]) * rbe[ip];
        } else {
#pragma unroll
            for (int ip = 0; ip < 64; ++ip) xwp[ip] = bf2f(Ks[(63 - ip) * 136 + cc]) * rbe[64 + 63 - ip];
        }
        asm volatile("" ::: "memory");
        __syncthreads();
        float* Ls0 = (float*)lds; float* Ls1 = (float*)(lds + 17408);
#pragma unroll
        for (int d = 0; d < 2; ++d)
#pragma unroll
            for (int n = 0; n < 4; ++n)
#pragma unroll
                for (int r = 0; r < 4; ++r) {
                    const int i = 16 * wid + 4 * quad + r, j = 16 * n + l15;
                    const int ip = d ? 63 - i : i, jp = d ? 63 - j : j;
                    if (jp < ip) (d ? Ls1 : Ls0)[ip * 64 + jp] = rbs[d * 64 + i] * G[n][r] * __expf(gcs[d * 64 + i] - gcs[d * 64 + j]);
                }
        __syncthreads();
        const float* Lsel = dd ? Ls1 : Ls0;
        f2_t x2[64];
#pragma unroll
        for (int ip = 0; ip < 64; ++ip) x2[ip] = (f2_t){0.f, xwp[ip]};
        if (dd == 0) {
#pragma unroll
            for (int ip = 0; ip < 64; ++ip) x2[ip].x = stage[ip * 129 + cc] * rbs[ip];
        } else {
#pragma unroll
            for (int ip = 0; ip < 64; ++ip) x2[ip].x = stage[(63 - ip) * 129 + cc] * rbs[64 + 63 - ip];
        }
        asm volatile("" ::: "memory");
#pragma unroll
        for (int ip = 0; ip < 64; ++ip) {
            f2_t a2 = x2[ip];
#pragma unroll
            for (int jp = 0; jp < ip; ++jp) { const float l = Lsel[ip * 64 + jp]; a2 -= x2[jp] * l; if ((jp & 7) == 7) asm volatile("" ::: "memory"); }
            x2[ip] = a2;
            asm volatile("" ::: "memory");
        }
        {
            int unit_o = unit, cc_o = cc; asm volatile("" : "+s"(unit_o)); asm volatile("" : "+v"(cc_o));
            u16* WNg = (u16*)(ws + OFF_WNEG) + ((size_t)dd * NCU + unit_o) * 8192 + permpos(cc_o);
#pragma unroll
            for (int ip = 0; ip < 1; ++ip) {}
            if (dd == 0) {
#pragma unroll
                for (int ip = 0; ip < 64; ++ip) { WNg[ip * 128] = f2bf(-x2[ip].y); if ((ip & 7) == 7) asm volatile("" ::: "memory"); }
            } else {
#pragma unroll
                for (int ip = 0; ip < 64; ++ip) { WNg[(63 - ip) * 128] = f2bf(-x2[ip].y); if ((ip & 7) == 7) asm volatile("" ::: "memory"); }
            }
            asm volatile("" ::: "memory");
            u16* UTg = (u16*)(ws + OFF_UT) + ((size_t)dd * NCU + unit_o) * 8192 + cc_o * 64;
            if (dd == 0) {
#pragma unroll
                for (int i = 0; i < 8; ++i) { u32x4 v = {pk2(x2[8 * i].x, x2[8 * i + 1].x), pk2(x2[8 * i + 2].x, x2[8 * i + 3].x), pk2(x2[8 * i + 4].x, x2[8 * i + 5].x), pk2(x2[8 * i + 6].x, x2[8 * i + 7].x)}; *(u32x4*)(UTg + 8 * i) = v; }
            } else {
#pragma unroll
                for (int i = 0; i < 8; ++i) { u32x4 v = {pk2(x2[63 - 8 * i].x, x2[62 - 8 * i].x), pk2(x2[61 - 8 * i].x, x2[60 - 8 * i].x), pk2(x2[59 - 8 * i].x, x2[58 - 8 * i].x), pk2(x2[57 - 8 * i].x, x2[56 - 8 * i].x)}; *(u32x4*)(UTg + 8 * i) = v; }
            }
        }
        __syncthreads();
    }
    }
}

DI void gdn_scan_block(const Params& p, int sb, unsigned char* lds0, unsigned char* lds1, int role) {
    const int tid = (threadIdx.x & 255), lane = tid & 63, wid = tid >> 6, l15 = lane & 15, quad = lane >> 4;
    const int chain = sb >> 1, half = sb & 1, b = chain >> 3, h = (chain >> 1) & 3, d = chain & 1, slice = half * 4 + wid;
    unsigned char* ws = p.ws;
    if (role == 1) {
        u32x4 pre[16]; float presc = 0.f;
        auto issue = [&](int step) {
            const int ck = d ? (step < 4 ? 3 - step : 135 - step) : step;
            const size_t cu = (size_t)(b * NCK + ck) * 4 + h, dcu = (size_t)d * NCU + cu;
            const u32x4* WN = (const u32x4*)(ws + OFF_WNEG + dcu * 16384);
            const u32x4* QN = (const u32x4*)(ws + OFF_QN + cu * 16384);
            const u32x4* KT = (const u32x4*)(ws + OFF_KNT + cu * 16384);
            const u32x4* IN = (const u32x4*)(ws + OFF_INTRA + dcu * 8192);
            const u32x4* UT = (const u32x4*)(ws + OFF_UT + dcu * 16384 + (size_t)half * 8192);
            const float* SC = (const float*)(ws + OFF_SCAL) + dcu * 192;
#pragma unroll
            for (int i = 0; i < 4; ++i) { pre[i] = WN[tid + 256 * i]; pre[4 + i] = QN[tid + 256 * i]; pre[8 + i] = KT[tid + 256 * i]; }
#pragma unroll
            for (int i = 0; i < 2; ++i) { pre[12 + i] = IN[tid + 256 * i]; pre[14 + i] = UT[tid + 256 * i]; }
            if (tid < 192) presc = SC[tid];
        };
        auto commit = [&](unsigned char* L) {
#pragma unroll
            for (int i = 0; i < 4; ++i) {
                const int r16 = (tid >> 4) + 16 * i, c16 = tid & 15;
                *(u32x4*)(L + r16 * 272 + c16 * 16) = pre[i];
                *(u32x4*)(L + 17408 + r16 * 272 + c16 * 16) = pre[4 + i];
                const int r8 = (tid >> 3) + 32 * i, c8 = tid & 7;
                *(u32x4*)(L + 34816 + r8 * 144 + c8 * 16) = pre[8 + i];
            }
#pragma unroll
            for (int i = 0; i < 2; ++i) {
                const int r8 = (tid >> 3) + 32 * i, c8 = tid & 7;
                *(u32x4*)(L + 53248 + r8 * 144 + c8 * 16) = pre[12 + i];
                *(u32x4*)(L + 62464 + r8 * 144 + c8 * 16) = pre[14 + i];
            }
            if (tid < 192) ((float*)(L + 71680))[tid] = presc;
        };
        issue(0); commit(lds0); issue(1);
        __syncthreads();
        for (int step = 0; step < NCK; ++step) {
            if (step + 1 < NCK) { commit(((step + 1) & 1) ? lds1 : lds0); if (step + 2 < NCK) issue(step + 2); }
            __syncthreads();
        }
        return;
    }
    f32x4 S[8];
#pragma unroll
    for (int i = 0; i < 8; ++i) S[i] = (f32x4){0.f, 0.f, 0.f, 0.f};
    u16* Og = (u16*)(ws + OFF_O01) + (size_t)d * NLAT * 512;
    __syncthreads();
    for (int step = 0; step < NCK; ++step) {
        const int ck = d ? (step < 4 ? 3 - step : 135 - step) : step;
        const bool isctx = ck < 4;
        const unsigned char* L = (step & 1) ? lds1 : lds0;
        const u16* WNl = (const u16*)L; const u16* QNl = (const u16*)(L + 17408); const u16* KTl = (const u16*)(L + 34816); const u16* INl = (const u16*)(L + 53248); const u16* UTl = (const u16*)(L + 62464); const float* SCl = (const float*)(L + 71680);
        bf16x8 Sb[4];
#pragma unroll
        for (int ks = 0; ks < 4; ++ks) Sb[ks] = mk8(pk2(S[2 * ks][0], S[2 * ks][1]), pk2(S[2 * ks][2], S[2 * ks][3]), pk2(S[2 * ks + 1][0], S[2 * ks + 1][1]), pk2(S[2 * ks + 1][2], S[2 * ks + 1][3]));
        f32x4 vn[4], o[4];
#pragma unroll
        for (int mt = 0; mt < 4; ++mt) {
            const u32x2 raw = *(const u32x2*)(UTl + (16 * wid + l15) * 72 + 16 * mt + 4 * quad);
            vn[mt] = (f32x4){bflo(raw.x), bfhi(raw.x), bflo(raw.y), bfhi(raw.y)};
#pragma unroll
            for (int ks = 0; ks < 4; ++ks) {
                const bf16x8 a = *(const bf16x8*)(WNl + (16 * mt + l15) * 136 + 32 * ks + 8 * quad);
                vn[mt] = MFMA16(a, Sb[ks], vn[mt]);
            }
        }
        if (!isctx) {
#pragma unroll
            for (int mt = 0; mt < 4; ++mt) {
                o[mt] = (f32x4){0.f, 0.f, 0.f, 0.f};
#pragma unroll
                for (int ks = 0; ks < 4; ++ks) {
                    const bf16x8 a = *(const bf16x8*)(QNl + (16 * mt + l15) * 136 + 32 * ks + 8 * quad);
                    o[mt] = MFMA16(a, Sb[ks], o[mt]);
                }
                const f32x4 qs = *(const f32x4*)(SCl + 16 * mt + 4 * quad);
                o[mt] = o[mt] * qs;
            }
        }
        bf16x8 vb[2], vsb[2];
        {
            f32x4 kc[4];
#pragma unroll
            for (int mt = 0; mt < 4; ++mt) kc[mt] = *(const f32x4*)(SCl + 64 + 16 * mt + 4 * quad);
#pragma unroll
            for (int k2 = 0; k2 < 2; ++k2) {
                const f32x4 a = vn[2 * k2], c = vn[2 * k2 + 1];
                vb[k2] = mk8(pk2(a[0], a[1]), pk2(a[2], a[3]), pk2(c[0], c[1]), pk2(c[2], c[3]));
                const f32x4 as = a * kc[2 * k2], cs = c * kc[2 * k2 + 1];
                vsb[k2] = mk8(pk2(as[0], as[1]), pk2(as[2], as[3]), pk2(cs[0], cs[1]), pk2(cs[2], cs[3]));
            }
        }
        const float egl = SCl[128];
#pragma unroll
        for (int st = 0; st < 8; ++st) {
            S[st] = S[st] * egl;
#pragma unroll
            for (int k2 = 0; k2 < 2; ++k2) {
                const bf16x8 a = *(const bf16x8*)(KTl + (16 * st + l15) * 72 + 32 * k2 + 8 * quad);
                S[st] = MFMA16(a, vsb[k2], S[st]);
            }
        }
        if (!isctx) {
            const int tok0 = b * SEQ + (ck - 4) * 64;
#pragma unroll
            for (int mt = 0; mt < 4; ++mt) {
#pragma unroll
                for (int k2 = 0; k2 < 2; ++k2) {
                    const bf16x8 a = *(const bf16x8*)(INl + (16 * mt + l15) * 72 + 32 * k2 + 8 * quad);
                    o[mt] = MFMA16(a, vb[k2], o[mt]);
                }
#pragma unroll
                for (int r = 0; r < 4; ++r) Og[(size_t)(tok0 + 16 * mt + 4 * quad + r) * 512 + h * 128 + 16 * slice + l15] = f2bf(o[mt][r]);
            }
        }
        __syncthreads();
    }
}

DI void attn_unit(const Params& p, int P, int half, unsigned char* lds, float Mb) {
    const int tid = (threadIdx.x & 255), lane = tid & 63, wid = tid >> 6, l31 = lane & 31, hh = lane >> 5;
    const int kh = P & 3, qb = 2 * ((P >> 2) & 63) + half, bk = P >> 8, b = bk >> 1, kvh = bk & 1, head = kvh * 4 + wid;
    unsigned char* ws = p.ws;
    const u16* MIX = (const u16*)(ws + OFF_MIX);
    constexpr int NT = SKV / 64 / 4;
    const u16* Kg = (const u16*)(ws + OFF_K) + (size_t)bk * SKV * 64 + (size_t)kh * NT * 64 * 64;
    const u16* Vg = (const u16*)(ws + OFF_VT) + (size_t)bk * 64 * SKV + (size_t)kh * NT * 64;
    u16* Kl = (u16*)lds; u16* Vl = (u16*)(lds + 36864);
    const int tokA = b * SEQ + qb * 64 + l31;
    const size_t qrowA = (size_t)tokA * DM + head * 64, qrowB = qrowA + (size_t)32 * DM;
    bf16x8 qfA[4], qfB[4];
#pragma unroll
    for (int ks = 0; ks < 4; ++ks) { qfA[ks] = *(const bf16x8*)(MIX + qrowA + 16 * ks + 8 * hh); qfB[ks] = *(const bf16x8*)(MIX + qrowB + 16 * ks + 8 * hh); }
    f32x16 o0A, o1A, o0B, o1B; f2_t l2A = {0.f, 0.f}, l2B = {0.f, 0.f};
#pragma unroll
    for (int i = 0; i < 16; ++i) { o0A[i] = 0.f; o1A[i] = 0.f; o0B[i] = 0.f; o1B[i] = 0.f; }
    const bf16x8 ones = mk8(0x3f803f80u, 0x3f803f80u, 0x3f803f80u, 0x3f803f80u);
    int t5_ = (int)threadIdx.x; asm volatile("" : "+v"(t5_));
    const int lrow = t5_ >> 3, lcc = t5_ & 7;
    u32x4 rk, rv;
    rk = *(const u32x4*)(Kg + (size_t)lrow * 64 + lcc * 8); rv = *(const u32x4*)(Vg + (size_t)lrow * SKV + lcc * 8);
    __syncthreads();
    *(u32x4*)(Kl + lrow * 72 + lcc * 8) = rk; *(u32x4*)(Vl + lrow * 72 + lcc * 8) = rv;
    rk = *(const u32x4*)(Kg + (size_t)(64 + lrow) * 64 + lcc * 8); rv = *(const u32x4*)(Vg + (size_t)lrow * SKV + 64 + lcc * 8);
    __syncthreads();
    for (int kt = 0; kt < NT; ++kt) {
        const u16* Kc = Kl + (kt & 1) * 9216; const u16* Vc = Vl + (kt & 1) * 9216;
        if (kt + 1 < NT) {
            u16* Kn = Kl + ((kt + 1) & 1) * 9216; u16* Vn = Vl + ((kt + 1) & 1) * 9216;
            *(u32x4*)(Kn + lrow * 72 + lcc * 8) = rk; *(u32x4*)(Vn + lrow * 72 + lcc * 8) = rv;
        }
        if (kt + 2 < NT) { rk = *(const u32x4*)(Kg + (size_t)((kt + 2) * 64 + lrow) * 64 + lcc * 8); rv = *(const u32x4*)(Vg + (size_t)lrow * SKV + (kt + 2) * 64 + lcc * 8); }
#pragma unroll
        for (int sub = 0; sub < 2; ++sub) {
            f32x16 sA, sB;
#pragma unroll
            for (int i = 0; i < 16; ++i) { sA[i] = -Mb; sB[i] = -Mb; }
#pragma unroll
            for (int ks = 0; ks < 4; ++ks) {
                const bf16x8 kf = *(const bf16x8*)(Kc + (sub * 32 + l31) * 72 + 16 * ks + 8 * hh);
                sA = MFMA32(kf, qfA[ks], sA); sB = MFMA32(kf, qfB[ks], sB);
            }
#pragma unroll
            for (int i = 0; i < 16; ++i) { sA[i] = __builtin_amdgcn_exp2f(sA[i]); sB[i] = __builtin_amdgcn_exp2f(sB[i]); }
#pragma unroll
            for (int i = 0; i < 8; ++i) { l2A += (f2_t){sA[2 * i], sA[2 * i + 1]}; l2B += (f2_t){sB[2 * i], sB[2 * i + 1]}; }
#pragma unroll
            for (int sp = 0; sp < 2; ++sp) {
                const bf16x8 pA = mk8(pk2(sA[8 * sp], sA[8 * sp + 1]), pk2(sA[8 * sp + 2], sA[8 * sp + 3]), pk2(sA[8 * sp + 4], sA[8 * sp + 5]), pk2(sA[8 * sp + 6], sA[8 * sp + 7]));
                const bf16x8 pB = mk8(pk2(sB[8 * sp], sB[8 * sp + 1]), pk2(sB[8 * sp + 2], sB[8 * sp + 3]), pk2(sB[8 * sp + 4], sB[8 * sp + 5]), pk2(sB[8 * sp + 6], sB[8 * sp + 7]));
                const u16* v0 = Vc + l31 * 72 + sub * 32 + 16 * sp + 4 * hh;
                const bf16x8 vf0 = mk8(*(const u32x2*)v0, *(const u32x2*)(v0 + 8));
                const bf16x8 vf1 = mk8(*(const u32x2*)(v0 + 32 * 72), *(const u32x2*)(v0 + 32 * 72 + 8));
                o0A = MFMA32(vf0, pA, o0A); o0B = MFMA32(vf0, pB, o0B); o1A = MFMA32(vf1, pA, o1A); o1B = MFMA32(vf1, pB, o1B);
            }
        }
        __syncthreads();
    }
    float* LP = (float*)(ws + OFF_LP) + (size_t)kh * NLAT * 8;
    float lsA = l2A.x + l2A.y, lsB = l2B.x + l2B.y; lsA += __shfl_xor(lsA, 32); lsB += __shfl_xor(lsB, 32);
    int lane_o = lane; asm volatile("" : "+v"(lane_o));
    const int tokO = b * SEQ + qb * 64 + (lane_o & 31);
    if (hh == 0) { LP[(size_t)tokO * 8 + head] = lsA; LP[(size_t)(tokO + 32) * 8 + head] = lsB; }
    u16* OPA = (u16*)p.out + (size_t)kh * NLAT * 512 + (size_t)tokO * 512 + head * 64;
    u16* OPB = OPA + (size_t)32 * 512;
#pragma unroll
    for (int g = 0; g < 4; ++g) {
        { u32x2 w0 = {pk2(o0A[4 * g], o0A[4 * g + 1]), pk2(o0A[4 * g + 2], o0A[4 * g + 3])}; u32x2 w1 = {pk2(o1A[4 * g], o1A[4 * g + 1]), pk2(o1A[4 * g + 2], o1A[4 * g + 3])};
          *(u32x2*)(OPA + 8 * g + 4 * hh) = w0; *(u32x2*)(OPA + 32 + 8 * g + 4 * hh) = w1; }
        { u32x2 w0 = {pk2(o0B[4 * g], o0B[4 * g + 1]), pk2(o0B[4 * g + 2], o0B[4 * g + 3])}; u32x2 w1 = {pk2(o1B[4 * g], o1B[4 * g + 1]), pk2(o1B[4 * g + 2], o1B[4 * g + 3])};
          *(u32x2*)(OPB + 8 * g + 4 * hh) = w0; *(u32x2*)(OPB + 32 + 8 * g + 4 * hh) = w1; }
    }
}

namespace pg8 {
#define PG8_LAS __attribute__((address_space(3)))
typedef unsigned short bf16_t;
typedef short bf16x8 __attribute__((ext_vector_type(8)));
typedef float f32x4 __attribute__((ext_vector_type(4)));
typedef unsigned u32x4 __attribute__((ext_vector_type(4)));
constexpr int BM = 256, BK = 64, HALF = 128, HTB = HALF * BK * 2  , STAGE_BYTES = 8 * HTB, NXCD = 8, WGM = 8;

__host__ __device__ __forceinline__ int lds_byte(int r, int c) { const int st = (r >> 4) * 2 + (c >> 5), rr = r & 15, cc = c & 31, ob = rr * 64 + cc * 2; return st * 1024 + (ob ^ (((ob >> 9) & 1) << 5)); }
__host__ __device__ __forceinline__ void stage_rc(int b, int& R, int& C) { const int st = b / 1024, sb = b % 1024, swz = sb ^ (((sb >> 9) & 1) << 5); R = (st >> 1) * 16 + swz / 64; C = (st & 1) * 32 + (swz % 64) / 2; }
__host__ __device__ __forceinline__ int perm32(int rho) { const int n = rho >> 4, i = rho & 15; return 8 * (i >> 2) + 4 * n + (i & 3); }

struct Unit { int pm, pn; };
struct Gemm { const bf16_t* A; const bf16_t* Bt; int M, N, K; };

struct StaticOrder {
    int nM, nN, nwg, G, c;
    __host__ __device__ void init(int M, int N, int G_, int c_) { nM = M / BM; nN = N / BM; nwg = nM * nN; G = G_; c = c_; }
    __host__ __device__ bool next(int i, Unit& u) const {
        const long L = (long)i * G + c; if (L >= nwg) return false;
        int wgid = (int)L; { const int q = nwg / NXCD, r = nwg % NXCD, xcd = wgid % NXCD, off = wgid / NXCD; wgid = (xcd < r ? xcd * (q + 1) : r * (q + 1) + (xcd - r) * q) + off; }
        const int nig = WGM * nN, gid = wgid / nig, fm = gid * WGM, gsz = (nM - fm) < WGM ? (nM - fm) : WGM;
        u.pm = fm + ((wgid % nig) % gsz); u.pn = (wgid % nig) / gsz; return true;
    }
    __device__ __forceinline__ void a_ready(const Unit&) const {}
    __device__ __forceinline__ void done(const Unit&) const {}
};


template <class Epi, class Sched, bool ALIGN_EPI = false, bool SP2 = false>
__device__ __forceinline__ void gemm_phase(PG8_LAS unsigned char* lds, const Gemm g, const Sched& S, const Epi& E) {
    const int tid = threadIdx.x, wid = __builtin_amdgcn_readfirstlane(tid >> 6), lane = tid & 63, wr = wid >> 2, wc = wid & 3, fr = lane & 15, fq = lane >> 4;
    const int K = g.K, nt = K / BK;
    unsigned voffA[2], voffB[2];
#pragma unroll
    for (int i = 0; i < 2; ++i) { int R, C; stage_rc(tid * 16 + i * 8192, R, C); const int Rb = Epi::PERM ? ((R & ~31) + perm32(R & 31)) : R;
        voffA[i] = (unsigned)(R * K + C) * 2u; voffB[i] = (unsigned)(Rb * K + C) * 2u; }
    const size_t kstep = (size_t)(BK * 2);
    const size_t hstep = (size_t)HALF * K * 2;
    const size_t tstep = 2 * hstep;
    const unsigned ldsw = (unsigned)wid * 1024u;
    const int aoff = lds_byte(wr * 64 + fr, fq * 8), boff = lds_byte(wc * 32 + fr, fq * 8);
#define PG8_SA(b, h) (((b) * 2 + (h)) * HTB)
#define PG8_SB(b, h) ((4 + (b) * 2 + (h)) * HTB)
#define PG8_STAGE(bufoff, gbase, voff) do { _Pragma("unroll") for (int _i = 0; _i < 2; ++_i) \
        __builtin_amdgcn_global_load_lds((const unsigned*)((const char*)(gbase) + (voff)[_i]), (PG8_LAS unsigned*)(lds + (bufoff) + ldsw + _i * 8192), 16, 0, 0); } while (0)
#define PG8_LDA(dst, b, h) do { _Pragma("unroll") for (int m = 0; m < 4; ++m) _Pragma("unroll") for (int k = 0; k < 2; ++k) dst[m][k] = *(const PG8_LAS bf16x8*)(lds + PG8_SA(b, h) + aoff + m * 2048 + k * 1024); } while (0)
#define PG8_LDB(dst, b, h) do { _Pragma("unroll") for (int n = 0; n < 2; ++n) _Pragma("unroll") for (int k = 0; k < 2; ++k) dst[n][k] = *(const PG8_LAS bf16x8*)(lds + PG8_SB(b, h) + boff + n * 2048 + k * 1024); } while (0)
#define PG8_MMA(ai, bj, At, Bt) do { __builtin_amdgcn_s_setprio(1); _Pragma("unroll") for (int m = 0; m < 4; ++m) _Pragma("unroll") for (int n = 0; n < 2; ++n) _Pragma("unroll") for (int k = 0; k < 2; ++k) \
        acc[ai][bj][m][n] = __builtin_amdgcn_mfma_f32_16x16x32_bf16(Bt[n][k], At[m][k], acc[ai][bj][m][n], 0, 0, 0); __builtin_amdgcn_s_setprio(0); } while (0)
#define PG8_WAIT_V(n) asm volatile("s_waitcnt vmcnt(" #n ")" ::: "memory")
#define PG8_WAIT_L(n) asm volatile("s_waitcnt lgkmcnt(" #n ")" ::: "memory")
#define PG8_BAR __builtin_amdgcn_s_barrier()
#define PG8_SCHED __builtin_amdgcn_sched_barrier(0)
    Unit cur, nxt; int ui = 0;
    if (!S.next(0, cur)) return;
    f32x4 acc[2][2][4][2];
#pragma unroll
    for (int a = 0; a < 2; ++a)
#pragma unroll
        for (int b = 0; b < 2; ++b)
#pragma unroll
            for (int m = 0; m < 4; ++m)
#pragma unroll
                for (int n = 0; n < 2; ++n) acc[a][b][m][n] = (f32x4){0.f, 0.f, 0.f, 0.f};
    bf16x8 At[4][2], B0[2][2], B1[2][2];
    const char* cA = (const char*)g.A + (size_t)cur.pm * tstep; const char* cB = (const char*)g.Bt + (size_t)cur.pn * tstep;
    S.a_ready(cur);
    if constexpr (SP2) {
        PG8_STAGE(PG8_SB(0, 0), cB, voffB); PG8_STAGE(PG8_SB(0, 1), cB + hstep, voffB); PG8_STAGE(PG8_SA(0, 0), cA, voffA); PG8_STAGE(PG8_SA(0, 1), cA + hstep, voffA);
        if (wr == 1) PG8_BAR;
        PG8_WAIT_V(2); PG8_BAR;
        PG8_STAGE(PG8_SB(1, 0), cB + kstep, voffB); PG8_STAGE(PG8_SA(1, 0), cA + kstep, voffA); PG8_STAGE(PG8_SB(1, 1), cB + hstep + kstep, voffB);
        PG8_WAIT_V(6); PG8_BAR;
    } else {
        PG8_STAGE(PG8_SB(0, 0), cB, voffB); PG8_STAGE(PG8_SA(0, 0), cA, voffA); PG8_STAGE(PG8_SB(0, 1), cB + hstep, voffB); PG8_STAGE(PG8_SA(0, 1), cA + hstep, voffA);
        if (wr == 1) PG8_BAR;
        PG8_WAIT_V(4); PG8_BAR;
        PG8_STAGE(PG8_SB(1, 0), cB + kstep, voffB); PG8_STAGE(PG8_SA(1, 0), cA + kstep, voffA); PG8_STAGE(PG8_SB(1, 1), cB + hstep + kstep, voffB);
        PG8_WAIT_V(6); PG8_BAR;
    }
    for (;;) {
        const bool has_next = S.next(ui + 1, nxt);
        const char* nA = has_next ? (const char*)g.A + (size_t)nxt.pm * tstep : cA; const char* nB = has_next ? (const char*)g.Bt + (size_t)nxt.pn * tstep : cB;
        for (int t = 0; t < nt; t += 2) {
            const bool last = (t == nt - 2);
            const char* a1 = cA + (size_t)(t + 1) * kstep;
            const char* a2 = last ? nA : cA + (size_t)(t + 2) * kstep; const char* b2 = last ? nB : cB + (size_t)(t + 2) * kstep;
            const char* a3 = a2 + kstep; const char* b3 = b2 + kstep;
            if (last && has_next) S.a_ready(nxt);
            if constexpr (SP2) {
            PG8_LDB(B0, 0, 0); PG8_LDB(B1, 0, 1); PG8_SCHED; PG8_LDA(At, 0, 0); PG8_STAGE(PG8_SA(1, 1), a1 + hstep, voffA);
            PG8_WAIT_V(8); PG8_WAIT_L(0); PG8_BAR; PG8_MMA(0, 0, At, B0); PG8_MMA(0, 1, At, B1); PG8_BAR; PG8_SCHED;
            PG8_LDA(At, 0, 1); PG8_STAGE(PG8_SB(0, 0), b2, voffB); PG8_STAGE(PG8_SB(0, 1), b2 + hstep, voffB); PG8_STAGE(PG8_SA(0, 0), a2, voffA);
            PG8_WAIT_V(8); PG8_WAIT_L(0); PG8_BAR; PG8_MMA(1, 0, At, B0); PG8_MMA(1, 1, At, B1); PG8_BAR; PG8_SCHED;
            PG8_LDB(B0, 1, 0); PG8_LDB(B1, 1, 1); PG8_SCHED; PG8_LDA(At, 1, 0); PG8_STAGE(PG8_SA(0, 1), a2 + hstep, voffA);
            PG8_WAIT_V(8); PG8_WAIT_L(0); PG8_BAR; PG8_MMA(0, 0, At, B0); PG8_MMA(0, 1, At, B1); PG8_BAR; PG8_SCHED;
            PG8_LDA(At, 1, 1); PG8_STAGE(PG8_SB(1, 0), b3, voffB); PG8_STAGE(PG8_SB(1, 1), b3 + hstep, voffB); PG8_STAGE(PG8_SA(1, 0), a3, voffA);
            PG8_WAIT_V(8); PG8_WAIT_L(0); PG8_BAR; PG8_MMA(1, 0, At, B0); PG8_MMA(1, 1, At, B1); PG8_BAR; PG8_SCHED;
            } else {
            PG8_LDB(B0, 0, 0); PG8_SCHED; PG8_LDA(At, 0, 0); PG8_STAGE(PG8_SA(1, 1), a1 + hstep, voffA);
            PG8_WAIT_L(8); PG8_BAR; PG8_WAIT_L(0); PG8_MMA(0, 0, At, B0); PG8_BAR; PG8_SCHED;
            PG8_LDB(B1, 0, 1); PG8_STAGE(PG8_SB(0, 0), b2, voffB);
            PG8_BAR; PG8_WAIT_L(0); PG8_MMA(0, 1, At, B1); PG8_BAR;
            PG8_LDA(At, 0, 1); PG8_STAGE(PG8_SA(0, 0), a2, voffA);
            PG8_BAR; PG8_WAIT_L(0); PG8_MMA(1, 0, At, B0); PG8_BAR; PG8_SCHED;
            PG8_STAGE(PG8_SB(0, 1), b2 + hstep, voffB);
            PG8_WAIT_V(6); PG8_BAR; PG8_MMA(1, 1, At, B1); PG8_BAR;
            PG8_LDB(B0, 1, 0); PG8_SCHED; PG8_LDA(At, 1, 0); PG8_STAGE(PG8_SA(0, 1), a2 + hstep, voffA);
            PG8_WAIT_L(8); PG8_BAR; PG8_WAIT_L(0); PG8_MMA(0, 0, At, B0); PG8_BAR; PG8_SCHED;
            PG8_LDB(B1, 1, 1); PG8_STAGE(PG8_SB(1, 0), b3, voffB);
            PG8_BAR; PG8_WAIT_L(0); PG8_MMA(0, 1, At, B1); PG8_BAR;
            PG8_LDA(At, 1, 1); PG8_STAGE(PG8_SA(1, 0), a3, voffA);
            PG8_BAR; PG8_WAIT_L(0); PG8_MMA(1, 0, At, B0); PG8_BAR; PG8_SCHED;
            PG8_STAGE(PG8_SB(1, 1), b3 + hstep, voffB);
            PG8_WAIT_V(6); PG8_BAR; PG8_MMA(1, 1, At, B1); PG8_BAR;
            }
        }
        if constexpr (ALIGN_EPI) { if (wr == 0) PG8_BAR; }
        if constexpr (!Epi::AFTER_DRAIN) { E(acc, cur, wr, wc, fr, fq); S.done(cur); }
        if (!has_next) break;
#pragma unroll
        for (int a = 0; a < 2; ++a)
#pragma unroll
            for (int b = 0; b < 2; ++b)
#pragma unroll
                for (int m = 0; m < 4; ++m)
#pragma unroll
                    for (int n = 0; n < 2; ++n) acc[a][b][m][n] = (f32x4){0.f, 0.f, 0.f, 0.f};
        cur = nxt; cA = nA; cB = nB; ++ui;
        if constexpr (ALIGN_EPI) { if (wr == 1) PG8_BAR; }
    }
    PG8_WAIT_V(0);
    if constexpr (!ALIGN_EPI) { if (wr == 0) PG8_BAR; }
    PG8_BAR;
    if constexpr (Epi::AFTER_DRAIN) { E.fused(acc, cur, wr, wc, fr, fq, lds, wid, lane); S.done(cur); }
#undef PG8_SA
#undef PG8_SB
#undef PG8_STAGE
#undef PG8_LDA
#undef PG8_LDB
#undef PG8_MMA
#undef PG8_WAIT_V
#undef PG8_WAIT_L
#undef PG8_BAR
#undef PG8_SCHED
}

struct EpiRelu2 {
    static constexpr bool PERM = true, AFTER_DRAIN = false;
    bf16_t* O; int ldc;
    __device__ __forceinline__ void operator()(const f32x4 (&acc)[2][2][4][2], const Unit& u, int wr, int wc, int fr, int fq) const {
#pragma unroll
        for (int ai = 0; ai < 2; ++ai)
#pragma unroll
            for (int m = 0; m < 4; ++m) {
                bf16_t* rowp = O + (size_t)(u.pm * BM + ai * HALF + wr * 64 + m * 16 + fr) * ldc + u.pn * BM + wc * 32 + 8 * fq;
#pragma unroll
                for (int bj = 0; bj < 2; ++bj) {
                    f32x4 v0 = acc[ai][bj][m][0], v1 = acc[ai][bj][m][1];
#pragma unroll
                    for (int r = 0; r < 4; ++r) { const float a = fmaxf(v0[r], 0.f); v0[r] = a * a; const float c = fmaxf(v1[r], 0.f); v1[r] = c * c; }
                    u32x4 w = {::pk2(v0[0], v0[1]), ::pk2(v0[2], v0[3]), ::pk2(v1[0], v1[1]), ::pk2(v1[2], v1[3])};
                    *(u32x4*)(rowp + bj * HALF) = w;
                }
            }
    }
};
struct EpiGatedRes {
    static constexpr bool PERM = true, AFTER_DRAIN = false;
    const float* base; float* out; const float* gate; int gate_bstride; int ldc;
    __device__ __forceinline__ void operator()(const f32x4 (&acc)[2][2][4][2], const Unit& u, int wr, int wc, int fr, int fq) const {
        const float* g = gate + ((u.pm * BM) >> 13) * gate_bstride;
        const int col0 = u.pn * BM + wc * 32 + 8 * fq;
        f32x4 gv[2][2];
#pragma unroll
        for (int bj = 0; bj < 2; ++bj)
#pragma unroll
            for (int n = 0; n < 2; ++n) gv[bj][n] = *(const f32x4*)(g + col0 + bj * HALF + n * 4);
#pragma unroll
        for (int ai = 0; ai < 2; ++ai)
#pragma unroll
            for (int m = 0; m < 4; ++m) {
                const size_t off = (size_t)(u.pm * BM + ai * HALF + wr * 64 + m * 16 + fr) * ldc + col0;
#pragma unroll
                for (int bj = 0; bj < 2; ++bj)
#pragma unroll
                    for (int n = 0; n < 2; ++n) {
                        const f32x4 xv = *(const f32x4*)(base + off + bj * HALF + n * 4);
                        *(f32x4*)(out + off + bj * HALF + n * 4) = xv + gv[bj][n] * acc[ai][bj][m][n];
                    }
            }
    }
};
struct EpiInProj {
    static constexpr bool PERM = true, AFTER_DRAIN = false;
    bf16_t* MIX; bf16_t* Kb; bf16_t* Vt; bf16_t* DQ; float* GT; const float* a_log; const float* dt_bias;
    __device__ __forceinline__ void operator()(const f32x4 (&acc)[2][2][4][2], const Unit& u, int wr, int wc, int fr, int fq) const {
        const int pn = u.pn; const bool lat = u.pm < 64;
#pragma unroll
        for (int ai = 0; ai < 2; ++ai)
#pragma unroll
            for (int m = 0; m < 4; ++m) {
                const int gr = u.pm * BM + ai * HALF + wr * 64 + m * 16 + fr;
                int bb, kvpos;
                if (lat) { bb = gr >> 13; kvpos = 256 + (gr & 8191); } else { const int cr = gr - 16384; bb = cr >> 8; kvpos = cr & 255; }
#pragma unroll
                for (int bj = 0; bj < 2; ++bj) {
                    const int cl = bj * HALF + wc * 32 + 8 * fq;
                    const f32x4 v0 = acc[ai][bj][m][0], v1 = acc[ai][bj][m][1];
                    const u32x4 w = {::pk2(v0[0], v0[1]), ::pk2(v0[2], v0[3]), ::pk2(v1[0], v1[1]), ::pk2(v1[2], v1[3])};
                    if (pn < 2) { if (lat) *(u32x4*)(MIX + (size_t)gr * 1024 + pn * 256 + cl) = w; }
                    else if (pn == 2) {
                        if (bj == 0) { const int kvh = cl >> 6, d = cl & 63; *(u32x4*)(Kb + ((size_t)(bb * 2 + kvh) * 8448 + kvpos) * 64 + d) = w; }
                        else { const int c2 = cl - HALF, kvh = c2 >> 6, d = c2 & 63; bf16_t* vp = Vt + ((size_t)(bb * 2 + kvh) * 64 + d) * 8448 + kvpos;
#pragma unroll
                            for (int e = 0; e < 4; ++e) { vp[(2 * e) * 8448] = (bf16_t)(w[e] & 0xffffu); vp[(2 * e + 1) * 8448] = (bf16_t)(w[e] >> 16); } }
                    }
                    else if (pn < 9) *(u32x4*)(DQ + (size_t)gr * 1536 + (pn - 3) * 256 + cl) = w;
                    else { if (lat) *(u32x4*)(MIX + (size_t)gr * 1024 + 512 + (pn - 9) * 256 + cl) = w; }
                }
            }
    }
};
}

#define XB_TMO      128
#define XB_XCNT(j)  (256  + 64 * (j))
#define XB_XSUB(j)  (1280 + 64 * (j))
#define XB_XGEN(j)  (2304 + 64 * (j))
#define XB_TOP      3328
#define XB_TOPGEN   3392
#define XCD_BAR_WORDS 3456
#define XB_SPIN_CAP (1u << 22)
#define LAS __attribute__((address_space(3)))
DI unsigned xb_ld(unsigned* p)              { return __hip_atomic_load(p, __ATOMIC_RELAXED, __HIP_MEMORY_SCOPE_AGENT); }
DI unsigned xb_add(unsigned* p, unsigned v) { return __hip_atomic_fetch_add(p, v, __ATOMIC_RELAXED, __HIP_MEMORY_SCOPE_AGENT); }
DI unsigned xb_xcc_id() { return (unsigned)__builtin_amdgcn_s_getreg((3 << 11) | 20) & 0xFu; }
#define XB_SPIN(cond, bar) do { unsigned _sp = 0; while (cond) { __builtin_amdgcn_s_sleep(1); \
    if ((++_sp & 255u) == 0u) { if (xb_ld(&(bar)[XB_TMO])) break; if (_sp > XB_SPIN_CAP) { atomicAdd(&(bar)[XB_TMO], 1u); break; } } } } while (0)
struct XcdBarrier { unsigned* bar; unsigned x; volatile LAS unsigned* st; };
DI XcdBarrier xcd_barrier_post(unsigned* bar, volatile LAS unsigned* st) {
    XcdBarrier b; b.bar = bar; b.x = xb_xcc_id(); b.st = st;
    if (threadIdx.x == 0) (void)xb_add(&bar[XB_XCNT(b.x)], 1u);
    return b;
}
DI void xcd_barrier_complete(unsigned* bar, unsigned x, unsigned& nloc, unsigned& nx) {
    const unsigned G = gridDim.x * gridDim.y * gridDim.z;
    unsigned sum, cnt, mine, sp = 0u;
    for (;;) {
        sum = 0u; cnt = 0u; mine = 0u;
#pragma unroll
        for (unsigned j = 0; j < 16; ++j) { const unsigned c = xb_ld(&bar[XB_XCNT(j)]); sum += c; cnt += (c > 0u) ? 1u : 0u; mine = (j == x) ? c : mine; }
        if (sum == G) break;
        __builtin_amdgcn_s_sleep(1);
        if ((++sp & 255u) == 0u) { if (xb_ld(&bar[XB_TMO])) break; if (sp > XB_SPIN_CAP) { atomicAdd(&bar[XB_TMO], 1u); break; } }
    }
    nloc = mine > 0u ? mine : 1u; nx = cnt > 0u ? cnt : 1u;
}
DI void xcd_barrier(const XcdBarrier& b) {
    asm volatile("s_waitcnt vmcnt(0)" ::: "memory");
    __syncthreads();
    if (threadIdx.x == 0) {
        unsigned* bar = b.bar;
        __builtin_amdgcn_s_waitcnt(0);
        unsigned nloc = b.st[0], nx = b.st[1];
        if (nloc == 0u) { xcd_barrier_complete(bar, b.x, nloc, nx); b.st[0] = nloc; b.st[1] = nx; }
        const unsigned old = xb_add(&bar[XB_XSUB(b.x)], 1u);
        const unsigned gen = old / nloc;
        if (old + 1u == (gen + 1u) * nloc) {
            __builtin_amdgcn_fence(__ATOMIC_RELEASE, "agent");
            asm volatile("s_waitcnt vmcnt(0)" ::: "memory");
            const unsigned og = xb_add(&bar[XB_TOP], 1u);
            const unsigned tg = og / nx;
            if (og + 1u == (tg + 1u) * nx) xb_add(&bar[XB_TOPGEN], 1u);
            else XB_SPIN(xb_ld(&bar[XB_TOPGEN]) == tg, bar);
            __builtin_amdgcn_fence(__ATOMIC_ACQUIRE, "agent");
            xb_add(&bar[XB_XGEN(b.x)], 1u);
            asm volatile("s_waitcnt vmcnt(0)" ::: "memory");
        } else {
            XB_SPIN(xb_ld(&bar[XB_XGEN(b.x)]) == gen, bar);
            __builtin_amdgcn_fence(__ATOMIC_ACQUIRE, "agent");
            asm volatile("s_waitcnt vmcnt(0)" ::: "memory");
        }
    }
    __syncthreads();
}

__global__ void __launch_bounds__(512, 2) mega(Params p) {
    extern __shared__ __attribute__((aligned(16))) unsigned char lds_raw[];
    const int half = __builtin_amdgcn_readfirstlane(threadIdx.x >> 8);
    const int tid = threadIdx.x & 255, lane = tid & 63, wid = tid >> 6;
    const int nblk = gridDim.x * 2, bid = blockIdx.x * 2 + half;
    auto lwid = [&]() { int w_ = (int)((threadIdx.x & 255) >> 6); asm volatile("" : "+v"(w_)); return w_; };
    unsigned char* const lds_base = lds_raw; unsigned char* const lds = lds_raw + half * 73728;
    unsigned char* ws = p.ws;
    const int lo = p.ph_lo, hi = p.ph_hi;
#ifndef PH_MASK
#define PH_MASK 0x3ff
#endif
#define IN_PH(k) ((((PH_MASK) >> (k)) & 1) && lo <= (k) && (k) <= hi)
#define SEAM(k) do { if ((k) < hi) { xcd_barrier(xb); } } while (0)
    if (threadIdx.x < 4) ((volatile LAS unsigned*)(lds_base + 147456))[threadIdx.x] = 0u;
    __syncthreads();
    XcdBarrier xb = xcd_barrier_post((unsigned*)(ws + OFF_BAR), (volatile LAS unsigned*)(lds_base + 147456));
    if (hi > 1000) cg::this_grid().sync();
    float* MOD = (float*)(ws + OFF_MODZ);
    int* CNT = (int*)(ws + OFF_MISC);

    if (IN_PH(0)) {
        constexpr int T_MOD = 96 * 4;
        for (int t = bid; t < T_MOD + 2; t += nblk) {
            if (t < T_MOD) {
                const int j = t >> 2, kq = t & 3; float* sv = (float*)lds; float* red = sv + 768;
                __syncthreads();
                for (int i = tid; i < 768; i += 256) { const int which = i >> 8, k = kq * 256 + (i & 255); const float cv = which < 2 ? p.c[which * 1024 + k] : p.c_ctx[k]; sv[i] = silu_f(cv); }
                __syncthreads();
                const int col = j * 64 + lane; float a0 = 0.f, a1 = 0.f, a2 = 0.f;
#pragma unroll 8
                for (int k = 64 * wid; k < 64 * wid + 64; ++k) { const float wv = p.w_mod[(size_t)(kq * 256 + k) * 6144 + col]; a0 += sv[k] * wv; a1 += sv[256 + k] * wv; a2 += sv[512 + k] * wv; }
                red[(wid * 3 + 0) * 64 + lane] = a0; red[(wid * 3 + 1) * 64 + lane] = a1; red[(wid * 3 + 2) * 64 + lane] = a2;
                __syncthreads();
                if (tid < 192) { const int which = tid >> 6, cl = tid & 63; float sacc = kq == 0 ? p.b_mod[j * 64 + cl] : 0.f; for (int w = 0; w < 4; ++w) sacc += red[(w * 3 + which) * 64 + cl]; atomicAdd(&MOD[which * 6144 + j * 64 + cl], sacc); }
            } else if (t == T_MOD) {
                f2_t* RT = (f2_t*)(ws + OFF_ROPE);
                for (int i = tid; i < 2048; i += 256) {
                    const int pos = i >> 4, j = i & 15;
                    const float inv = exp2f(-(float)j * 0.8304820237218406f);
                    const float ang = (float)pos * inv;
                    const float n = rintf(ang * 0.15915494309189535f);
                    float r = fmaf(-n, 6.28125f, ang); r = fmaf(-n, 1.9353071795864769e-3f, r);
                    RT[i] = (f2_t){cosf(r), sinf(r)};
                }
            } else { if (tid == 0) CNT[0] = 0; }
        }
        for (int t = bid; t < 16 * (INP / 64); t += nblk) wconv_tile(p.w_in, DM, INC, INP, (u16*)(ws + OFF_WIN), t, (float*)lds);
        SEAM(0);
    }
    if (IN_PH(1)) {
        u16* H = (u16*)(ws + OFF_H);
        norm_rows([&](int r) { return r < NLAT ? p.x + (size_t)r * DM : p.ctx + (size_t)(r - NLAT) * DM; }, NROW, bid * 4 + lwid(), nblk * 4, p.norm1_w, MOD, 0, 1, H, lane);
        SEAM(1);
    }
    if (IN_PH(2)) {
        pg8::Gemm g{(const u16*)(ws + OFF_H), (const u16*)(ws + OFF_WIN), NROW, 2816, DM}; pg8::StaticOrder S; S.init(NROW, 2816, (int)gridDim.x, (int)blockIdx.x);
        pg8::EpiInProj E{(u16*)(ws + OFF_MIX), (u16*)(ws + OFF_K), (u16*)(ws + OFF_VT), (u16*)(ws + OFF_DQKV), (float*)(ws + OFF_GATE), p.a_log, p.dt_bias};
        pg8::gemm_phase<pg8::EpiInProj, pg8::StaticOrder, true, true>((PG8_LAS unsigned char*)lds_base, g, S, E);
        {
            const u16* H = (const u16*)(ws + OFF_H); const u16* Wg = (const u16*)(ws + OFF_WIN) + (size_t)2816 * DM; float* GT = (float*)(ws + OFF_GATE);
            const int l15 = lane & 15, quad = lane >> 4;
            for (int rb = (int)blockIdx.x * 8 + (int)(threadIdx.x >> 6); rb < NROW / 16; rb += (int)gridDim.x * 8) {
                f32x4 acc = {0.f, 0.f, 0.f, 0.f};
                const u16* ap = H + (size_t)(rb * 16 + l15) * DM + 8 * quad; const u16* bp = Wg + (size_t)l15 * DM + 8 * quad;
#pragma unroll 8
                for (int ks = 0; ks < 32; ++ks) acc = MFMA16(*(const bf16x8*)(ap + 32 * ks), *(const bf16x8*)(bp + 32 * ks), acc);
                const int ci = l15;
#pragma unroll
                for (int r = 0; r < 4; ++r) {
                    const float x = acc[r]; float o;
                    if (ci < 8) o = 1.f / (1.f + __expf(-x));
                    else { const float xx = x + p.dt_bias[ci - 8]; const float sp = xx > 20.f ? xx : log1pf(__expf(xx)); o = -__expf(p.a_log[ci - 8]) * sp; }
                    GT[(size_t)(rb * 16 + 4 * quad + r) * 16 + ci] = o;
                }
            }
        }
        SEAM(2);
    }
    if (IN_PH(3)) {
        if (bid < 32) { gdn_prep_unit(p, ((bid >> 4) * NCK + ((bid >> 2) & 3)) * 4 + (bid & 3), lds); } else {
        {
            u16* MIX = (u16*)(ws + OFF_MIX); u16* Kb = (u16*)(ws + OFF_K); const f2_t* RT = (const f2_t*)(ws + OFF_ROPE);
            const int l8 = lane & 7, sub = lane >> 3;
            for (int it = (bid - 32) * 4 + wid; it < NLAT + (NB * 2 * SKV) / 8; it += (nblk - 32) * 4) {
                u16* ptr; int t; bool rope; const float* nw; float scale;
                if (it < NLAT) { ptr = MIX + (size_t)it * DM + sub * 64 + l8 * 8; t = it & (SEQ - 1); rope = true; nw = p.q_norm_w; scale = QSCALE; }
                else { const int j = (it - NLAT) * 8 + sub, bk = j / SKV, pos = j - bk * SKV; ptr = Kb + ((size_t)bk * SKV + pos) * 64 + l8 * 8; rope = pos >= CTXL; t = pos >= CTXL ? pos - CTXL : 0; nw = p.k_norm_w; scale = 1.f; }
                const u32x4 raw = *(const u32x4*)ptr;
                float y[8];
#pragma unroll
                for (int e = 0; e < 4; ++e) { y[2 * e] = bflo(raw[e]); y[2 * e + 1] = bfhi(raw[e]); }
                float ss = 0.f;
#pragma unroll
                for (int e = 0; e < 8; ++e) ss += y[e] * y[e];
                ss += __shfl_xor(ss, 1); ss += __shfl_xor(ss, 2); ss += __shfl_xor(ss, 4);
                const float rinv = rsqrtf(ss * (1.f / 64.f) + EPS);
                const f32x4 wa = *(const f32x4*)(nw + 8 * l8), wb = *(const f32x4*)(nw + 8 * l8 + 4);
                const int ppos = (l8 & 4) ? (t & 63) : (t >> 6); const float sgn = (l8 & 2) ? 1.f : -1.f;
#pragma unroll
                for (int e = 0; e < 8; ++e) {
                    const float v = y[e] * rinv * (e < 4 ? wa[e] : wb[e - 4]);
                    const float pv = __shfl_xor(v, 2);
                    const f2_t cs = RT[ppos * 16 + 8 * (l8 & 1) + e];
                    const float vr = v * cs.x + sgn * pv * cs.y;
                    y[e] = (rope ? vr : v) * scale;
                }
                const u32x4 w = {pk2(y[0], y[1]), pk2(y[2], y[3]), pk2(y[4], y[5]), pk2(y[6], y[7])};
                *(u32x4*)ptr = w;
            }
        }
        constexpr int T_WO = 16 * 16, T_W1 = 16 * 64, T_W2 = 64 * 16;
        for (int t = bid - 32; t < T_WO + T_W1 + T_W2; t += nblk - 32) {
            if (t < T_WO) wconv_tile(p.w_out, DM, DM, DM, (u16*)(ws + OFF_WOUT), t, (float*)lds);
            else if (t < T_WO + T_W1) wconv_tile(p.w_mlp1, DM, DFF, DFF, (u16*)(ws + OFF_WM1), t - T_WO, (float*)lds);
            else wconv_tile(p.w_mlp2, DFF, DM, DM, (u16*)(ws + OFF_WM2), t - T_WO - T_W1, (float*)lds);
        }
        }
        for (int j = bid; j < 1024; j += nblk) gdn_prep_unit(p, ((j >> 9) * NCK + 4 + ((j & 511) >> 2)) * 4 + (j & 3), lds);
        SEAM(3);
    }
    if (IN_PH(4)) {
        if (blockIdx.x < 32) {
            gdn_scan_block(p, (int)blockIdx.x, lds_base, lds_base + 73728, half);
        }
        float Mb;
        { const float a = wave_max(fabsf(p.q_norm_w[lane])), bq = wave_max(fabsf(p.k_norm_w[lane])); Mb = 8.f * a * bq * 1.4426950408889634f; }
        int* su = (int*)(lds_base + 147456 + 8);
        for (;;) {
            __syncthreads();
            if (threadIdx.x == 0) *su = atomicAdd(CNT, 2);
            __syncthreads();
            const int u0 = *su;
            if (u0 >= 2048) break;
            attn_unit(p, u0 >> 1, half, lds_base, Mb);
        }
        SEAM(4);
    }
    if (IN_PH(5)) {
        const u16* O0 = (const u16*)(ws + OFF_O01); const u16* O1 = O0 + (size_t)NLAT * 512; u16* MIX = (u16*)(ws + OFF_MIX);
        const int e0 = (8 * lane) & 127;
        const f32x4 nwa = *(const f32x4*)(p.dn_norm_w + e0), nwb = *(const f32x4*)(p.dn_norm_w + e0 + 4);
        {
            const u16* PP = (const u16*)p.out; const float* LL = (const float*)(ws + OFF_LP);
            for (int r = bid * 4 + lwid(); r < NLAT; r += nblk * 4) {
                const size_t off = (size_t)r * 512 + 8 * lane;
                float acc[8] = {0.f, 0.f, 0.f, 0.f, 0.f, 0.f, 0.f, 0.f}; float lsum = 0.f;
#pragma unroll
                for (int q = 0; q < 4; ++q) {
                    const u32x4 a = *(const u32x4*)(PP + (size_t)q * NLAT * 512 + off);
                    lsum += LL[(size_t)q * NLAT * 8 + (size_t)r * 8 + (lane >> 3)];
#pragma unroll
                    for (int i = 0; i < 4; ++i) { acc[2 * i] += bflo(a[i]); acc[2 * i + 1] += bfhi(a[i]); }
                }
                const float inv = 1.f / lsum;
                u32x4 w = {pk2(acc[0] * inv, acc[1] * inv), pk2(acc[2] * inv, acc[3] * inv), pk2(acc[4] * inv, acc[5] * inv), pk2(acc[6] * inv, acc[7] * inv)};
                *(u32x4*)(MIX + (size_t)r * DM + 8 * lane) = w;
            }
        }
        int r = bid * 4 + lwid(); const int rs = nblk * 4;
        u32x4 na = {0u, 0u, 0u, 0u}, nc = na, nz = na;
        if (r < NLAT) { na = *(const u32x4*)(O0 + (size_t)r * 512 + 8 * lane); nc = *(const u32x4*)(O1 + (size_t)r * 512 + 8 * lane); nz = *(const u32x4*)(MIX + (size_t)r * DM + 512 + 8 * lane); }
        for (; r < NLAT; r += rs) {
            const u32x4 a = na, c = nc, z = nz;
            if (r + rs < NLAT) { const int r2 = r + rs; na = *(const u32x4*)(O0 + (size_t)r2 * 512 + 8 * lane); nc = *(const u32x4*)(O1 + (size_t)r2 * 512 + 8 * lane); nz = *(const u32x4*)(MIX + (size_t)r2 * DM + 512 + 8 * lane); }
            float o[8], zz[8];
#pragma unroll
            for (int i = 0; i < 4; ++i) { o[2 * i] = bflo(a[i]) + bflo(c[i]); o[2 * i + 1] = bfhi(a[i]) + bfhi(c[i]); zz[2 * i] = bflo(z[i]); zz[2 * i + 1] = bfhi(z[i]); }
            float ss = 0.f;
#pragma unroll
            for (int i = 0; i < 8; ++i) ss += o[i] * o[i];
            ss += __shfl_xor(ss, 1); ss += __shfl_xor(ss, 2); ss += __shfl_xor(ss, 4); ss += __shfl_xor(ss, 8);
            const float rinv = rsqrtf(ss * (1.f / 128.f) + EPS);
            float y[8];
#pragma unroll
            for (int i = 0; i < 8; ++i) y[i] = o[i] * rinv * (i < 4 ? nwa[i] : nwb[i - 4]) * silu_f(zz[i]);
            u32x4 w = {pk2(y[0], y[1]), pk2(y[2], y[3]), pk2(y[4], y[5]), pk2(y[6], y[7])};
            *(u32x4*)(MIX + (size_t)r * DM + 512 + 8 * lane) = w;
        }
        SEAM(5);
    }
    if (IN_PH(6)) {
        pg8::Gemm g{(const u16*)(ws + OFF_MIX), (const u16*)(ws + OFF_WOUT), NLAT, DM, DM}; pg8::StaticOrder S; S.init(NLAT, DM, (int)gridDim.x, (int)blockIdx.x);
        pg8::EpiGatedRes E{p.x, p.out, MOD + 2 * 1024, 6144, DM};
        pg8::gemm_phase<pg8::EpiGatedRes, pg8::StaticOrder, true, true>((PG8_LAS unsigned char*)lds_base, g, S, E);
        SEAM(6);
    }
    if (IN_PH(7)) {
        u16* H2 = (u16*)(ws + OFF_H2);
        norm_rows([&](int r) { return (const float*)p.out + (size_t)r * DM; }, NLAT, bid * 4 + lwid(), nblk * 4, p.norm2_w, MOD, 3, 4, H2, lane);
        SEAM(7);
    }
    if (IN_PH(8)) {
        pg8::Gemm g{(const u16*)(ws + OFF_H2), (const u16*)(ws + OFF_WM1), NLAT, DFF, DM}; pg8::StaticOrder S; S.init(NLAT, DFF, (int)gridDim.x, (int)blockIdx.x);
        pg8::EpiRelu2 E{(u16*)(ws + OFF_HID), DFF};
        pg8::gemm_phase<pg8::EpiRelu2, pg8::StaticOrder, true, true>((PG8_LAS unsigned char*)lds_base, g, S, E);
        SEAM(8);
    }
    if (IN_PH(9)) {
        pg8::Gemm g{(const u16*)(ws + OFF_HID), (const u16*)(ws + OFF_WM2), NLAT, DM, DFF}; pg8::StaticOrder S; S.init(NLAT, DM, (int)gridDim.x, (int)blockIdx.x);
        pg8::EpiGatedRes E{p.out, p.out, MOD + 5 * 1024, 6144, DM};
        pg8::gemm_phase<pg8::EpiGatedRes, pg8::StaticOrder, true, true>((PG8_LAS unsigned char*)lds_base, g, S, E);
    }
}

extern "C" void kernel_launch(void* const* d_in, const int* in_sizes, int n_in, void* d_out, int out_size, void* d_ws, size_t ws_size, hipStream_t stream) {
    static int grid = 0;
    if (grid == 0) {
        if (ws_size < WS_NEED) { fprintf(stderr, "kernel_launch: workspace too small (%zu < %zu)\n", ws_size, (size_t)WS_END); grid = -1; return; }
        int dev = 0, cus = 0, per_cu = 0;
        hipGetDevice(&dev);
        hipDeviceGetAttribute(&cus, hipDeviceAttributeMultiprocessorCount, dev);
        hipFuncSetAttribute((const void*)mega, hipFuncAttributeMaxDynamicSharedMemorySize, LDS_BYTES);
        hipOccupancyMaxActiveBlocksPerMultiprocessor(&per_cu, (const void*)mega, 512, LDS_BYTES);
        if (per_cu < 1) per_cu = 1;
        if (per_cu > 1) per_cu = 1;
        grid = cus * per_cu;
        fprintf(stderr, "kernel_launch: cus %d per_cu %d grid %d ws %zu need %zu\n", cus, per_cu, grid, ws_size, (size_t)WS_END);
    }
    if (grid < 0) return;
    if (hipMemsetAsync((unsigned char*)d_ws + OFF_BAR, 0, ZERO_BYTES, stream) != hipSuccess) { fprintf(stderr, "kernel_launch: memset of barrier words failed\n"); return; }
    Params p{};
    const float** pp = (const float**)&p;
    for (int i = 0; i < 18; ++i) pp[i] = (const float*)d_in[i];
    p.out = (float*)d_out; p.ws = (unsigned char*)d_ws;
#if ONE_LAUNCH
    p.ph_lo = 0; p.ph_hi = 9;
    void* args[] = {&p};
    hipError_t e = hipLaunchCooperativeKernel((const void*)mega, dim3(grid), dim3(512), args, LDS_BYTES, stream);
    if (e != hipSuccess) fprintf(stderr, "cooperative launch failed: %s (grid %d)\n", hipGetErrorString(e), grid);
#else
#ifndef DUP_PH
#define DUP_PH -1
#endif
    for (int ph = 0; ph <= 9; ++ph) {
        p.ph_lo = ph; p.ph_hi = ph;
        hipLaunchKernelGGL(mega, dim3(grid), dim3(512), LDS_BYTES, stream, p);
        if (ph == DUP_PH) hipLaunchKernelGGL(mega, dim3(grid), dim3(512), LDS_BYTES, stream, p);
    }
#endif
}
```

```cpp
#include <hip/hip_runtime.h>
#include <hip/hip_cooperative_groups.h>
#include <stdint.h>
#include <cstdio>
namespace cg = cooperative_groups;

#ifndef ONE_LAUNCH
#define ONE_LAUNCH 1
#endif

typedef unsigned short u16;
typedef __bf16 bf2_t __attribute__((ext_vector_type(2)));
typedef float f2_t __attribute__((ext_vector_type(2)));
typedef short bf16x8 __attribute__((ext_vector_type(8)));
typedef float f32x4 __attribute__((ext_vector_type(4)));
typedef float f32x16 __attribute__((ext_vector_type(16)));
typedef unsigned u32x2 __attribute__((ext_vector_type(2)));
typedef unsigned u32x4 __attribute__((ext_vector_type(4)));

#define DI __device__ __forceinline__
DI unsigned pk2(float lo, float hi) { f2_t v = {lo, hi}; return __builtin_bit_cast(unsigned, __builtin_convertvector(v, bf2_t)); }
DI u16 f2bf(float x) { return (u16)(pk2(x, 0.f) & 0xffffu); }
DI float bf2f(u16 v) { return __uint_as_float(((unsigned)v) << 16); }
DI float bflo(unsigned v) { return __uint_as_float(v << 16); }
DI float bfhi(unsigned v) { return __uint_as_float(v & 0xffff0000u); }
DI bf16x8 mk8(unsigned a, unsigned b, unsigned c, unsigned d) { u32x4 v = {a, b, c, d}; return __builtin_bit_cast(bf16x8, v); }
DI bf16x8 mk8(u32x2 lo, u32x2 hi) { u32x4 v = {lo.x, lo.y, hi.x, hi.y}; return __builtin_bit_cast(bf16x8, v); }
#define MFMA16(a, b, c) __builtin_amdgcn_mfma_f32_16x16x32_bf16((a), (b), (c), 0, 0, 0)
#define MFMA32(a, b, c) __builtin_amdgcn_mfma_f32_32x32x16_bf16((a), (b), (c), 0, 0, 0)

constexpr int DM = 1024, NB = 2, SEQ = 8192, NLAT = NB * SEQ, CTXL = 256, NCTX = NB * CTXL, NROW = NLAT + NCTX;
constexpr int INC = 2832, INP = 3072, DFF = 4096, SKV = CTXL + SEQ;
constexpr int NCK = 132;
constexpr int NCU = NB * NCK * 4;
constexpr float EPS = 1e-6f;
constexpr float QSCALE = 0.125f * 1.4426950408889634f;

constexpr size_t OFF_WIN = 0;
constexpr size_t OFF_MOD = OFF_WIN + (size_t)INP * DM * 2;
constexpr size_t OFF_ROPE = OFF_MOD + 3 * 6144 * 4;
constexpr size_t OFF_MISC = OFF_ROPE + 128 * 16 * 8;
constexpr size_t OFF_H = OFF_MISC + 256;
constexpr size_t OFF_WOUT = OFF_H;
constexpr size_t OFF_WM1 = OFF_WOUT + (size_t)DM * DM * 2;
constexpr size_t OFF_WM2 = OFF_WM1 + (size_t)DFF * DM * 2;
constexpr size_t OFF_DQKV = OFF_H + (size_t)NROW * DM * 2;
constexpr size_t OFF_O01 = OFF_DQKV;
constexpr size_t OFF_H2 = OFF_DQKV;
constexpr size_t OFF_MIX = OFF_DQKV + (size_t)NROW * 1536 * 2;
constexpr size_t OFF_HID = OFF_MIX;
constexpr size_t OFF_K = OFF_MIX + (size_t)NLAT * DM * 2;
constexpr size_t OFF_VT = OFF_K + (size_t)NB * 2 * SKV * 64 * 2;
constexpr size_t OFF_GATE = OFF_VT + (size_t)NB * 2 * SKV * 64 * 2;
constexpr size_t OFF_QN = OFF_GATE + (size_t)NROW * 16 * 4;
constexpr size_t OFF_KNT = OFF_QN + (size_t)NCU * 8192 * 2;
constexpr size_t OFF_WNEG = OFF_KNT + (size_t)NCU * 8192 * 2;
constexpr size_t OFF_UT = OFF_WNEG + (size_t)2 * NCU * 8192 * 2;
constexpr size_t OFF_INTRA = OFF_UT + (size_t)2 * NCU * 8192 * 2;
constexpr size_t OFF_SCAL = OFF_INTRA + (size_t)2 * NCU * 4096 * 2;
constexpr size_t WS_END = OFF_SCAL + (size_t)2 * NCU * 192 * 4;
static_assert(OFF_HID + (size_t)NLAT * DFF * 2 <= WS_END, "hid overlay");
static_assert(WS_END + 16384 + 3 * 6144 * 4 + 4 * 16384 * 8 * 4 <= (size_t)256 * 1024 * 1024, "ws budget");

constexpr int LDS_BYTES = 2 * 73728 + 16;
constexpr size_t OFF_BAR = WS_END;
constexpr size_t OFF_MODZ = OFF_BAR + 16384;
constexpr size_t ZERO_BYTES = 16384 + 3 * 6144 * 4;
constexpr size_t OFF_LP = OFF_MODZ + 3 * 6144 * 4;
constexpr size_t WS_NEED = OFF_LP + (size_t)4 * NLAT * 8 * 4;


struct Params {
    const float *x, *c, *ctx, *c_ctx, *w_mod, *b_mod, *norm1_w, *w_in, *q_norm_w, *k_norm_w, *conv_w, *a_log, *dt_bias, *dn_norm_w, *w_out, *norm2_w, *w_mlp1, *w_mlp2;
    float* out; unsigned char* ws; int ph_lo, ph_hi;
};

DI void wconv_tile(const float* __restrict__ W, int K, int N, int Npad, u16* __restrict__ Wt, int tile, float* st) {
    const int ntn = Npad / 64, kt = tile / ntn, nt = tile % ntn, k0 = kt * 64, n0 = nt * 64;
    const int tid = (threadIdx.x & 255), c = tid & 63, r4 = tid >> 6;
    __syncthreads();
#pragma unroll 4
    for (int i = 0; i < 16; ++i) { const int k = i * 4 + r4, n = n0 + c; st[k * 65 + c] = (n < N) ? W[(size_t)(k0 + k) * N + n] : 0.f; }
    __syncthreads();
#pragma unroll 4
    for (int i = 0; i < 16; ++i) { const int n = i * 4 + r4; Wt[(size_t)(n0 + n) * K + k0 + c] = f2bf(st[c * 65 + n]); }
}

template <class Epi>
DI void gemm_tile(const u16* __restrict__ A, int lda, const u16* __restrict__ Bt, int ldb, int K, int m0, int n0, unsigned char* lds, Epi&& epi) {
    const int tid = (threadIdx.x & 255), lane = tid & 63, wid = tid >> 6, wr = wid >> 1, wc = wid & 1, l15 = lane & 15, quad = lane >> 4;
    u16* As = (u16*)lds; u16* Bs = (u16*)(lds + 18432);
    f32x4 acc[4][4];
#pragma unroll
    for (int m = 0; m < 4; ++m)
#pragma unroll
        for (int n = 0; n < 4; ++n) acc[m][n] = (f32x4){0.f, 0.f, 0.f, 0.f};
    u32x4 ra[4], rb[4];
    const int lrow = tid >> 3, lcc = tid & 7;
    const u16* Ap = A + (size_t)(m0 + lrow) * lda + lcc * 8;
    const u16* Bp = Bt + (size_t)(n0 + lrow) * ldb + lcc * 8;
    const int nk = K / 64;
#pragma unroll
    for (int i = 0; i < 4; ++i) { ra[i] = *(const u32x4*)(Ap + (size_t)(32 * i) * lda); rb[i] = *(const u32x4*)(Bp + (size_t)(32 * i) * ldb); }
    __syncthreads();
#pragma unroll
    for (int i = 0; i < 4; ++i) { *(u32x4*)(As + (lrow + 32 * i) * 72 + lcc * 8) = ra[i]; *(u32x4*)(Bs + (lrow + 32 * i) * 72 + lcc * 8) = rb[i]; }
#pragma unroll
    for (int i = 0; i < 4; ++i) { ra[i] = *(const u32x4*)(Ap + (size_t)(32 * i) * lda + 64); rb[i] = *(const u32x4*)(Bp + (size_t)(32 * i) * ldb + 64); }
    __syncthreads();
    for (int kt = 0; kt < nk; ++kt) {
        const u16* Ac = As + (kt & 1) * 18432; const u16* Bc = Bs + (kt & 1) * 18432;
        if (kt + 1 < nk) {
            u16* An = As + ((kt + 1) & 1) * 18432; u16* Bn = Bs + ((kt + 1) & 1) * 18432;
#pragma unroll
            for (int i = 0; i < 4; ++i) { *(u32x4*)(An + (lrow + 32 * i) * 72 + lcc * 8) = ra[i]; *(u32x4*)(Bn + (lrow + 32 * i) * 72 + lcc * 8) = rb[i]; }
        }
        if (kt + 2 < nk) {
#pragma unroll
            for (int i = 0; i < 4; ++i) { ra[i] = *(const u32x4*)(Ap + (size_t)(32 * i) * lda + (kt + 2) * 64); rb[i] = *(const u32x4*)(Bp + (size_t)(32 * i) * ldb + (kt + 2) * 64); }
        }
#pragma unroll
        for (int ks = 0; ks < 2; ++ks) {
            bf16x8 af[4], bfr[4];
#pragma unroll
            for (int m = 0; m < 4; ++m) af[m] = *(const bf16x8*)(Ac + (64 * wr + 16 * m + l15) * 72 + 32 * ks + 8 * quad);
#pragma unroll
            for (int n = 0; n < 4; ++n) bfr[n] = *(const bf16x8*)(Bc + (64 * wc + 16 * n + l15) * 72 + 32 * ks + 8 * quad);
#pragma unroll
            for (int m = 0; m < 4; ++m)
#pragma unroll
                for (int n = 0; n < 4; ++n) acc[m][n] = MFMA16(bfr[n], af[m], acc[m][n]);
        }
        __syncthreads();
    }
    epi(acc, m0 + 64 * wr, n0 + 64 * wc, l15, quad);
}

DI float silu_f(float v) { return v / (1.f + __expf(-v)); }
DI int permpos(int c) { const int k = c & 31; return (c & ~31) | (8 * ((k & 15) >> 2) + 4 * (k >> 4) + (k & 3)); }
DI float wave_max(float v) {
#pragma unroll
    for (int o = 32; o > 0; o >>= 1) v = fmaxf(v, __shfl_xor(v, o));
    return v;
}
DI float wave_sum(float v) {
#pragma unroll
    for (int o = 32; o > 0; o >>= 1) v += __shfl_xor(v, o);
    return v;
}

template <class SrcF>
DI void norm_rows(SrcF srcf, int nrows, int row0, int rstride, const float* __restrict__ nw, const float* __restrict__ MOD, int shift_idx, int scale_idx, u16* __restrict__ dst, int lane) {
    f32x4 w[4], sh[4], sc[4]; int cur = -1;
    f32x4 v[4], nx[4];
    int r = row0;
    if (r < nrows) {
        const float* src = srcf(r);
#pragma unroll
        for (int i = 0; i < 4; ++i) nx[i] = *(const f32x4*)(src + 4 * lane + 256 * i);
    }
    for (; r < nrows; r += rstride) {
#pragma unroll
        for (int i = 0; i < 4; ++i) v[i] = nx[i];
        if (r + rstride < nrows) {
            const float* src = srcf(r + rstride);
#pragma unroll
            for (int i = 0; i < 4; ++i) nx[i] = *(const f32x4*)(src + 4 * lane + 256 * i);
        }
        const int which = r < NLAT ? (r >> 13) : 2;
        if (which != cur) {
            cur = which;
#pragma unroll
            for (int i = 0; i < 4; ++i) {
                const int c = 4 * lane + 256 * i;
                w[i] = *(const f32x4*)(nw + c); sh[i] = *(const f32x4*)(MOD + which * 6144 + shift_idx * 1024 + c); sc[i] = *(const f32x4*)(MOD + which * 6144 + scale_idx * 1024 + c);
                w[i] = w[i] * (sc[i] + 1.f);
            }
        }
        float ss = 0.f;
#pragma unroll
        for (int i = 0; i < 4; ++i) ss += v[i][0] * v[i][0] + v[i][1] * v[i][1] + v[i][2] * v[i][2] + v[i][3] * v[i][3];
        ss = wave_sum(ss);
        const float rinv = rsqrtf(ss * (1.f / 1024.f) + EPS);
#pragma unroll
        for (int i = 0; i < 4; ++i) {
            const f32x4 yv = v[i] * rinv * w[i] + sh[i];
            u32x2 o = {pk2(yv[0], yv[1]), pk2(yv[2], yv[3])};
            *(u32x2*)(dst + (size_t)r * DM + 4 * lane + 256 * i) = o;
        }
    }
}

DI void gdn_prep_unit(const Params& p, int unit, unsigned char* lds) {
    int tid_in = (threadIdx.x & 255); asm volatile("" : "+v"(tid_in));
    const int tid = tid_in, lane = tid & 63, wid = tid >> 6, l15 = lane & 15, quad = lane >> 4;
    const int h = unit & 3, bc = unit >> 2, b = bc / NCK, ck = bc % NCK;
    const bool isctx = ck < 4;
    const int seqlen = isctx ? CTXL : SEQ;
    const int c0 = isctx ? ck * 64 : (ck - 4) * 64;
    const int rowbase = isctx ? (NLAT + b * CTXL) : b * SEQ;
    unsigned char* ws = p.ws;
    const u16* DQ = (const u16*)(ws + OFF_DQKV);
    const float* GT = (const float*)(ws + OFF_GATE);
    u16* Qs = (u16*)lds; u16* Ks = (u16*)(lds + 17408); float* stage = (float*)(lds + 34816);
    float* gs = (float*)(lds + 67840); float* gcs = (float*)(lds + 71936); float* rbs = (float*)(lds + 72448); float* rbe = (float*)(lds + 72960); float* rn = (float*)(lds + 73472);
    u16* QNg = (u16*)(ws + OFF_QN) + (size_t)unit * 8192;
    u16* KNTg = (u16*)(ws + OFF_KNT) + (size_t)unit * 8192;
    __syncthreads();
    {
        const int t = tid >> 2, q4 = tid & 3;
        *(f32x4*)(gs + t * 16 + q4 * 4) = *(const f32x4*)(GT + (size_t)(rowbase + c0 + t) * 16 + q4 * 4);
    }
    const int cch = tid & 127, th = tid >> 7;
    float* part = rbs;
    u32x4 rawreg[5];
    auto raw_fetch = [&](int wh) {
#pragma unroll
        for (int i = 0; i < 5; ++i) {
            const int idx = tid + 256 * i; const int row = idx >> 4, cc = idx & 15, s = c0 - 2 + row;
            u32x4 v = {0u, 0u, 0u, 0u};
            if (idx < 68 * 16 && s >= 0 && s < seqlen) v = *(const u32x4*)(DQ + (size_t)(rowbase + s) * 1536 + wh * 512 + h * 128 + cc * 8);
            rawreg[i] = v;
        }
    };
    raw_fetch(2);
#pragma unroll 1
    for (int wi = 0; wi < 3; ++wi) {
        const int which = wi == 0 ? 2 : wi - 1;
        if (isctx && wi == 1) continue;
        u16* raw = (wi == 0) ? Qs : Ks;
        __syncthreads();
#pragma unroll
        for (int i = 0; i < 5; ++i) {
            const int idx = tid + 256 * i;
            if (idx < 68 * 16) { const int row = idx >> 4, cc = idx & 15; *(u32x4*)(raw + row * 128 + cc * 8) = rawreg[i]; }
        }
        if (wi < 2) raw_fetch((isctx || wi == 1) ? 1 : 0);
        const int col = which * 512 + h * 128 + cch;
        const float w0 = p.conv_w[0 * 1536 + col], w1 = p.conv_w[1 * 1536 + col], w2 = p.conv_w[2 * 1536 + col], w3 = p.conv_w[3 * 1536 + col], w4 = p.conv_w[4 * 1536 + col];
        __syncthreads();
        float y[32];
        {
            const u16* rp = raw + (32 * th) * 128 + cch;
            float xa = bf2f(rp[0]), xb = bf2f(rp[128]), xc = bf2f(rp[256]), xd = bf2f(rp[384]);
#pragma unroll
            for (int i = 0; i < 32; ++i) {
                const float xe = bf2f(rp[(i + 4) * 128]);
                y[i] = silu_f(w0 * xa + w1 * xb + w2 * xc + w3 * xd + w4 * xe);
                xa = xb; xb = xc; xc = xd; xd = xe;
            }
        }
        if (which == 2) {
#pragma unroll
            for (int i = 0; i < 32; ++i) stage[(32 * th + i) * 129 + cch] = y[i];
        } else {
            float mine = 0.f;
#pragma unroll
            for (int i = 0; i < 32; ++i) { const float ssum = wave_sum(y[i] * y[i]); if (lane == i) mine = ssum; }
            if (lane < 32) part[wid * 32 + lane] = mine;
            __syncthreads();
            if (which == 0) {
#pragma unroll
                for (int i = 0; i < 32; ++i) {
                    const int t = 32 * th + i; const float rinv = rsqrtf(part[(2 * th) * 32 + i] + part[(2 * th + 1) * 32 + i] + EPS);
                    const u16 v = f2bf(y[i] * rinv); Qs[t * 136 + cch] = v; QNg[t * 128 + permpos(cch)] = v;
                }
            } else {
                unsigned pkd[16];
#pragma unroll
                for (int i = 0; i < 16; ++i) {
                    const int t = 32 * th + 2 * i;
                    const float r0 = rsqrtf(part[(2 * th) * 32 + 2 * i] + part[(2 * th + 1) * 32 + 2 * i] + EPS), r1 = rsqrtf(part[(2 * th) * 32 + 2 * i + 1] + part[(2 * th + 1) * 32 + 2 * i + 1] + EPS);
                    const unsigned v = pk2(y[2 * i] * r0, y[2 * i + 1] * r1); pkd[i] = v;
                    Ks[t * 136 + cch] = (u16)(v & 0xffffu); Ks[(t + 1) * 136 + cch] = (u16)(v >> 16);
                }
#pragma unroll
                for (int i = 0; i < 4; ++i) { u32x4 v = {pkd[2 * i], pkd[2 * i + 1], pkd[8 + 2 * i], pkd[8 + 2 * i + 1]}; *(u32x4*)(KNTg + cch * 64 + 32 * th + 8 * i) = v; }
            }
        }
    }
    __syncthreads();
    int unit_l = unit, tid_l = tid_in;
    asm volatile("" : "+s"(unit_l)); asm volatile("" : "+v"(tid_l));
    {
    const int unit = unit_l, tid = tid_l, lane = tid & 63, wid = tid >> 6, l15 = lane & 15, quad = lane >> 4;
    if (tid < 128) {
        const int d = tid >> 6, t = tid & 63; float s = 0.f;
        if (d == 0) { for (int u = 0; u <= t; ++u) s += gs[u * 16 + 8 + h]; }
        else        { for (int u = t; u < 64; ++u) s += gs[u * 16 + 12 + h]; }
        gcs[d * 64 + t] = s;
    }
    __syncthreads();
    if (tid < 128) {
        const int d = tid >> 6, t = tid & 63;
        const float gc = gcs[d * 64 + t], gl = gcs[d * 64 + (d ? 0 : 63)], be = gs[t * 16 + d * 4 + h];
        rbs[d * 64 + t] = be; rbe[d * 64 + t] = be * __expf(gc);
        float* SC = (float*)(ws + OFF_SCAL) + ((size_t)d * NCU + unit) * 192;
        SC[t] = __expf(gc) * 0.08838834764831845f; SC[64 + t] = __expf(gl - gc);
        if (t == 0) SC[128] = __expf(gl);
    }
    if (!isctx) {
        f32x4 QK[4];
#pragma unroll
        for (int n = 0; n < 4; ++n) QK[n] = (f32x4){0.f, 0.f, 0.f, 0.f};
#pragma unroll
        for (int ks = 0; ks < 4; ++ks) {
            const bf16x8 aq = *(const bf16x8*)(Qs + (16 * wid + l15) * 136 + 32 * ks + 8 * quad);
#pragma unroll
            for (int n = 0; n < 4; ++n) {
                const bf16x8 bb = *(const bf16x8*)(Ks + (16 * n + l15) * 136 + 32 * ks + 8 * quad);
                QK[n] = MFMA16(aq, bb, QK[n]);
            }
        }
#pragma unroll
        for (int d = 0; d < 2; ++d) {
            u16* INg = (u16*)(ws + OFF_INTRA) + ((size_t)d * NCU + unit) * 4096;
#pragma unroll
            for (int n = 0; n < 4; ++n)
#pragma unroll
                for (int r = 0; r < 4; ++r) {
                    const int i = 16 * wid + 4 * quad + r, j = 16 * n + l15;
                    const bool keep = d ? (j >= i) : (j <= i);
                    const float iv = keep ? QK[n][r] * 0.08838834764831845f * __expf(gcs[d * 64 + i] - gcs[d * 64 + j]) : 0.f;
                    INg[i * 64 + permpos(j)] = f2bf(iv);
                }
        }
    }
    __syncthreads();
    {
        f32x4 G[4];
#pragma unroll
        for (int n = 0; n < 4; ++n) G[n] = (f32x4){0.f, 0.f, 0.f, 0.f};
#pragma unroll
        for (int ks = 0; ks < 4; ++ks) {
            const bf16x8 ak = *(const bf16x8*)(Ks + (16 * wid + l15) * 136 + 32 * ks + 8 * quad);
#pragma unroll
            for (int n = 0; n < 4; ++n) {
                const bf16x8 bb = *(const bf16x8*)(Ks + (16 * n + l15) * 136 + 32 * ks + 8 * quad);
                G[n] = MFMA16(ak, bb, G[n]);
            }
        }
        const int dd = __builtin_amdgcn_readfirstlane(tid >> 7), cc = tid & 127;
        float xwp[64];
#pragma unroll
        for (int ip = 0; ip < 64; ++ip) xwp[ip] = 0.f;
        if (dd == 0) {
#pragma unroll
            for (int ip = 0; ip < 64; ++ip) xwp[ip] = bf2f(Ks[ip * 136 + cc]) * rbe[ip];
        } else {
#pragma unroll
            for (int ip = 0; ip < 64; ++ip) xwp[ip] = bf2f(Ks[(63 - ip) * 136 + cc]) * rbe[64 + 63 - ip];
        }
        asm volatile("" ::: "memory");
        __syncthreads();
        float* Ls0 = (float*)lds; float* Ls1 = (float*)(lds + 17408);
#pragma unroll
        for (int d = 0; d < 2; ++d)
#pragma unroll
            for (int n = 0; n < 4; ++n)
#pragma unroll
                for (int r = 0; r < 4; ++r) {
                    const int i = 16 * wid + 4 * quad + r, j = 16 * n + l15;
                    const int ip = d ? 63 - i : i, jp = d ? 63 - j : j;
                    if (jp < ip) (d ? Ls1 : Ls0)[ip * 64 + jp] = rbs[d * 64 + i] * G[n][r] * __expf(gcs[d * 64 + i] - gcs[d * 64 + j]);
                }
        __syncthreads();
        const float* Lsel = dd ? Ls1 : Ls0;
        f2_t x2[64];
#pragma unroll
        for (int ip = 0; ip < 64; ++ip) x2[ip] = (f2_t){0.f, xwp[ip]};
        if (dd == 0) {
#pragma unroll
            for (int ip = 0; ip < 64; ++ip) x2[ip].x = stage[ip * 129 + cc] * rbs[ip];
        } else {
#pragma unroll
            for (int ip = 0; ip < 64; ++ip) x2[ip].x = stage[(63 - ip) * 129 + cc] * rbs[64 + 63 - ip];
        }
        asm volatile("" ::: "memory");
#pragma unroll
        for (int ip = 0; ip < 64; ++ip) {
            f2_t a2 = x2[ip];
#pragma unroll
            for (int jp = 0; jp < ip; ++jp) { const float l = Lsel[ip * 64 + jp]; a2 -= x2[jp] * l; if ((jp & 7) == 7) asm volatile("" ::: "memory"); }
            x2[ip] = a2;
            asm volatile("" ::: "memory");
        }
        {
            int unit_o = unit, cc_o = cc; asm volatile("" : "+s"(unit_o)); asm volatile("" : "+v"(cc_o));
            u16* WNg = (u16*)(ws + OFF_WNEG) + ((size_t)dd * NCU + unit_o) * 8192 + permpos(cc_o);
#pragma unroll
            for (int ip = 0; ip < 1; ++ip) {}
            if (dd == 0) {
#pragma unroll
                for (int ip = 0; ip < 64; ++ip) { WNg[ip * 128] = f2bf(-x2[ip].y); if ((ip & 7) == 7) asm volatile("" ::: "memory"); }
            } else {
#pragma unroll
                for (int ip = 0; ip < 64; ++ip) { WNg[(63 - ip) * 128] = f2bf(-x2[ip].y); if ((ip & 7) == 7) asm volatile("" ::: "memory"); }
            }
            asm volatile("" ::: "memory");
            u16* UTg = (u16*)(ws + OFF_UT) + ((size_t)dd * NCU + unit_o) * 8192 + cc_o * 64;
            if (dd == 0) {
#pragma unroll
                for (int i = 0; i < 8; ++i) { u32x4 v = {pk2(x2[8 * i].x, x2[8 * i + 1].x), pk2(x2[8 * i + 2].x, x2[8 * i + 3].x), pk2(x2[8 * i + 4].x, x2[8 * i + 5].x), pk2(x2[8 * i + 6].x, x2[8 * i + 7].x)}; *(u32x4*)(UTg + 8 * i) = v; }
            } else {
#pragma unroll
                for (int i = 0; i < 8; ++i) { u32x4 v = {pk2(x2[63 - 8 * i].x, x2[62 - 8 * i].x), pk2(x2[61 - 8 * i].x, x2[60 - 8 * i].x), pk2(x2[59 - 8 * i].x, x2[58 - 8 * i].x), pk2(x2[57 - 8 * i].x, x2[56 - 8 * i].x)}; *(u32x4*)(UTg + 8 * i) = v; }
            }
        }
        __syncthreads();
    }
    }
}

DI void gdn_scan_block(const Params& p, int sb, unsigned char* lds0, unsigned char* lds1, int role) {
    const int tid = (threadIdx.x & 255), lane = tid & 63, wid = tid >> 6, l15 = lane & 15, quad = lane >> 4;
    const int chain = sb >> 1, half = sb & 1, b = chain >> 3, h = (chain >> 1) & 3, d = chain & 1, slice = half * 4 + wid;
    unsigned char* ws = p.ws;
    if (role == 1) {
        u32x4 pre[16]; float presc = 0.f;
        auto issue = [&](int step) {
            const int ck = d ? (step < 4 ? 3 - step : 135 - step) : step;
            const size_t cu = (size_t)(b * NCK + ck) * 4 + h, dcu = (size_t)d * NCU + cu;
            const u32x4* WN = (const u32x4*)(ws + OFF_WNEG + dcu * 16384);
            const u32x4* QN = (const u32x4*)(ws + OFF_QN + cu * 16384);
            const u32x4* KT = (const u32x4*)(ws + OFF_KNT + cu * 16384);
            const u32x4* IN = (const u32x4*)(ws + OFF_INTRA + dcu * 8192);
            const u32x4* UT = (const u32x4*)(ws + OFF_UT + dcu * 16384 + (size_t)half * 8192);
            const float* SC = (const float*)(ws + OFF_SCAL) + dcu * 192;
#pragma unroll
            for (int i = 0; i < 4; ++i) { pre[i] = WN[tid + 256 * i]; pre[4 + i] = QN[tid + 256 * i]; pre[8 + i] = KT[tid + 256 * i]; }
#pragma unroll
            for (int i = 0; i < 2; ++i) { pre[12 + i] = IN[tid + 256 * i]; pre[14 + i] = UT[tid + 256 * i]; }
            if (tid < 192) presc = SC[tid];
        };
        auto commit = [&](unsigned char* L) {
#pragma unroll
            for (int i = 0; i < 4; ++i) {
                const int r16 = (tid >> 4) + 16 * i, c16 = tid & 15;
                *(u32x4*)(L + r16 * 272 + c16 * 16) = pre[i];
                *(u32x4*)(L + 17408 + r16 * 272 + c16 * 16) = pre[4 + i];
                const int r8 = (tid >> 3) + 32 * i, c8 = tid & 7;
                *(u32x4*)(L + 34816 + r8 * 144 + c8 * 16) = pre[8 + i];
            }
#pragma unroll
            for (int i = 0; i < 2; ++i) {
                const int r8 = (tid >> 3) + 32 * i, c8 = tid & 7;
                *(u32x4*)(L + 53248 + r8 * 144 + c8 * 16) = pre[12 + i];
                *(u32x4*)(L + 62464 + r8 * 144 + c8 * 16) = pre[14 + i];
            }
            if (tid < 192) ((float*)(L + 71680))[tid] = presc;
        };
        issue(0); commit(lds0); issue(1);
        __syncthreads();
        for (int step = 0; step < NCK; ++step) {
            if (step + 1 < NCK) { commit(((step + 1) & 1) ? lds1 : lds0); if (step + 2 < NCK) issue(step + 2); }
            __syncthreads();
        }
        return;
    }
    f32x4 S[8];
#pragma unroll
    for (int i = 0; i < 8; ++i) S[i] = (f32x4){0.f, 0.f, 0.f, 0.f};
    u16* Og = (u16*)(ws + OFF_O01) + (size_t)d * NLAT * 512;
    __syncthreads();
    for (int step = 0; step < NCK; ++step) {
        const int ck = d ? (step < 4 ? 3 - step : 135 - step) : step;
        const bool isctx = ck < 4;
        const unsigned char* L = (step & 1) ? lds1 : lds0;
        const u16* WNl = (const u16*)L; const u16* QNl = (const u16*)(L + 17408); const u16* KTl = (const u16*)(L + 34816); const u16* INl = (const u16*)(L + 53248); const u16* UTl = (const u16*)(L + 62464); const float* SCl = (const float*)(L + 71680);
        bf16x8 Sb[4];
#pragma unroll
        for (int ks = 0; ks < 4; ++ks) Sb[ks] = mk8(pk2(S[2 * ks][0], S[2 * ks][1]), pk2(S[2 * ks][2], S[2 * ks][3]), pk2(S[2 * ks + 1][0], S[2 * ks + 1][1]), pk2(S[2 * ks + 1][2], S[2 * ks + 1][3]));
        f32x4 vn[4], o[4];
#pragma unroll
        for (int mt = 0; mt < 4; ++mt) {
            const u32x2 raw = *(const u32x2*)(UTl + (16 * wid + l15) * 72 + 16 * mt + 4 * quad);
            vn[mt] = (f32x4){bflo(raw.x), bfhi(raw.x), bflo(raw.y), bfhi(raw.y)};
#pragma unroll
            for (int ks = 0; ks < 4; ++ks) {
                const bf16x8 a = *(const bf16x8*)(WNl + (16 * mt + l15) * 136 + 32 * ks + 8 * quad);
                vn[mt] = MFMA16(a, Sb[ks], vn[mt]);
            }
        }
        if (!isctx) {
#pragma unroll
            for (int mt = 0; mt < 4; ++mt) {
                o[mt] = (f32x4){0.f, 0.f, 0.f, 0.f};
#pragma unroll
                for (int ks = 0; ks < 4; ++ks) {
                    const bf16x8 a = *(const bf16x8*)(QNl + (16 * mt + l15) * 136 + 32 * ks + 8 * quad);
                    o[mt] = MFMA16(a, Sb[ks], o[mt]);
                }
                const f32x4 qs = *(const f32x4*)(SCl + 16 * mt + 4 * quad);
                o[mt] = o[mt] * qs;
            }
        }
        bf16x8 vb[2], vsb[2];
        {
            f32x4 kc[4];
#pragma unroll
            for (int mt = 0; mt < 4; ++mt) kc[mt] = *(const f32x4*)(SCl + 64 + 16 * mt + 4 * quad);
#pragma unroll
            for (int k2 = 0; k2 < 2; ++k2) {
                const f32x4 a = vn[2 * k2], c = vn[2 * k2 + 1];
                vb[k2] = mk8(pk2(a[0], a[1]), pk2(a[2], a[3]), pk2(c[0], c[1]), pk2(c[2], c[3]));
                const f32x4 as = a * kc[2 * k2], cs = c * kc[2 * k2 + 1];
                vsb[k2] = mk8(pk2(as[0], as[1]), pk2(as[2], as[3]), pk2(cs[0], cs[1]), pk2(cs[2], cs[3]));
            }
        }
        const float egl = SCl[128];
#pragma unroll
        for (int st = 0; st < 8; ++st) {
            S[st] = S[st] * egl;
#pragma unroll
            for (int k2 = 0; k2 < 2; ++k2) {
                const bf16x8 a = *(const bf16x8*)(KTl + (16 * st + l15) * 72 + 32 * k2 + 8 * quad);
                S[st] = MFMA16(a, vsb[k2], S[st]);
            }
        }
        if (!isctx) {
            const int tok0 = b * SEQ + (ck - 4) * 64;
#pragma unroll
            for (int mt = 0; mt < 4; ++mt) {
#pragma unroll
                for (int k2 = 0; k2 < 2; ++k2) {
                    const bf16x8 a = *(const bf16x8*)(INl + (16 * mt + l15) * 72 + 32 * k2 + 8 * quad);
                    o[mt] = MFMA16(a, vb[k2], o[mt]);
                }
#pragma unroll
                for (int r = 0; r < 4; ++r) Og[(size_t)(tok0 + 16 * mt + 4 * quad + r) * 512 + h * 128 + 16 * slice + l15] = f2bf(o[mt][r]);
            }
        }
        __syncthreads();
    }
}

DI void attn_unit(const Params& p, int P, int half, unsigned char* lds, float Mb) {
    const int tid = (threadIdx.x & 255), lane = tid & 63, wid = tid >> 6, l31 = lane & 31, hh = lane >> 5;
    const int kh = P & 3, qb = 2 * ((P >> 2) & 63) + half, bk = P >> 8, b = bk >> 1, kvh = bk & 1, head = kvh * 4 + wid;
    unsigned char* ws = p.ws;
    const u16* MIX = (const u16*)(ws + OFF_MIX);
    constexpr int NT = SKV / 64 / 4;
    const u16* Kg = (const u16*)(ws + OFF_K) + (size_t)bk * SKV * 64 + (size_t)kh * NT * 64 * 64;
    const u16* Vg = (const u16*)(ws + OFF_VT) + (size_t)bk * 64 * SKV + (size_t)kh * NT * 64;
    u16* Kl = (u16*)lds; u16* Vl = (u16*)(lds + 36864);
    const int tokA = b * SEQ + qb * 64 + l31;
    const size_t qrowA = (size_t)tokA * DM + head * 64, qrowB = qrowA + (size_t)32 * DM;
    bf16x8 qfA[4], qfB[4];
#pragma unroll
    for (int ks = 0; ks < 4; ++ks) { qfA[ks] = *(const bf16x8*)(MIX + qrowA + 16 * ks + 8 * hh); qfB[ks] = *(const bf16x8*)(MIX + qrowB + 16 * ks + 8 * hh); }
    f32x16 o0A, o1A, o0B, o1B; f2_t l2A = {0.f, 0.f}, l2B = {0.f, 0.f};
#pragma unroll
    for (int i = 0; i < 16; ++i) { o0A[i] = 0.f; o1A[i] = 0.f; o0B[i] = 0.f; o1B[i] = 0.f; }
    const bf16x8 ones = mk8(0x3f803f80u, 0x3f803f80u, 0x3f803f80u, 0x3f803f80u);
    int t5_ = (int)threadIdx.x; asm volatile("" : "+v"(t5_));
    const int lrow = t5_ >> 3, lcc = t5_ & 7;
    u32x4 rk, rv;
    {
        const u32x4 k0 = *(const u32x4*)(Kg + (size_t)lrow * 64 + lcc * 8), v0 = *(const u32x4*)(Vg + (size_t)lrow * SKV + lcc * 8);
        rk = *(const u32x4*)(Kg + (size_t)(64 + lrow) * 64 + lcc * 8); rv = *(const u32x4*)(Vg + (size_t)lrow * SKV + 64 + lcc * 8);
        __syncthreads();
        *(u32x4*)(Kl + lrow * 72 + lcc * 8) = k0; *(u32x4*)(Vl + lrow * 72 + lcc * 8) = v0;
    }
    __syncthreads();
    for (int kt = 0; kt < NT; ++kt) {
        const u16* Kc = Kl + (kt & 1) * 9216; const u16* Vc = Vl + (kt & 1) * 9216;
        if (kt + 1 < NT) {
            u16* Kn = Kl + ((kt + 1) & 1) * 9216; u16* Vn = Vl + ((kt + 1) & 1) * 9216;
            *(u32x4*)(Kn + lrow * 72 + lcc * 8) = rk; *(u32x4*)(Vn + lrow * 72 + lcc * 8) = rv;
        }
        if (kt + 2 < NT) { rk = *(const u32x4*)(Kg + (size_t)((kt + 2) * 64 + lrow) * 64 + lcc * 8); rv = *(const u32x4*)(Vg + (size_t)lrow * SKV + (kt + 2) * 64 + lcc * 8); }
#pragma unroll
        for (int sub = 0; sub < 2; ++sub) {
            f32x16 sA, sB;
#pragma unroll
            for (int i = 0; i < 16; ++i) { sA[i] = -Mb; sB[i] = -Mb; }
#pragma unroll
            for (int ks = 0; ks < 4; ++ks) {
                const bf16x8 kf = *(const bf16x8*)(Kc + (sub * 32 + l31) * 72 + 16 * ks + 8 * hh);
                sA = MFMA32(kf, qfA[ks], sA); sB = MFMA32(kf, qfB[ks], sB);
            }
#pragma unroll
            for (int i = 0; i < 16; ++i) { sA[i] = __builtin_amdgcn_exp2f(sA[i]); sB[i] = __builtin_amdgcn_exp2f(sB[i]); }
#pragma unroll
            for (int i = 0; i < 8; ++i) { l2A += (f2_t){sA[2 * i], sA[2 * i + 1]}; l2B += (f2_t){sB[2 * i], sB[2 * i + 1]}; }
#pragma unroll
            for (int sp = 0; sp < 2; ++sp) {
                const bf16x8 pA = mk8(pk2(sA[8 * sp], sA[8 * sp + 1]), pk2(sA[8 * sp + 2], sA[8 * sp + 3]), pk2(sA[8 * sp + 4], sA[8 * sp + 5]), pk2(sA[8 * sp + 6], sA[8 * sp + 7]));
                const bf16x8 pB = mk8(pk2(sB[8 * sp], sB[8 * sp + 1]), pk2(sB[8 * sp + 2], sB[8 * sp + 3]), pk2(sB[8 * sp + 4], sB[8 * sp + 5]), pk2(sB[8 * sp + 6], sB[8 * sp + 7]));
                const u16* v0 = Vc + l31 * 72 + sub * 32 + 16 * sp + 4 * hh;
                const bf16x8 vf0 = mk8(*(const u32x2*)v0, *(const u32x2*)(v0 + 8));
                const bf16x8 vf1 = mk8(*(const u32x2*)(v0 + 32 * 72), *(const u32x2*)(v0 + 32 * 72 + 8));
                o0A = MFMA32(vf0, pA, o0A); o0B = MFMA32(vf0, pB, o0B); o1A = MFMA32(vf1, pA, o1A); o1B = MFMA32(vf1, pB, o1B);
            }
        }
        __syncthreads();
    }
    float* LP = (float*)(ws + OFF_LP) + (size_t)kh * NLAT * 8;
    float lsA = l2A.x + l2A.y, lsB = l2B.x + l2B.y; lsA += __shfl_xor(lsA, 32); lsB += __shfl_xor(lsB, 32);
    int lane_o = lane; asm volatile("" : "+v"(lane_o));
    const int tokO = b * SEQ + qb * 64 + (lane_o & 31);
    if (hh == 0) { LP[(size_t)tokO * 8 + head] = lsA; LP[(size_t)(tokO + 32) * 8 + head] = lsB; }
    u16* OPA = (u16*)p.out + (size_t)kh * NLAT * 512 + (size_t)tokO * 512 + head * 64;
    u16* OPB = OPA + (size_t)32 * 512;
#pragma unroll
    for (int g = 0; g < 4; ++g) {
        { u32x2 w0 = {pk2(o0A[4 * g], o0A[4 * g + 1]), pk2(o0A[4 * g + 2], o0A[4 * g + 3])}; u32x2 w1 = {pk2(o1A[4 * g], o1A[4 * g + 1]), pk2(o1A[4 * g + 2], o1A[4 * g + 3])};
          *(u32x2*)(OPA + 8 * g + 4 * hh) = w0; *(u32x2*)(OPA + 32 + 8 * g + 4 * hh) = w1; }
        { u32x2 w0 = {pk2(o0B[4 * g], o0B[4 * g + 1]), pk2(o0B[4 * g + 2], o0B[4 * g + 3])}; u32x2 w1 = {pk2(o1B[4 * g], o1B[4 * g + 1]), pk2(o1B[4 * g + 2], o1B[4 * g + 3])};
          *(u32x2*)(OPB + 8 * g + 4 * hh) = w0; *(u32x2*)(OPB + 32 + 8 * g + 4 * hh) = w1; }
    }
}

namespace pg8 {
#define PG8_LAS __attribute__((address_space(3)))
typedef unsigned short bf16_t;
typedef short bf16x8 __attribute__((ext_vector_type(8)));
typedef float f32x4 __attribute__((ext_vector_type(4)));
typedef unsigned u32x4 __attribute__((ext_vector_type(4)));
constexpr int BM = 256, BK = 64, HALF = 128, HTB = HALF * BK * 2  , STAGE_BYTES = 8 * HTB, NXCD = 8, WGM = 8;

__host__ __device__ __forceinline__ int lds_byte(int r, int c) { const int st = (r >> 4) * 2 + (c >> 5), rr = r & 15, cc = c & 31, ob = rr * 64 + cc * 2; return st * 1024 + (ob ^ (((ob >> 9) & 1) << 5)); }
__host__ __device__ __forceinline__ void stage_rc(int b, int& R, int& C) { const int st = b / 1024, sb = b % 1024, swz = sb ^ (((sb >> 9) & 1) << 5); R = (st >> 1) * 16 + swz / 64; C = (st & 1) * 32 + (swz % 64) / 2; }
__host__ __device__ __forceinline__ int perm32(int rho) { const int n = rho >> 4, i = rho & 15; return 8 * (i >> 2) + 4 * n + (i & 3); }

struct Unit { int pm, pn; };
struct Gemm { const bf16_t* A; const bf16_t* Bt; int M, N, K; };

struct StaticOrder {
    int nM, nN, nwg, G, c;
    __host__ __device__ void init(int M, int N, int G_, int c_) { nM = M / BM; nN = N / BM; nwg = nM * nN; G = G_; c = c_; }
    __host__ __device__ bool next(int i, Unit& u) const {
        const long L = (long)i * G + c; if (L >= nwg) return false;
        int wgid = (int)L; { const int q = nwg / NXCD, r = nwg % NXCD, xcd = wgid % NXCD, off = wgid / NXCD; wgid = (xcd < r ? xcd * (q + 1) : r * (q + 1) + (xcd - r) * q) + off; }
        const int nig = WGM * nN, gid = wgid / nig, fm = gid * WGM, gsz = (nM - fm) < WGM ? (nM - fm) : WGM;
        u.pm = fm + ((wgid % nig) % gsz); u.pn = (wgid % nig) / gsz; return true;
    }
    __device__ __forceinline__ void a_ready(const Unit&) const {}
    __device__ __forceinline__ void done(const Unit&) const {}
};


template <class Epi, class Sched, bool ALIGN_EPI = false, bool SP2 = false>
__device__ __forceinline__ void gemm_phase(PG8_LAS unsigned char* lds, const Gemm g, const Sched& S, const Epi& E) {
    const int tid = threadIdx.x, wid = __builtin_amdgcn_readfirstlane(tid >> 6), lane = tid & 63, wr = wid >> 2, wc = wid & 3, fr = lane & 15, fq = lane >> 4;
    const int K = g.K, nt = K / BK;
    unsigned voffA[2], voffB[2];
#pragma unroll
    for (int i = 0; i < 2; ++i) { int R, C; stage_rc(tid * 16 + i * 8192, R, C); const int Rb = Epi::PERM ? ((R & ~31) + perm32(R & 31)) : R;
        voffA[i] = (unsigned)(R * K + C) * 2u; voffB[i] = (unsigned)(Rb * K + C) * 2u; }
    const size_t kstep = (size_t)(BK * 2);
    const size_t hstep = (size_t)HALF * K * 2;
    const size_t tstep = 2 * hstep;
    const unsigned ldsw = (unsigned)wid * 1024u;
    const int aoff = lds_byte(wr * 64 + fr, fq * 8), boff = lds_byte(wc * 32 + fr, fq * 8);
#define PG8_SA(b, h) (((b) * 2 + (h)) * HTB)
#define PG8_SB(b, h) ((4 + (b) * 2 + (h)) * HTB)
#define PG8_STAGE(bufoff, gbase, voff) do { _Pragma("unroll") for (int _i = 0; _i < 2; ++_i) \
        __builtin_amdgcn_global_load_lds((const unsigned*)((const char*)(gbase) + (voff)[_i]), (PG8_LAS unsigned*)(lds + (bufoff) + ldsw + _i * 8192), 16, 0, 0); } while (0)
#define PG8_LDA(dst, b, h) do { _Pragma("unroll") for (int m = 0; m < 4; ++m) _Pragma("unroll") for (int k = 0; k < 2; ++k) dst[m][k] = *(const PG8_LAS bf16x8*)(lds + PG8_SA(b, h) + aoff + m * 2048 + k * 1024); } while (0)
#define PG8_LDB(dst, b, h) do { _Pragma("unroll") for (int n = 0; n < 2; ++n) _Pragma("unroll") for (int k = 0; k < 2; ++k) dst[n][k] = *(const PG8_LAS bf16x8*)(lds + PG8_SB(b, h) + boff + n * 2048 + k * 1024); } while (0)
#define PG8_MMA(ai, bj, At, Bt) do { __builtin_amdgcn_s_setprio(1); _Pragma("unroll") for (int m = 0; m < 4; ++m) _Pragma("unroll") for (int n = 0; n < 2; ++n) _Pragma("unroll") for (int k = 0; k < 2; ++k) \
        acc[ai][bj][m][n] = __builtin_amdgcn_mfma_f32_16x16x32_bf16(Bt[n][k], At[m][k], acc[ai][bj][m][n], 0, 0, 0); __builtin_amdgcn_s_setprio(0); } while (0)
#define PG8_WAIT_V(n) asm volatile("s_waitcnt vmcnt(" #n ")" ::: "memory")
#define PG8_WAIT_L(n) asm volatile("s_waitcnt lgkmcnt(" #n ")" ::: "memory")
#define PG8_BAR __builtin_amdgcn_s_barrier()
#define PG8_SCHED __builtin_amdgcn_sched_barrier(0)
    Unit cur, nxt; int ui = 0;
    if (!S.next(0, cur)) return;
    f32x4 acc[2][2][4][2];
#pragma unroll
    for (int a = 0; a < 2; ++a)
#pragma unroll
        for (int b = 0; b < 2; ++b)
#pragma unroll
            for (int m = 0; m < 4; ++m)
#pragma unroll
                for (int n = 0; n < 2; ++n) acc[a][b][m][n] = (f32x4){0.f, 0.f, 0.f, 0.f};
    bf16x8 At[4][2], B0[2][2], B1[2][2];
    const char* cA = (const char*)g.A + (size_t)cur.pm * tstep; const char* cB = (const char*)g.Bt + (size_t)cur.pn * tstep;
    S.a_ready(cur);
    if constexpr (SP2) {
        PG8_STAGE(PG8_SB(0, 0), cB, voffB); PG8_STAGE(PG8_SB(0, 1), cB + hstep, voffB); PG8_STAGE(PG8_SA(0, 0), cA, voffA); PG8_STAGE(PG8_SA(0, 1), cA + hstep, voffA);
        if (wr == 1) PG8_BAR;
        PG8_WAIT_V(2); PG8_BAR;
        PG8_STAGE(PG8_SB(1, 0), cB + kstep, voffB); PG8_STAGE(PG8_SA(1, 0), cA + kstep, voffA); PG8_STAGE(PG8_SB(1, 1), cB + hstep + kstep, voffB);
        PG8_WAIT_V(6); PG8_BAR;
    } else {
        PG8_STAGE(PG8_SB(0, 0), cB, voffB); PG8_STAGE(PG8_SA(0, 0), cA, voffA); PG8_STAGE(PG8_SB(0, 1), cB + hstep, voffB); PG8_STAGE(PG8_SA(0, 1), cA + hstep, voffA);
        if (wr == 1) PG8_BAR;
        PG8_WAIT_V(4); PG8_BAR;
        PG8_STAGE(PG8_SB(1, 0), cB + kstep, voffB); PG8_STAGE(PG8_SA(1, 0), cA + kstep, voffA); PG8_STAGE(PG8_SB(1, 1), cB + hstep + kstep, voffB);
        PG8_WAIT_V(6); PG8_BAR;
    }
    for (;;) {
        const bool has_next = S.next(ui + 1, nxt);
        const char* nA = has_next ? (const char*)g.A + (size_t)nxt.pm * tstep : cA; const char* nB = has_next ? (const char*)g.Bt + (size_t)nxt.pn * tstep : cB;
        for (int t = 0; t < nt; t += 2) {
            const bool last = (t == nt - 2);
            const char* a1 = cA + (size_t)(t + 1) * kstep;
            const char* a2 = last ? nA : cA + (size_t)(t + 2) * kstep; const char* b2 = last ? nB : cB + (size_t)(t + 2) * kstep;
            const char* a3 = a2 + kstep; const char* b3 = b2 + kstep;
            if (last && has_next) S.a_ready(nxt);
            if constexpr (SP2) {
            PG8_LDB(B0, 0, 0); PG8_LDB(B1, 0, 1); PG8_SCHED; PG8_LDA(At, 0, 0); PG8_STAGE(PG8_SA(1, 1), a1 + hstep, voffA);
            PG8_WAIT_V(8); PG8_WAIT_L(0); PG8_BAR; PG8_MMA(0, 0, At, B0); PG8_MMA(0, 1, At, B1); PG8_BAR; PG8_SCHED;
            PG8_LDA(At, 0, 1); PG8_STAGE(PG8_SB(0, 0), b2, voffB); PG8_STAGE(PG8_SB(0, 1), b2 + hstep, voffB); PG8_STAGE(PG8_SA(0, 0), a2, voffA);
            PG8_WAIT_V(8); PG8_WAIT_L(0); PG8_BAR; PG8_MMA(1, 0, At, B0); PG8_MMA(1, 1, At, B1); PG8_BAR; PG8_SCHED;
            PG8_LDB(B0, 1, 0); PG8_LDB(B1, 1, 1); PG8_SCHED; PG8_LDA(At, 1, 0); PG8_STAGE(PG8_SA(0, 1), a2 + hstep, voffA);
            PG8_WAIT_V(8); PG8_WAIT_L(0); PG8_BAR; PG8_MMA(0, 0, At, B0); PG8_MMA(0, 1, At, B1); PG8_BAR; PG8_SCHED;
            PG8_LDA(At, 1, 1); PG8_STAGE(PG8_SB(1, 0), b3, voffB); PG8_STAGE(PG8_SB(1, 1), b3 + hstep, voffB); PG8_STAGE(PG8_SA(1, 0), a3, voffA);
            PG8_WAIT_V(8); PG8_WAIT_L(0); PG8_BAR; PG8_MMA(1, 0, At, B0); PG8_MMA(1, 1, At, B1); PG8_BAR; PG8_SCHED;
            } else {
            PG8_LDB(B0, 0, 0); PG8_SCHED; PG8_LDA(At, 0, 0); PG8_STAGE(PG8_SA(1, 1), a1 + hstep, voffA);
            PG8_WAIT_L(8); PG8_BAR; PG8_WAIT_L(0); PG8_MMA(0, 0, At, B0); PG8_BAR; PG8_SCHED;
            PG8_LDB(B1, 0, 1); PG8_STAGE(PG8_SB(0, 0), b2, voffB);
            PG8_BAR; PG8_WAIT_L(0); PG8_MMA(0, 1, At, B1); PG8_BAR;
            PG8_LDA(At, 0, 1); PG8_STAGE(PG8_SA(0, 0), a2, voffA);
            PG8_BAR; PG8_WAIT_L(0); PG8_MMA(1, 0, At, B0); PG8_BAR; PG8_SCHED;
            PG8_STAGE(PG8_SB(0, 1), b2 + hstep, voffB);
            PG8_WAIT_V(6); PG8_BAR; PG8_MMA(1, 1, At, B1); PG8_BAR;
            PG8_LDB(B0, 1, 0); PG8_SCHED; PG8_LDA(At, 1, 0); PG8_STAGE(PG8_SA(0, 1), a2 + hstep, voffA);
            PG8_WAIT_L(8); PG8_BAR; PG8_WAIT_L(0); PG8_MMA(0, 0, At, B0); PG8_BAR; PG8_SCHED;
            PG8_LDB(B1, 1, 1); PG8_STAGE(PG8_SB(1, 0), b3, voffB);
            PG8_BAR; PG8_WAIT_L(0); PG8_MMA(0, 1, At, B1); PG8_BAR;
            PG8_LDA(At, 1, 1); PG8_STAGE(PG8_SA(1, 0), a3, voffA);
            PG8_BAR; PG8_WAIT_L(0); PG8_MMA(1, 0, At, B0); PG8_BAR; PG8_SCHED;
            PG8_STAGE(PG8_SB(1, 1), b3 + hstep, voffB);
            PG8_WAIT_V(6); PG8_BAR; PG8_MMA(1, 1, At, B1); PG8_BAR;
            }
        }
        if constexpr (ALIGN_EPI) { if (wr == 0) PG8_BAR; }
        if constexpr (!Epi::AFTER_DRAIN) { E(acc, cur, wr, wc, fr, fq); S.done(cur); }
        if (!has_next) break;
#pragma unroll
        for (int a = 0; a < 2; ++a)
#pragma unroll
            for (int b = 0; b < 2; ++b)
#pragma unroll
                for (int m = 0; m < 4; ++m)
#pragma unroll
                    for (int n = 0; n < 2; ++n) acc[a][b][m][n] = (f32x4){0.f, 0.f, 0.f, 0.f};
        cur = nxt; cA = nA; cB = nB; ++ui;
        if constexpr (ALIGN_EPI) { if (wr == 1) PG8_BAR; }
    }
    PG8_WAIT_V(0);
    if constexpr (!ALIGN_EPI) { if (wr == 0) PG8_BAR; }
    PG8_BAR;
    if constexpr (Epi::AFTER_DRAIN) { E.fused(acc, cur, wr, wc, fr, fq, lds, wid, lane); S.done(cur); }
#undef PG8_SA
#undef PG8_SB
#undef PG8_STAGE
#undef PG8_LDA
#undef PG8_LDB
#undef PG8_MMA
#undef PG8_WAIT_V
#undef PG8_WAIT_L
#undef PG8_BAR
#undef PG8_SCHED
}

struct EpiRelu2 {
    static constexpr bool PERM = true, AFTER_DRAIN = false;
    bf16_t* O; int ldc;
    __device__ __forceinline__ void operator()(const f32x4 (&acc)[2][2][4][2], const Unit& u, int wr, int wc, int fr, int fq) const {
#pragma unroll
        for (int ai = 0; ai < 2; ++ai)
#pragma unroll
            for (int m = 0; m < 4; ++m) {
                bf16_t* rowp = O + (size_t)(u.pm * BM + ai * HALF + wr * 64 + m * 16 + fr) * ldc + u.pn * BM + wc * 32 + 8 * fq;
#pragma unroll
                for (int bj = 0; bj < 2; ++bj) {
                    f32x4 v0 = acc[ai][bj][m][0], v1 = acc[ai][bj][m][1];
#pragma unroll
                    for (int r = 0; r < 4; ++r) { const float a = fmaxf(v0[r], 0.f); v0[r] = a * a; const float c = fmaxf(v1[r], 0.f); v1[r] = c * c; }
                    u32x4 w = {::pk2(v0[0], v0[1]), ::pk2(v0[2], v0[3]), ::pk2(v1[0], v1[1]), ::pk2(v1[2], v1[3])};
                    *(u32x4*)(rowp + bj * HALF) = w;
                }
            }
    }
};
struct EpiGatedRes {
    static constexpr bool PERM = true, AFTER_DRAIN = false;
    const float* base; float* out; const float* gate; int gate_bstride; int ldc;
    __device__ __forceinline__ void operator()(const f32x4 (&acc)[2][2][4][2], const Unit& u, int wr, int wc, int fr, int fq) const {
        const float* g = gate + ((u.pm * BM) >> 13) * gate_bstride;
        const int col0 = u.pn * BM + wc * 32 + 8 * fq;
        f32x4 gv[2][2];
#pragma unroll
        for (int bj = 0; bj < 2; ++bj)
#pragma unroll
            for (int n = 0; n < 2; ++n) gv[bj][n] = *(const f32x4*)(g + col0 + bj * HALF + n * 4);
#pragma unroll
        for (int ai = 0; ai < 2; ++ai)
#pragma unroll
            for (int m = 0; m < 4; ++m) {
                const size_t off = (size_t)(u.pm * BM + ai * HALF + wr * 64 + m * 16 + fr) * ldc + col0;
#pragma unroll
                for (int bj = 0; bj < 2; ++bj)
#pragma unroll
                    for (int n = 0; n < 2; ++n) {
                        const f32x4 xv = *(const f32x4*)(base + off + bj * HALF + n * 4);
                        *(f32x4*)(out + off + bj * HALF + n * 4) = xv + gv[bj][n] * acc[ai][bj][m][n];
                    }
            }
    }
};
struct EpiInProj {
    static constexpr bool PERM = true, AFTER_DRAIN = false;
    bf16_t* MIX; bf16_t* Kb; bf16_t* Vt; bf16_t* DQ; float* GT; const float* a_log; const float* dt_bias;
    __device__ __forceinline__ void operator()(const f32x4 (&acc)[2][2][4][2], const Unit& u, int wr, int wc, int fr, int fq) const {
        const int pn = u.pn; const bool lat = u.pm < 64;
#pragma unroll
        for (int ai = 0; ai < 2; ++ai)
#pragma unroll
            for (int m = 0; m < 4; ++m) {
                const int gr = u.pm * BM + ai * HALF + wr * 64 + m * 16 + fr;
                int bb, kvpos;
                if (lat) { bb = gr >> 13; kvpos = 256 + (gr & 8191); } else { const int cr = gr - 16384; bb = cr >> 8; kvpos = cr & 255; }
#pragma unroll
                for (int bj = 0; bj < 2; ++bj) {
                    const int cl = bj * HALF + wc * 32 + 8 * fq;
                    const f32x4 v0 = acc[ai][bj][m][0], v1 = acc[ai][bj][m][1];
                    const u32x4 w = {::pk2(v0[0], v0[1]), ::pk2(v0[2], v0[3]), ::pk2(v1[0], v1[1]), ::pk2(v1[2], v1[3])};
                    if (pn < 2) { if (lat) *(u32x4*)(MIX + (size_t)gr * 1024 + pn * 256 + cl) = w; }
                    else if (pn == 2) {
                        if (bj == 0) { const int kvh = cl >> 6, d = cl & 63; *(u32x4*)(Kb + ((size_t)(bb * 2 + kvh) * 8448 + kvpos) * 64 + d) = w; }
                        else { const int c2 = cl - HALF, kvh = c2 >> 6, d = c2 & 63; bf16_t* vp = Vt + ((size_t)(bb * 2 + kvh) * 64 + d) * 8448 + kvpos;
#pragma unroll
                            for (int e = 0; e < 4; ++e) { vp[(2 * e) * 8448] = (bf16_t)(w[e] & 0xffffu); vp[(2 * e + 1) * 8448] = (bf16_t)(w[e] >> 16); } }
                    }
                    else if (pn < 9) *(u32x4*)(DQ + (size_t)gr * 1536 + (pn - 3) * 256 + cl) = w;
                    else { if (lat) *(u32x4*)(MIX + (size_t)gr * 1024 + 512 + (pn - 9) * 256 + cl) = w; }
                }
            }
    }
};
}

#define XB_TMO      128
#define XB_XCNT(j)  (256  + 64 * (j))
#define XB_XSUB(j)  (1280 + 64 * (j))
#define XB_XGEN(j)  (2304 + 64 * (j))
#define XB_TOP      3328
#define XB_TOPGEN   3392
#define XCD_BAR_WORDS 3456
#define XB_SPIN_CAP (1u << 22)
#define LAS __attribute__((address_space(3)))
DI unsigned xb_ld(unsigned* p)              { return __hip_atomic_load(p, __ATOMIC_RELAXED, __HIP_MEMORY_SCOPE_AGENT); }
DI unsigned xb_add(unsigned* p, unsigned v) { return __hip_atomic_fetch_add(p, v, __ATOMIC_RELAXED, __HIP_MEMORY_SCOPE_AGENT); }
DI unsigned xb_xcc_id() { return (unsigned)__builtin_amdgcn_s_getreg((3 << 11) | 20) & 0xFu; }
#define XB_SPIN(cond, bar) do { unsigned _sp = 0; while (cond) { __builtin_amdgcn_s_sleep(1); \
    if ((++_sp & 255u) == 0u) { if (xb_ld(&(bar)[XB_TMO])) break; if (_sp > XB_SPIN_CAP) { atomicAdd(&(bar)[XB_TMO], 1u); break; } } } } while (0)
struct XcdBarrier { unsigned* bar; unsigned x; volatile LAS unsigned* st; };
DI XcdBarrier xcd_barrier_post(unsigned* bar, volatile LAS unsigned* st) {
    XcdBarrier b; b.bar = bar; b.x = xb_xcc_id(); b.st = st;
    if (threadIdx.x == 0) (void)xb_add(&bar[XB_XCNT(b.x)], 1u);
    return b;
}
DI void xcd_barrier_complete(unsigned* bar, unsigned x, unsigned& nloc, unsigned& nx) {
    const unsigned G = gridDim.x * gridDim.y * gridDim.z;
    unsigned sum, cnt, mine, sp = 0u;
    for (;;) {
        sum = 0u; cnt = 0u; mine = 0u;
#pragma unroll
        for (unsigned j = 0; j < 16; ++j) { const unsigned c = xb_ld(&bar[XB_XCNT(j)]); sum += c; cnt += (c > 0u) ? 1u : 0u; mine = (j == x) ? c : mine; }
        if (sum == G) break;
        __builtin_amdgcn_s_sleep(1);
        if ((++sp & 255u) == 0u) { if (xb_ld(&bar[XB_TMO])) break; if (sp > XB_SPIN_CAP) { atomicAdd(&bar[XB_TMO], 1u); break; } }
    }
    nloc = mine > 0u ? mine : 1u; nx = cnt > 0u ? cnt : 1u;
}
DI void xcd_barrier(const XcdBarrier& b) {
    asm volatile("s_waitcnt vmcnt(0)" ::: "memory");
    __syncthreads();
    if (threadIdx.x == 0) {
        unsigned* bar = b.bar;
        __builtin_amdgcn_s_waitcnt(0);
        unsigned nloc = b.st[0], nx = b.st[1];
        if (nloc == 0u) { xcd_barrier_complete(bar, b.x, nloc, nx); b.st[0] = nloc; b.st[1] = nx; }
        const unsigned old = xb_add(&bar[XB_XSUB(b.x)], 1u);
        const unsigned gen = old / nloc;
        if (old + 1u == (gen + 1u) * nloc) {
            __builtin_amdgcn_fence(__ATOMIC_RELEASE, "agent");
            asm volatile("s_waitcnt vmcnt(0)" ::: "memory");
            const unsigned og = xb_add(&bar[XB_TOP], 1u);
            const unsigned tg = og / nx;
            if (og + 1u == (tg + 1u) * nx) xb_add(&bar[XB_TOPGEN], 1u);
            else XB_SPIN(xb_ld(&bar[XB_TOPGEN]) == tg, bar);
            __builtin_amdgcn_fence(__ATOMIC_ACQUIRE, "agent");
            xb_add(&bar[XB_XGEN(b.x)], 1u);
            asm volatile("s_waitcnt vmcnt(0)" ::: "memory");
        } else {
            XB_SPIN(xb_ld(&bar[XB_XGEN(b.x)]) == gen, bar);
            __builtin_amdgcn_fence(__ATOMIC_ACQUIRE, "agent");
            asm volatile("s_waitcnt vmcnt(0)" ::: "memory");
        }
    }
    __syncthreads();
}

__global__ void __launch_bounds__(512, 2) mega(Params p) {
    extern __shared__ __attribute__((aligned(16))) unsigned char lds_raw[];
    const int half = __builtin_amdgcn_readfirstlane(threadIdx.x >> 8);
    const int tid = threadIdx.x & 255, lane = tid & 63, wid = tid >> 6;
    const int nblk = gridDim.x * 2, bid = blockIdx.x * 2 + half;
    auto lwid = [&]() { int w_ = (int)((threadIdx.x & 255) >> 6); asm volatile("" : "+v"(w_)); return w_; };
    unsigned char* const lds_base = lds_raw; unsigned char* const lds = lds_raw + half * 73728;
    unsigned char* ws = p.ws;
    const int lo = p.ph_lo, hi = p.ph_hi;
#ifndef PH_MASK
#define PH_MASK 0x3ff
#endif
#define IN_PH(k) ((((PH_MASK) >> (k)) & 1) && lo <= (k) && (k) <= hi)
#define SEAM(k) do { if ((k) < hi) { xcd_barrier(xb); } } while (0)
    if (threadIdx.x < 4) ((volatile LAS unsigned*)(lds_base + 147456))[threadIdx.x] = 0u;
    __syncthreads();
    XcdBarrier xb = xcd_barrier_post((unsigned*)(ws + OFF_BAR), (volatile LAS unsigned*)(lds_base + 147456));
    if (hi > 1000) cg::this_grid().sync();
    float* MOD = (float*)(ws + OFF_MODZ);
    int* CNT = (int*)(ws + OFF_MISC);

    if (IN_PH(0)) {
        constexpr int T_MOD = 96 * 4;
        for (int t = bid; t < T_MOD + 2; t += nblk) {
            if (t < T_MOD) {
                const int j = t >> 2, kq = t & 3; float* sv = (float*)lds; float* red = sv + 768;
                __syncthreads();
                for (int i = tid; i < 768; i += 256) { const int which = i >> 8, k = kq * 256 + (i & 255); const float cv = which < 2 ? p.c[which * 1024 + k] : p.c_ctx[k]; sv[i] = silu_f(cv); }
                __syncthreads();
                const int col = j * 64 + lane; float a0 = 0.f, a1 = 0.f, a2 = 0.f;
#pragma unroll 8
                for (int k = 64 * wid; k < 64 * wid + 64; ++k) { const float wv = p.w_mod[(size_t)(kq * 256 + k) * 6144 + col]; a0 += sv[k] * wv; a1 += sv[256 + k] * wv; a2 += sv[512 + k] * wv; }
                red[(wid * 3 + 0) * 64 + lane] = a0; red[(wid * 3 + 1) * 64 + lane] = a1; red[(wid * 3 + 2) * 64 + lane] = a2;
                __syncthreads();
                if (tid < 192) { const int which = tid >> 6, cl = tid & 63; float sacc = kq == 0 ? p.b_mod[j * 64 + cl] : 0.f; for (int w = 0; w < 4; ++w) sacc += red[(w * 3 + which) * 64 + cl]; atomicAdd(&MOD[which * 6144 + j * 64 + cl], sacc); }
            } else if (t == T_MOD) {
                f2_t* RT = (f2_t*)(ws + OFF_ROPE);
                for (int i = tid; i < 2048; i += 256) {
                    const int pos = i >> 4, j = i & 15;
                    const float inv = exp2f(-(float)j * 0.8304820237218406f);
                    const float ang = (float)pos * inv;
                    const float n = rintf(ang * 0.15915494309189535f);
                    float r = fmaf(-n, 6.28125f, ang); r = fmaf(-n, 1.9353071795864769e-3f, r);
                    RT[i] = (f2_t){cosf(r), sinf(r)};
                }
            } else { if (tid == 0) CNT[0] = 0; }
        }
        for (int t = bid; t < 16 * (INP / 64); t += nblk) wconv_tile(p.w_in, DM, INC, INP, (u16*)(ws + OFF_WIN), t, (float*)lds);
        SEAM(0);
    }
    if (IN_PH(1)) {
        u16* H = (u16*)(ws + OFF_H);
        norm_rows([&](int r) { return r < NLAT ? p.x + (size_t)r * DM : p.ctx + (size_t)(r - NLAT) * DM; }, NROW, bid * 4 + lwid(), nblk * 4, p.norm1_w, MOD, 0, 1, H, lane);
        SEAM(1);
    }
    if (IN_PH(2)) {
        pg8::Gemm g{(const u16*)(ws + OFF_H), (const u16*)(ws + OFF_WIN), NROW, 2816, DM}; pg8::StaticOrder S; S.init(NROW, 2816, (int)gridDim.x, (int)blockIdx.x);
        pg8::EpiInProj E{(u16*)(ws + OFF_MIX), (u16*)(ws + OFF_K), (u16*)(ws + OFF_VT), (u16*)(ws + OFF_DQKV), (float*)(ws + OFF_GATE), p.a_log, p.dt_bias};
        pg8::gemm_phase<pg8::EpiInProj, pg8::StaticOrder, true, true>((PG8_LAS unsigned char*)lds_base, g, S, E);
        {
            const u16* H = (const u16*)(ws + OFF_H); const u16* Wg = (const u16*)(ws + OFF_WIN) + (size_t)2816 * DM; float* GT = (float*)(ws + OFF_GATE);
            const int l15 = lane & 15, quad = lane >> 4;
            for (int rb = (int)blockIdx.x * 8 + (int)(threadIdx.x >> 6); rb < NROW / 16; rb += (int)gridDim.x * 8) {
                f32x4 acc = {0.f, 0.f, 0.f, 0.f};
                const u16* ap = H + (size_t)(rb * 16 + l15) * DM + 8 * quad; const u16* bp = Wg + (size_t)l15 * DM + 8 * quad;
#pragma unroll 8
                for (int ks = 0; ks < 32; ++ks) acc = MFMA16(*(const bf16x8*)(ap + 32 * ks), *(const bf16x8*)(bp + 32 * ks), acc);
                const int ci = l15;
#pragma unroll
                for (int r = 0; r < 4; ++r) {
                    const float x = acc[r]; float o;
                    if (ci < 8) o = 1.f / (1.f + __expf(-x));
                    else { const float xx = x + p.dt_bias[ci - 8]; const float sp = xx > 20.f ? xx : log1pf(__expf(xx)); o = -__expf(p.a_log[ci - 8]) * sp; }
                    GT[(size_t)(rb * 16 + 4 * quad + r) * 16 + ci] = o;
                }
            }
        }
        SEAM(2);
    }
    if (IN_PH(3)) {
        if (bid < 32) { gdn_prep_unit(p, ((bid >> 4) * NCK + ((bid >> 2) & 3)) * 4 + (bid & 3), lds); } else {
        {
            u16* MIX = (u16*)(ws + OFF_MIX); u16* Kb = (u16*)(ws + OFF_K); const f2_t* RT = (const f2_t*)(ws + OFF_ROPE);
            const int l8 = lane & 7, sub = lane >> 3;
            for (int it = (bid - 32) * 4 + wid; it < NLAT + (NB * 2 * SKV) / 8; it += (nblk - 32) * 4) {
                u16* ptr; int t; bool rope; const float* nw; float scale;
                if (it < NLAT) { ptr = MIX + (size_t)it * DM + sub * 64 + l8 * 8; t = it & (SEQ - 1); rope = true; nw = p.q_norm_w; scale = QSCALE; }
                else { const int j = (it - NLAT) * 8 + sub, bk = j / SKV, pos = j - bk * SKV; ptr = Kb + ((size_t)bk * SKV + pos) * 64 + l8 * 8; rope = pos >= CTXL; t = pos >= CTXL ? pos - CTXL : 0; nw = p.k_norm_w; scale = 1.f; }
                const u32x4 raw = *(const u32x4*)ptr;
                float y[8];
#pragma unroll
                for (int e = 0; e < 4; ++e) { y[2 * e] = bflo(raw[e]); y[2 * e + 1] = bfhi(raw[e]); }
                float ss = 0.f;
#pragma unroll
                for (int e = 0; e < 8; ++e) ss += y[e] * y[e];
                ss += __shfl_xor(ss, 1); ss += __shfl_xor(ss, 2); ss += __shfl_xor(ss, 4);
                const float rinv = rsqrtf(ss * (1.f / 64.f) + EPS);
                const f32x4 wa = *(const f32x4*)(nw + 8 * l8), wb = *(const f32x4*)(nw + 8 * l8 + 4);
                const int ppos = (l8 & 4) ? (t & 63) : (t >> 6); const float sgn = (l8 & 2) ? 1.f : -1.f;
#pragma unroll
                for (int e = 0; e < 8; ++e) {
                    const float v = y[e] * rinv * (e < 4 ? wa[e] : wb[e - 4]);
                    const float pv = __shfl_xor(v, 2);
                    const f2_t cs = RT[ppos * 16 + 8 * (l8 & 1) + e];
                    const float vr = v * cs.x + sgn * pv * cs.y;
                    y[e] = (rope ? vr : v) * scale;
                }
                const u32x4 w = {pk2(y[0], y[1]), pk2(y[2], y[3]), pk2(y[4], y[5]), pk2(y[6], y[7])};
                *(u32x4*)ptr = w;
            }
        }
        constexpr int T_WO = 16 * 16, T_W1 = 16 * 64, T_W2 = 64 * 16;
        for (int t = bid - 32; t < T_WO + T_W1 + T_W2; t += nblk - 32) {
            if (t < T_WO) wconv_tile(p.w_out, DM, DM, DM, (u16*)(ws + OFF_WOUT), t, (float*)lds);
            else if (t < T_WO + T_W1) wconv_tile(p.w_mlp1, DM, DFF, DFF, (u16*)(ws + OFF_WM1), t - T_WO, (float*)lds);
            else wconv_tile(p.w_mlp2, DFF, DM, DM, (u16*)(ws + OFF_WM2), t - T_WO - T_W1, (float*)lds);
        }
        }
        for (int j = bid; j < 1024; j += nblk) gdn_prep_unit(p, ((j >> 9) * NCK + 4 + ((j & 511) >> 2)) * 4 + (j & 3), lds);
        SEAM(3);
    }
    if (IN_PH(4)) {
        if (blockIdx.x < 32) {
            gdn_scan_block(p, (int)blockIdx.x, lds_base, lds_base + 73728, half);
        }
        float Mb;
        { const float a = wave_max(fabsf(p.q_norm_w[lane])), bq = wave_max(fabsf(p.k_norm_w[lane])); Mb = 8.f * a * bq * 1.4426950408889634f; }
        int* su = (int*)(lds_base + 147456 + 8);
        __syncthreads();
        if (threadIdx.x == 0) *su = atomicAdd(CNT, 2);
        __syncthreads();
        int u0 = *su;
        while (u0 < 2048) {
            int nxt = 0;
            if (threadIdx.x == 0) nxt = atomicAdd(CNT, 2);
            attn_unit(p, u0 >> 1, half, lds_base, Mb);
            if (threadIdx.x == 0) *su = nxt;
            __syncthreads();
            u0 = *su;
        }
        SEAM(4);
    }
    if (IN_PH(5)) {
        const u16* O0 = (const u16*)(ws + OFF_O01); const u16* O1 = O0 + (size_t)NLAT * 512; u16* MIX = (u16*)(ws + OFF_MIX);
        const int e0 = (8 * lane) & 127;
        const f32x4 nwa = *(const f32x4*)(p.dn_norm_w + e0), nwb = *(const f32x4*)(p.dn_norm_w + e0 + 4);
        {
            const u16* PP = (const u16*)p.out; const float* LL = (const float*)(ws + OFF_LP);
            for (int r = bid * 4 + lwid(); r < NLAT; r += nblk * 4) {
                const size_t off = (size_t)r * 512 + 8 * lane;
                float acc[8] = {0.f, 0.f, 0.f, 0.f, 0.f, 0.f, 0.f, 0.f}; float lsum = 0.f;
#pragma unroll
                for (int q = 0; q < 4; ++q) {
                    const u32x4 a = *(const u32x4*)(PP + (size_t)q * NLAT * 512 + off);
                    lsum += LL[(size_t)q * NLAT * 8 + (size_t)r * 8 + (lane >> 3)];
#pragma unroll
                    for (int i = 0; i < 4; ++i) { acc[2 * i] += bflo(a[i]); acc[2 * i + 1] += bfhi(a[i]); }
                }
                const float inv = 1.f / lsum;
                u32x4 w = {pk2(acc[0] * inv, acc[1] * inv), pk2(acc[2] * inv, acc[3] * inv), pk2(acc[4] * inv, acc[5] * inv), pk2(acc[6] * inv, acc[7] * inv)};
                *(u32x4*)(MIX + (size_t)r * DM + 8 * lane) = w;
            }
        }
        int r = bid * 4 + lwid(); const int rs = nblk * 4;
        u32x4 na = {0u, 0u, 0u, 0u}, nc = na, nz = na;
        if (r < NLAT) { na = *(const u32x4*)(O0 + (size_t)r * 512 + 8 * lane); nc = *(const u32x4*)(O1 + (size_t)r * 512 + 8 * lane); nz = *(const u32x4*)(MIX + (size_t)r * DM + 512 + 8 * lane); }
        for (; r < NLAT; r += rs) {
            const u32x4 a = na, c = nc, z = nz;
            if (r + rs < NLAT) { const int r2 = r + rs; na = *(const u32x4*)(O0 + (size_t)r2 * 512 + 8 * lane); nc = *(const u32x4*)(O1 + (size_t)r2 * 512 + 8 * lane); nz = *(const u32x4*)(MIX + (size_t)r2 * DM + 512 + 8 * lane); }
            float o[8], zz[8];
#pragma unroll
            for (int i = 0; i < 4; ++i) { o[2 * i] = bflo(a[i]) + bflo(c[i]); o[2 * i + 1] = bfhi(a[i]) + bfhi(c[i]); zz[2 * i] = bflo(z[i]); zz[2 * i + 1] = bfhi(z[i]); }
            float ss = 0.f;
#pragma unroll
            for (int i = 0; i < 8; ++i) ss += o[i] * o[i];
            ss += __shfl_xor(ss, 1); ss += __shfl_xor(ss, 2); ss += __shfl_xor(ss, 4); ss += __shfl_xor(ss, 8);
            const float rinv = rsqrtf(ss * (1.f / 128.f) + EPS);
            float y[8];
#pragma unroll
            for (int i = 0; i < 8; ++i) y[i] = o[i] * rinv * (i < 4 ? nwa[i] : nwb[i - 4]) * silu_f(zz[i]);
            u32x4 w = {pk2(y[0], y[1]), pk2(y[2], y[3]), pk2(y[4], y[5]), pk2(y[6], y[7])};
            *(u32x4*)(MIX + (size_t)r * DM + 512 + 8 * lane) = w;
        }
        SEAM(5);
    }
    if (IN_PH(6)) {
        pg8::Gemm g{(const u16*)(ws + OFF_MIX), (const u16*)(ws + OFF_WOUT), NLAT, DM, DM}; pg8::StaticOrder S; S.init(NLAT, DM, (int)gridDim.x, (int)blockIdx.x);
        pg8::EpiGatedRes E{p.x, p.out, MOD + 2 * 1024, 6144, DM};
        pg8::gemm_phase<pg8::EpiGatedRes, pg8::StaticOrder, true, true>((PG8_LAS unsigned char*)lds_base, g, S, E);
        SEAM(6);
    }
    if (IN_PH(7)) {
        u16* H2 = (u16*)(ws + OFF_H2);
        norm_rows([&](int r) { return (const float*)p.out + (size_t)r * DM; }, NLAT, bid * 4 + lwid(), nblk * 4, p.norm2_w, MOD, 3, 4, H2, lane);
        SEAM(7);
    }
    if (IN_PH(8)) {
        pg8::Gemm g{(const u16*)(ws + OFF_H2), (const u16*)(ws + OFF_WM1), NLAT, DFF, DM}; pg8::StaticOrder S; S.init(NLAT, DFF, (int)gridDim.x, (int)blockIdx.x);
        pg8::EpiRelu2 E{(u16*)(ws + OFF_HID), DFF};
        pg8::gemm_phase<pg8::EpiRelu2, pg8::StaticOrder, true, true>((PG8_LAS unsigned char*)lds_base, g, S, E);
        SEAM(8);
    }
    if (IN_PH(9)) {
        pg8::Gemm g{(const u16*)(ws + OFF_HID), (const u16*)(ws + OFF_WM2), NLAT, DM, DFF}; pg8::StaticOrder S; S.init(NLAT, DM, (int)gridDim.x, (int)blockIdx.x);
        pg8::EpiGatedRes E{p.out, p.out, MOD + 5 * 1024, 6144, DM};
        pg8::gemm_phase<pg8::EpiGatedRes, pg8::StaticOrder, true, true>((PG8_LAS unsigned char*)lds_base, g, S, E);
    }
}

extern "C" void kernel_launch(void* const* d_in, const int* in_sizes, int n_in, void* d_out, int out_size, void* d_ws, size_t ws_size, hipStream_t stream) {
    static int grid = 0;
    if (grid == 0) {
        if (ws_size < WS_NEED) { fprintf(stderr, "kernel_launch: workspace too small (%zu < %zu)\n", ws_size, (size_t)WS_END); grid = -1; return; }
        int dev = 0, cus = 0, per_cu = 0;
        hipGetDevice(&dev);
        hipDeviceGetAttribute(&cus, hipDeviceAttributeMultiprocessorCount, dev);
        hipFuncSetAttribute((const void*)mega, hipFuncAttributeMaxDynamicSharedMemorySize, LDS_BYTES);
        hipOccupancyMaxActiveBlocksPerMultiprocessor(&per_cu, (const void*)mega, 512, LDS_BYTES);
        if (per_cu < 1) per_cu = 1;
        if (per_cu > 1) per_cu = 1;
        grid = cus * per_cu;
        fprintf(stderr, "kernel_launch: cus %d per_cu %d grid %d ws %zu need %zu\n", cus, per_cu, grid, ws_size, (size_t)WS_END);
    }
    if (grid < 0) return;
    if (hipMemsetAsync((unsigned char*)d_ws + OFF_BAR, 0, ZERO_BYTES, stream) != hipSuccess) { fprintf(stderr, "kernel_launch: memset of barrier words failed\n"); return; }
    Params p{};
    const float** pp = (const float**)&p;
    for (int i = 0; i < 18; ++i) pp[i] = (const float*)d_in[i];
    p.out = (float*)d_out; p.ws = (unsigned char*)d_ws;
#if ONE_LAUNCH
    p.ph_lo = 0; p.ph_hi = 9;
    void* args[] = {&p};
    hipError_t e = hipLaunchCooperativeKernel((const void*)mega, dim3(grid), dim3(512), args, LDS_BYTES, stream);
    if (e != hipSuccess) fprintf(stderr, "cooperative launch failed: %s (grid %d)\n", hipGetErrorString(e), grid);
#else
#ifndef DUP_PH
#define DUP_PH -1
#endif
    for (int ph = 0; ph <= 9; ++ph) {
        p.ph_lo = ph; p.ph_hi = ph;
        hipLaunchKernelGGL(mega, dim3(grid), dim3(512), LDS_BYTES, stream, p);
        if (ph == DUP_PH) hipLaunchKernelGGL(mega, dim3(grid), dim3(512), LDS_BYTES, stream, p);
    }
#endif
}
```

```cpp
#include <hip/hip_runtime.h>
#include <hip/hip_cooperative_groups.h>
#include <stdint.h>
#include <cstdio>
namespace cg = cooperative_groups;

#ifndef ONE_LAUNCH
#define ONE_LAUNCH 1
#endif

typedef unsigned short u16;
typedef __bf16 bf2_t __attribute__((ext_vector_type(2)));
typedef float f2_t __attribute__((ext_vector_type(2)));
typedef short bf16x8 __attribute__((ext_vector_type(8)));
typedef float f32x4 __attribute__((ext_vector_type(4)));
typedef float f32x16 __attribute__((ext_vector_type(16)));
typedef unsigned u32x2 __attribute__((ext_vector_type(2)));
typedef unsigned u32x4 __attribute__((ext_vector_type(4)));

#define DI __device__ __forceinline__
DI unsigned pk2(float lo, float hi) { f2_t v = {lo, hi}; return __builtin_bit_cast(unsigned, __builtin_convertvector(v, bf2_t)); }
DI u16 f2bf(float x) { return (u16)(pk2(x, 0.f) & 0xffffu); }
DI float bf2f(u16 v) { return __uint_as_float(((unsigned)v) << 16); }
DI float bflo(unsigned v) { return __uint_as_float(v << 16); }
DI float bfhi(unsigned v) { return __uint_as_float(v & 0xffff0000u); }
DI bf16x8 mk8(unsigned a, unsigned b, unsigned c, unsigned d) { u32x4 v = {a, b, c, d}; return __builtin_bit_cast(bf16x8, v); }
DI bf16x8 mk8(u32x2 lo, u32x2 hi) { u32x4 v = {lo.x, lo.y, hi.x, hi.y}; return __builtin_bit_cast(bf16x8, v); }
#define MFMA16(a, b, c) __builtin_amdgcn_mfma_f32_16x16x32_bf16((a), (b), (c), 0, 0, 0)
#define MFMA32(a, b, c) __builtin_amdgcn_mfma_f32_32x32x16_bf16((a), (b), (c), 0, 0, 0)

constexpr int DM = 1024, NB = 2, SEQ = 8192, NLAT = NB * SEQ, CTXL = 256, NCTX = NB * CTXL, NROW = NLAT + NCTX;
constexpr int INC = 2832, INP = 3072, DFF = 4096, SKV = CTXL + SEQ;
constexpr int NCK = 132;
constexpr int NCU = NB * NCK * 4;
constexpr float EPS = 1e-6f;
constexpr float QSCALE = 0.125f * 1.4426950408889634f;

constexpr size_t OFF_WIN = 0;
constexpr size_t OFF_MOD = OFF_WIN + (size_t)INP * DM * 2;
constexpr size_t OFF_ROPE = OFF_MOD + 3 * 6144 * 4;
constexpr size_t OFF_MISC = OFF_ROPE + 128 * 16 * 8;
constexpr size_t OFF_H = OFF_MISC + 256;
constexpr size_t OFF_WOUT = OFF_H;
constexpr size_t OFF_WM1 = OFF_WOUT + (size_t)DM * DM * 2;
constexpr size_t OFF_WM2 = OFF_WM1 + (size_t)DFF * DM * 2;
constexpr size_t OFF_DQKV = OFF_H + (size_t)NROW * DM * 2;
constexpr size_t OFF_O01 = OFF_DQKV;
constexpr size_t OFF_H2 = OFF_DQKV;
constexpr size_t OFF_MIX = OFF_DQKV + (size_t)NROW * 1536 * 2;
constexpr size_t OFF_HID = OFF_MIX;
constexpr size_t OFF_K = OFF_MIX + (size_t)NLAT * DM * 2;
constexpr size_t OFF_VT = OFF_K + (size_t)NB * 2 * SKV * 64 * 2;
constexpr size_t OFF_GATE = OFF_VT + (size_t)NB * 2 * SKV * 64 * 2;
constexpr size_t OFF_QN = OFF_GATE + (size_t)NROW * 16 * 4;
constexpr size_t OFF_KNT = OFF_QN + (size_t)NCU * 8192 * 2;
constexpr size_t OFF_WNEG = OFF_KNT + (size_t)NCU * 8192 * 2;
constexpr size_t OFF_UT = OFF_WNEG + (size_t)2 * NCU * 8192 * 2;
constexpr size_t OFF_INTRA = OFF_UT + (size_t)2 * NCU * 8192 * 2;
constexpr size_t OFF_SCAL = OFF_INTRA + (size_t)2 * NCU * 4096 * 2;
constexpr size_t WS_END = OFF_SCAL + (size_t)2 * NCU * 192 * 4;
static_assert(OFF_HID + (size_t)NLAT * DFF * 2 <= WS_END, "hid overlay");
static_assert(WS_END + 16384 + 3 * 6144 * 4 + 4 * 16384 * 8 * 4 <= (size_t)256 * 1024 * 1024, "ws budget");

constexpr int LDS_BYTES = 2 * 73728 + 16;
constexpr size_t OFF_BAR = WS_END;
constexpr size_t OFF_MODZ = OFF_BAR + 16384;
constexpr size_t ZERO_BYTES = 16384 + 3 * 6144 * 4;
constexpr size_t OFF_LP = OFF_MODZ + 3 * 6144 * 4;
constexpr size_t WS_NEED = OFF_LP + (size_t)4 * NLAT * 8 * 4;


struct Params {
    const float *x, *c, *ctx, *c_ctx, *w_mod, *b_mod, *norm1_w, *w_in, *q_norm_w, *k_norm_w, *conv_w, *a_log, *dt_bias, *dn_norm_w, *w_out, *norm2_w, *w_mlp1, *w_mlp2;
    float* out; unsigned char* ws; int ph_lo, ph_hi;
};

DI void wconv_tile(const float* __restrict__ W, int K, int N, int Npad, u16* __restrict__ Wt, int tile, float* st) {
    const int ntn = Npad / 64, kt = tile / ntn, nt = tile % ntn, k0 = kt * 64, n0 = nt * 64;
    const int tid = (threadIdx.x & 255), c = tid & 63, r4 = tid >> 6;
    __syncthreads();
#pragma unroll 4
    for (int i = 0; i < 16; ++i) { const int k = i * 4 + r4, n = n0 + c; st[k * 65 + c] = (n < N) ? W[(size_t)(k0 + k) * N + n] : 0.f; }
    __syncthreads();
#pragma unroll 4
    for (int i = 0; i < 16; ++i) { const int n = i * 4 + r4; Wt[(size_t)(n0 + n) * K + k0 + c] = f2bf(st[c * 65 + n]); }
}

template <class Epi>
DI void gemm_tile(const u16* __restrict__ A, int lda, const u16* __restrict__ Bt, int ldb, int K, int m0, int n0, unsigned char* lds, Epi&& epi) {
    const int tid = (threadIdx.x & 255), lane = tid & 63, wid = tid >> 6, wr = wid >> 1, wc = wid & 1, l15 = lane & 15, quad = lane >> 4;
    u16* As = (u16*)lds; u16* Bs = (u16*)(lds + 18432);
    f32x4 acc[4][4];
#pragma unroll
    for (int m = 0; m < 4; ++m)
#pragma unroll
        for (int n = 0; n < 4; ++n) acc[m][n] = (f32x4){0.f, 0.f, 0.f, 0.f};
    u32x4 ra[4], rb[4];
    const int lrow = tid >> 3, lcc = tid & 7;
    const u16* Ap = A + (size_t)(m0 + lrow) * lda + lcc * 8;
    const u16* Bp = Bt + (size_t)(n0 + lrow) * ldb + lcc * 8;
    const int nk = K / 64;
#pragma unroll
    for (int i = 0; i < 4; ++i) { ra[i] = *(const u32x4*)(Ap + (size_t)(32 * i) * lda); rb[i] = *(const u32x4*)(Bp + (size_t)(32 * i) * ldb); }
    __syncthreads();
#pragma unroll
    for (int i = 0; i < 4; ++i) { *(u32x4*)(As + (lrow + 32 * i) * 72 + lcc * 8) = ra[i]; *(u32x4*)(Bs + (lrow + 32 * i) * 72 + lcc * 8) = rb[i]; }
#pragma unroll
    for (int i = 0; i < 4; ++i) { ra[i] = *(const u32x4*)(Ap + (size_t)(32 * i) * lda + 64); rb[i] = *(const u32x4*)(Bp + (size_t)(32 * i) * ldb + 64); }
    __syncthreads();
    for (int kt = 0; kt < nk; ++kt) {
        const u16* Ac = As + (kt & 1) * 18432; const u16* Bc = Bs + (kt & 1) * 18432;
        if (kt + 1 < nk) {
            u16* An = As + ((kt + 1) & 1) * 18432; u16* Bn = Bs + ((kt + 1) & 1) * 18432;
#pragma unroll
            for (int i = 0; i < 4; ++i) { *(u32x4*)(An + (lrow + 32 * i) * 72 + lcc * 8) = ra[i]; *(u32x4*)(Bn + (lrow + 32 * i) * 72 + lcc * 8) = rb[i]; }
        }
        if (kt + 2 < nk) {
#pragma unroll
            for (int i = 0; i < 4; ++i) { ra[i] = *(const u32x4*)(Ap + (size_t)(32 * i) * lda + (kt + 2) * 64); rb[i] = *(const u32x4*)(Bp + (size_t)(32 * i) * ldb + (kt + 2) * 64); }
        }
#pragma unroll
        for (int ks = 0; ks < 2; ++ks) {
            bf16x8 af[4], bfr[4];
#pragma unroll
            for (int m = 0; m < 4; ++m) af[m] = *(const bf16x8*)(Ac + (64 * wr + 16 * m + l15) * 72 + 32 * ks + 8 * quad);
#pragma unroll
            for (int n = 0; n < 4; ++n) bfr[n] = *(const bf16x8*)(Bc + (64 * wc + 16 * n + l15) * 72 + 32 * ks + 8 * quad);
#pragma unroll
            for (int m = 0; m < 4; ++m)
#pragma unroll
                for (int n = 0; n < 4; ++n) acc[m][n] = MFMA16(bfr[n], af[m], acc[m][n]);
        }
        __syncthreads();
    }
    epi(acc, m0 + 64 * wr, n0 + 64 * wc, l15, quad);
}

DI float silu_f(float v) { return v / (1.f + __expf(-v)); }
DI int permpos(int c) { const int k = c & 31; return (c & ~31) | (8 * ((k & 15) >> 2) + 4 * (k >> 4) + (k & 3)); }
DI float wave_max(float v) {
#pragma unroll
    for (int o = 32; o > 0; o >>= 1) v = fmaxf(v, __shfl_xor(v, o));
    return v;
}
DI float wave_sum(float v) {
#pragma unroll
    for (int o = 32; o > 0; o >>= 1) v += __shfl_xor(v, o);
    return v;
}

template <class SrcF>
DI void norm_rows(SrcF srcf, int nrows, int row0, int rstride, const float* __restrict__ nw, const float* __restrict__ MOD, int shift_idx, int scale_idx, u16* __restrict__ dst, int lane) {
    f32x4 w[4], sh[4], sc[4]; int cur = -1;
    f32x4 v[4], nx[4];
    int r = row0;
    if (r < nrows) {
        const float* src = srcf(r);
#pragma unroll
        for (int i = 0; i < 4; ++i) nx[i] = *(const f32x4*)(src + 4 * lane + 256 * i);
    }
    for (; r < nrows; r += rstride) {
#pragma unroll
        for (int i = 0; i < 4; ++i) v[i] = nx[i];
        if (r + rstride < nrows) {
            const float* src = srcf(r + rstride);
#pragma unroll
            for (int i = 0; i < 4; ++i) nx[i] = *(const f32x4*)(src + 4 * lane + 256 * i);
        }
        const int which = r < NLAT ? (r >> 13) : 2;
        if (which != cur) {
            cur = which;
#pragma unroll
            for (int i = 0; i < 4; ++i) {
                const int c = 4 * lane + 256 * i;
                w[i] = *(const f32x4*)(nw + c); sh[i] = *(const f32x4*)(MOD + which * 6144 + shift_idx * 1024 + c); sc[i] = *(const f32x4*)(MOD + which * 6144 + scale_idx * 1024 + c);
                w[i] = w[i] * (sc[i] + 1.f);
            }
        }
        float ss = 0.f;
#pragma unroll
        for (int i = 0; i < 4; ++i) ss += v[i][0] * v[i][0] + v[i][1] * v[i][1] + v[i][2] * v[i][2] + v[i][3] * v[i][3];
        ss = wave_sum(ss);
        const float rinv = rsqrtf(ss * (1.f / 1024.f) + EPS);
#pragma unroll
        for (int i = 0; i < 4; ++i) {
            const f32x4 yv = v[i] * rinv * w[i] + sh[i];
            u32x2 o = {pk2(yv[0], yv[1]), pk2(yv[2], yv[3])};
            *(u32x2*)(dst + (size_t)r * DM + 4 * lane + 256 * i) = o;
        }
    }
}

DI void gdn_prep_unit(const Params& p, int unit, unsigned char* lds) {
    int tid_in = (threadIdx.x & 255); asm volatile("" : "+v"(tid_in));
    const int tid = tid_in, lane = tid & 63, wid = tid >> 6, l15 = lane & 15, quad = lane >> 4;
    const int h = unit & 3, bc = unit >> 2, b = bc / NCK, ck = bc % NCK;
    const bool isctx = ck < 4;
    const int seqlen = isctx ? CTXL : SEQ;
    const int c0 = isctx ? ck * 64 : (ck - 4) * 64;
    const int rowbase = isctx ? (NLAT + b * CTXL) : b * SEQ;
    unsigned char* ws = p.ws;
    const u16* DQ = (const u16*)(ws + OFF_DQKV);
    const float* GT = (const float*)(ws + OFF_GATE);
    u16* Qs = (u16*)lds; u16* Ks = (u16*)(lds + 17408); float* stage = (float*)(lds + 34816);
    float* gs = (float*)(lds + 67840); float* gcs = (float*)(lds + 71936); float* rbs = (float*)(lds + 72448); float* rbe = (float*)(lds + 72960); float* rn = (float*)(lds + 73472);
    u16* QNg = (u16*)(ws + OFF_QN) + (size_t)unit * 8192;
    u16* KNTg = (u16*)(ws + OFF_KNT) + (size_t)unit * 8192;
    __syncthreads();
    {
        const int t = tid >> 2, q4 = tid & 3;
        *(f32x4*)(gs + t * 16 + q4 * 4) = *(const f32x4*)(GT + (size_t)(rowbase + c0 + t) * 16 + q4 * 4);
    }
    const int cch = tid & 127, th = tid >> 7;
    float* part = rbs;
    u32x4 rawreg[5];
    auto raw_fetch = [&](int wh) {
#pragma unroll
        for (int i = 0; i < 5; ++i) {
            const int idx = tid + 256 * i; const int row = idx >> 4, cc = idx & 15, s = c0 - 2 + row;
            u32x4 v = {0u, 0u, 0u, 0u};
            if (idx < 68 * 16 && s >= 0 && s < seqlen) v = *(const u32x4*)(DQ + (size_t)(rowbase + s) * 1536 + wh * 512 + h * 128 + cc * 8);
            rawreg[i] = v;
        }
    };
    raw_fetch(2);
#pragma unroll 1
    for (int wi = 0; wi < 3; ++wi) {
        const int which = wi == 0 ? 2 : wi - 1;
        if (isctx && wi == 1) continue;
        u16* raw = (wi == 0) ? Qs : Ks;
        __syncthreads();
#pragma unroll
        for (int i = 0; i < 5; ++i) {
            const int idx = tid + 256 * i;
            if (idx < 68 * 16) { const int row = idx >> 4, cc = idx & 15; *(u32x4*)(raw + row * 128 + cc * 8) = rawreg[i]; }
        }
        if (wi < 2) raw_fetch((isctx || wi == 1) ? 1 : 0);
        const int col = which * 512 + h * 128 + cch;
        const float w0 = p.conv_w[0 * 1536 + col], w1 = p.conv_w[1 * 1536 + col], w2 = p.conv_w[2 * 1536 + col], w3 = p.conv_w[3 * 1536 + col], w4 = p.conv_w[4 * 1536 + col];
        __syncthreads();
        float y[32];
        {
            const u16* rp = raw + (32 * th) * 128 + cch;
            float xa = bf2f(rp[0]), xb = bf2f(rp[128]), xc = bf2f(rp[256]), xd = bf2f(rp[384]);
#pragma unroll
            for (int i = 0; i < 32; ++i) {
                const float xe = bf2f(rp[(i + 4) * 128]);
                y[i] = silu_f(w0 * xa + w1 * xb + w2 * xc + w3 * xd + w4 * xe);
                xa = xb; xb = xc; xc = xd; xd = xe;
            }
        }
        if (which == 2) {
#pragma unroll
            for (int i = 0; i < 32; ++i) stage[(32 * th + i) * 129 + cch] = y[i];
        } else {
            float mine = 0.f;
#pragma unroll
            for (int i = 0; i < 32; ++i) { const float ssum = wave_sum(y[i] * y[i]); if (lane == i) mine = ssum; }
            if (lane < 32) part[wid * 32 + lane] = mine;
            __syncthreads();
            if (which == 0) {
#pragma unroll
                for (int i = 0; i < 32; ++i) {
                    const int t = 32 * th + i; const float rinv = rsqrtf(part[(2 * th) * 32 + i] + part[(2 * th + 1) * 32 + i] + EPS);
                    const u16 v = f2bf(y[i] * rinv); Qs[t * 136 + cch] = v; QNg[t * 128 + permpos(cch)] = v;
                }
            } else {
                unsigned pkd[16];
#pragma unroll
                for (int i = 0; i < 16; ++i) {
                    const int t = 32 * th + 2 * i;
                    const float r0 = rsqrtf(part[(2 * th) * 32 + 2 * i] + part[(2 * th + 1) * 32 + 2 * i] + EPS), r1 = rsqrtf(part[(2 * th) * 32 + 2 * i + 1] + part[(2 * th + 1) * 32 + 2 * i + 1] + EPS);
                    const unsigned v = pk2(y[2 * i] * r0, y[2 * i + 1] * r1); pkd[i] = v;
                    Ks[t * 136 + cch] = (u16)(v & 0xffffu); Ks[(t + 1) * 136 + cch] = (u16)(v >> 16);
                }
#pragma unroll
                for (int i = 0; i < 4; ++i) { u32x4 v = {pkd[2 * i], pkd[2 * i + 1], pkd[8 + 2 * i], pkd[8 + 2 * i + 1]}; *(u32x4*)(KNTg + cch * 64 + 32 * th + 8 * i) = v; }
            }
        }
    }
    __syncthreads();
    int unit_l = unit, tid_l = tid_in;
    asm volatile("" : "+s"(unit_l)); asm volatile("" : "+v"(tid_l));
    {
    const int unit = unit_l, tid = tid_l, lane = tid & 63, wid = tid >> 6, l15 = lane & 15, quad = lane >> 4;
    if (tid < 128) {
        const int d = tid >> 6, t = tid & 63; float s = 0.f;
        if (d == 0) { for (int u = 0; u <= t; ++u) s += gs[u * 16 + 8 + h]; }
        else        { for (int u = t; u < 64; ++u) s += gs[u * 16 + 12 + h]; }
        gcs[d * 64 + t] = s;
    }
    __syncthreads();
    if (tid < 128) {
        const int d = tid >> 6, t = tid & 63;
        const float gc = gcs[d * 64 + t], gl = gcs[d * 64 + (d ? 0 : 63)], be = gs[t * 16 + d * 4 + h];
        rbs[d * 64 + t] = be; rbe[d * 64 + t] = be * __expf(gc);
        float* SC = (float*)(ws + OFF_SCAL) + ((size_t)d * NCU + unit) * 192;
        SC[t] = __expf(gc) * 0.08838834764831845f; SC[64 + t] = __expf(gl - gc);
        if (t == 0) SC[128] = __expf(gl);
    }
    if (!isctx) {
        f32x4 QK[4];
#pragma unroll
        for (int n = 0; n < 4; ++n) QK[n] = (f32x4){0.f, 0.f, 0.f, 0.f};
#pragma unroll
        for (int ks = 0; ks < 4; ++ks) {
            const bf16x8 aq = *(const bf16x8*)(Qs + (16 * wid + l15) * 136 + 32 * ks + 8 * quad);
#pragma unroll
            for (int n = 0; n < 4; ++n) {
                const bf16x8 bb = *(const bf16x8*)(Ks + (16 * n + l15) * 136 + 32 * ks + 8 * quad);
                QK[n] = MFMA16(aq, bb, QK[n]);
            }
        }
#pragma unroll
        for (int d = 0; d < 2; ++d) {
            u16* INg = (u16*)(ws + OFF_INTRA) + ((size_t)d * NCU + unit) * 4096;
#pragma unroll
            for (int n = 0; n < 4; ++n)
#pragma unroll
                for (int r = 0; r < 4; ++r) {
                    const int i = 16 * wid + 4 * quad + r, j = 16 * n + l15;
                    const bool keep = d ? (j >= i) : (j <= i);
                    const float iv = keep ? QK[n][r] * 0.08838834764831845f * __expf(gcs[d * 64 + i] - gcs[d * 64 + j]) : 0.f;
                    INg[i * 64 + permpos(j)] = f2bf(iv);
                }
        }
    }
    __syncthreads();
    {
        f32x4 G[4];
#pragma unroll
        for (int n = 0; n < 4; ++n) G[n] = (f32x4){0.f, 0.f, 0.f, 0.f};
#pragma unroll
        for (int ks = 0; ks < 4; ++ks) {
            const bf16x8 ak = *(const bf16x8*)(Ks + (16 * wid + l15) * 136 + 32 * ks + 8 * quad);
#pragma unroll
            for (int n = 0; n < 4; ++n) {
                const bf16x8 bb = *(const bf16x8*)(Ks + (16 * n + l15) * 136 + 32 * ks + 8 * quad);
                G[n] = MFMA16(ak, bb, G[n]);
            }
        }
        const int dd = __builtin_amdgcn_readfirstlane(tid >> 7), cc = tid & 127;
        float xwp[64];
#pragma unroll
        for (int ip = 0; ip < 64; ++ip) xwp[ip] = 0.f;
        if (dd == 0) {
#pragma unroll
            for (int ip = 0; ip < 64; ++ip) xwp[ip] = bf2f(Ks[ip * 136 + cc]) * rbe[ip];
        } else {
#pragma unroll
            for (int ip = 0; ip < 64; ++ip) xwp[ip] = bf2f(Ks[(63 - ip) * 136 + cc]) * rbe[64 + 63 - ip];
        }
        asm volatile("" ::: "memory");
        __syncthreads();
        float* Ls0 = (float*)lds; float* Ls1 = (float*)(lds + 17408);
#pragma unroll
        for (int d = 0; d < 2; ++d)
#pragma unroll
            for (int n = 0; n < 4; ++n)
#pragma unroll
                for (int r = 0; r < 4; ++r) {
                    const int i = 16 * wid + 4 * quad + r, j = 16 * n + l15;
                    const int ip = d ? 63 - i : i, jp = d ? 63 - j : j;
                    if (jp < ip) (d ? Ls1 : Ls0)[ip * 64 + jp] = rbs[d * 64 + i] * G[n][r] * __expf(gcs[d * 64 + i] - gcs[d * 64 + j]);
                }
        __syncthreads();
        const float* Lsel = dd ? Ls1 : Ls0;
        f2_t x2[64];
#pragma unroll
        for (int ip = 0; ip < 64; ++ip) x2[ip] = (f2_t){0.f, xwp[ip]};
        if (dd == 0) {
#pragma unroll
            for (int ip = 0; ip < 64; ++ip) x2[ip].x = stage[ip * 129 + cc] * rbs[ip];
        } else {
#pragma unroll
            for (int ip = 0; ip < 64; ++ip) x2[ip].x = stage[(63 - ip) * 129 + cc] * rbs[64 + 63 - ip];
        }
        asm volatile("" ::: "memory");
#pragma unroll
        for (int ip = 0; ip < 64; ++ip) {
            f2_t a2 = x2[ip];
#pragma unroll
            for (int jp = 0; jp < ip; ++jp) { const float l = Lsel[ip * 64 + jp]; a2 -= x2[jp] * l; if ((jp & 7) == 7) asm volatile("" ::: "memory"); }
            x2[ip] = a2;
            asm volatile("" ::: "memory");
        }
        {
            int unit_o = unit, cc_o = cc; asm volatile("" : "+s"(unit_o)); asm volatile("" : "+v"(cc_o));
            u16* WNg = (u16*)(ws + OFF_WNEG) + ((size_t)dd * NCU + unit_o) * 8192 + permpos(cc_o);
#pragma unroll
            for (int ip = 0; ip < 1; ++ip) {}
            if (dd == 0) {
#pragma unroll
                for (int ip = 0; ip < 64; ++ip) { WNg[ip * 128] = f2bf(-x2[ip].y); if ((ip & 7) == 7) asm volatile("" ::: "memory"); }
            } else {
#pragma unroll
                for (int ip = 0; ip < 64; ++ip) { WNg[(63 - ip) * 128] = f2bf(-x2[ip].y); if ((ip & 7) == 7) asm volatile("" ::: "memory"); }
            }
            asm volatile("" ::: "memory");
            u16* UTg = (u16*)(ws + OFF_UT) + ((size_t)dd * NCU + unit_o) * 8192 + cc_o * 64;
            if (dd == 0) {
#pragma unroll
                for (int i = 0; i < 8; ++i) { u32x4 v = {pk2(x2[8 * i].x, x2[8 * i + 1].x), pk2(x2[8 * i + 2].x, x2[8 * i + 3].x), pk2(x2[8 * i + 4].x, x2[8 * i + 5].x), pk2(x2[8 * i + 6].x, x2[8 * i + 7].x)}; *(u32x4*)(UTg + 8 * i) = v; }
            } else {
#pragma unroll
                for (int i = 0; i < 8; ++i) { u32x4 v = {pk2(x2[63 - 8 * i].x, x2[62 - 8 * i].x), pk2(x2[61 - 8 * i].x, x2[60 - 8 * i].x), pk2(x2[59 - 8 * i].x, x2[58 - 8 * i].x), pk2(x2[57 - 8 * i].x, x2[56 - 8 * i].x)}; *(u32x4*)(UTg + 8 * i) = v; }
            }
        }
        __syncthreads();
    }
    }
}

DI void gdn_scan_block(const Params& p, int sb, unsigned char* lds0, unsigned char* lds1, int role) {
    const int tid = (threadIdx.x & 255), lane = tid & 63, wid = tid >> 6, l15 = lane & 15, quad = lane >> 4;
    const int chain = sb >> 1, half = sb & 1, b = chain >> 3, h = (chain >> 1) & 3, d = chain & 1, slice = half * 4 + wid;
    unsigned char* ws = p.ws;
    if (role == 1) {
        u32x4 pre[16]; float presc = 0.f;
        auto issue = [&](int step) {
            const int ck = d ? (step < 4 ? 3 - step : 135 - step) : step;
            const size_t cu = (size_t)(b * NCK + ck) * 4 + h, dcu = (size_t)d * NCU + cu;
            const u32x4* WN = (const u32x4*)(ws + OFF_WNEG + dcu * 16384);
            const u32x4* QN = (const u32x4*)(ws + OFF_QN + cu * 16384);
            const u32x4* KT = (const u32x4*)(ws + OFF_KNT + cu * 16384);
            const u32x4* IN = (const u32x4*)(ws + OFF_INTRA + dcu * 8192);
            const u32x4* UT = (const u32x4*)(ws + OFF_UT + dcu * 16384 + (size_t)half * 8192);
            const float* SC = (const float*)(ws + OFF_SCAL) + dcu * 192;
#pragma unroll
            for (int i = 0; i < 4; ++i) { pre[i] = WN[tid + 256 * i]; pre[4 + i] = QN[tid + 256 * i]; pre[8 + i] = KT[tid + 256 * i]; }
#pragma unroll
            for (int i = 0; i < 2; ++i) { pre[12 + i] = IN[tid + 256 * i]; pre[14 + i] = UT[tid + 256 * i]; }
            if (tid < 192) presc = SC[tid];
        };
        auto commit = [&](unsigned char* L) {
#pragma unroll
            for (int i = 0; i < 4; ++i) {
                const int r16 = (tid >> 4) + 16 * i, c16 = tid & 15;
                *(u32x4*)(L + r16 * 272 + c16 * 16) = pre[i];
                *(u32x4*)(L + 17408 + r16 * 272 + c16 * 16) = pre[4 + i];
                const int r8 = (tid >> 3) + 32 * i, c8 = tid & 7;
                *(u32x4*)(L + 34816 + r8 * 144 + c8 * 16) = pre[8 + i];
            }
#pragma unroll
            for (int i = 0; i < 2; ++i) {
                const int r8 = (tid >> 3) + 32 * i, c8 = tid & 7;
                *(u32x4*)(L + 53248 + r8 * 144 + c8 * 16) = pre[12 + i];
                *(u32x4*)(L + 62464 + r8 * 144 + c8 * 16) = pre[14 + i];
            }
            if (tid < 192) ((float*)(L + 71680))[tid] = presc;
        };
        issue(0); commit(lds0); issue(1);
        __syncthreads();
        for (int step = 0; step < NCK; ++step) {
            if (step + 1 < NCK) { commit(((step + 1) & 1) ? lds1 : lds0); if (step + 2 < NCK) issue(step + 2); }
            __syncthreads();
        }
        return;
    }
    f32x4 S[8];
#pragma unroll
    for (int i = 0; i < 8; ++i) S[i] = (f32x4){0.f, 0.f, 0.f, 0.f};
    u16* Og = (u16*)(ws + OFF_O01) + (size_t)d * NLAT * 512;
    __syncthreads();
    for (int step = 0; step < NCK; ++step) {
        const int ck = d ? (step < 4 ? 3 - step : 135 - step) : step;
        const bool isctx = ck < 4;
        const unsigned char* L = (step & 1) ? lds1 : lds0;
        const u16* WNl = (const u16*)L; const u16* QNl = (const u16*)(L + 17408); const u16* KTl = (const u16*)(L + 34816); const u16* INl = (const u16*)(L + 53248); const u16* UTl = (const u16*)(L + 62464); const float* SCl = (const float*)(L + 71680);
        bf16x8 Sb[4];
#pragma unroll
        for (int ks = 0; ks < 4; ++ks) Sb[ks] = mk8(pk2(S[2 * ks][0], S[2 * ks][1]), pk2(S[2 * ks][2], S[2 * ks][3]), pk2(S[2 * ks + 1][0], S[2 * ks + 1][1]), pk2(S[2 * ks + 1][2], S[2 * ks + 1][3]));
        f32x4 vn[4], o[4];
#pragma unroll
        for (int mt = 0; mt < 4; ++mt) {
            const u32x2 raw = *(const u32x2*)(UTl + (16 * wid + l15) * 72 + 16 * mt + 4 * quad);
            vn[mt] = (f32x4){bflo(raw.x), bfhi(raw.x), bflo(raw.y), bfhi(raw.y)};
#pragma unroll
            for (int ks = 0; ks < 4; ++ks) {
                const bf16x8 a = *(const bf16x8*)(WNl + (16 * mt + l15) * 136 + 32 * ks + 8 * quad);
                vn[mt] = MFMA16(a, Sb[ks], vn[mt]);
            }
        }
        if (!isctx) {
#pragma unroll
            for (int mt = 0; mt < 4; ++mt) {
                o[mt] = (f32x4){0.f, 0.f, 0.f, 0.f};
#pragma unroll
                for (int ks = 0; ks < 4; ++ks) {
                    const bf16x8 a = *(const bf16x8*)(QNl + (16 * mt + l15) * 136 + 32 * ks + 8 * quad);
                    o[mt] = MFMA16(a, Sb[ks], o[mt]);
                }
                const f32x4 qs = *(const f32x4*)(SCl + 16 * mt + 4 * quad);
                o[mt] = o[mt] * qs;
            }
        }
        bf16x8 vb[2], vsb[2];
        {
            f32x4 kc[4];
#pragma unroll
            for (int mt = 0; mt < 4; ++mt) kc[mt] = *(const f32x4*)(SCl + 64 + 16 * mt + 4 * quad);
#pragma unroll
            for (int k2 = 0; k2 < 2; ++k2) {
                const f32x4 a = vn[2 * k2], c = vn[2 * k2 + 1];
                vb[k2] = mk8(pk2(a[0], a[1]), pk2(a[2], a[3]), pk2(c[0], c[1]), pk2(c[2], c[3]));
                const f32x4 as = a * kc[2 * k2], cs = c * kc[2 * k2 + 1];
                vsb[k2] = mk8(pk2(as[0], as[1]), pk2(as[2], as[3]), pk2(cs[0], cs[1]), pk2(cs[2], cs[3]));
            }
        }
        const float egl = SCl[128];
#pragma unroll
        for (int st = 0; st < 8; ++st) {
            S[st] = S[st] * egl;
#pragma unroll
            for (int k2 = 0; k2 < 2; ++k2) {
                const bf16x8 a = *(const bf16x8*)(KTl + (16 * st + l15) * 72 + 32 * k2 + 8 * quad);
                S[st] = MFMA16(a, vsb[k2], S[st]);
            }
        }
        if (!isctx) {
            const int tok0 = b * SEQ + (ck - 4) * 64;
#pragma unroll
            for (int mt = 0; mt < 4; ++mt) {
#pragma unroll
                for (int k2 = 0; k2 < 2; ++k2) {
                    const bf16x8 a = *(const bf16x8*)(INl + (16 * mt + l15) * 72 + 32 * k2 + 8 * quad);
                    o[mt] = MFMA16(a, vb[k2], o[mt]);
                }
#pragma unroll
                for (int r = 0; r < 4; ++r) Og[(size_t)(tok0 + 16 * mt + 4 * quad + r) * 512 + h * 128 + 16 * slice + l15] = f2bf(o[mt][r]);
            }
        }
        __syncthreads();
    }
}

template <bool SHIFT>
DI void attn_unit(const Params& p, int P, int half, unsigned char* lds, float Mb) {
    const int tid = (threadIdx.x & 255), lane = tid & 63, wid = tid >> 6, l31 = lane & 31, hh = lane >> 5;
    const int kh = P & 3, qb = 2 * ((P >> 2) & 63) + half, bk = P >> 8, b = bk >> 1, kvh = bk & 1, head = kvh * 4 + wid;
    unsigned char* ws = p.ws;
    const u16* MIX = (const u16*)(ws + OFF_MIX);
    constexpr int NT = SKV / 64 / 4;
    const u16* Kg = (const u16*)(ws + OFF_K) + (size_t)bk * SKV * 64 + (size_t)kh * NT * 64 * 64;
    const u16* Vg = (const u16*)(ws + OFF_VT) + (size_t)bk * 64 * SKV + (size_t)kh * NT * 64;
    u16* Kl = (u16*)lds; u16* Vl = (u16*)(lds + 36864);
    const int tokA = b * SEQ + qb * 64 + l31;
    const size_t qrowA = (size_t)tokA * DM + head * 64, qrowB = qrowA + (size_t)32 * DM;
    bf16x8 qfA[4], qfB[4];
#pragma unroll
    for (int ks = 0; ks < 4; ++ks) { qfA[ks] = *(const bf16x8*)(MIX + qrowA + 16 * ks + 8 * hh); qfB[ks] = *(const bf16x8*)(MIX + qrowB + 16 * ks + 8 * hh); }
    f32x16 o0A, o1A, o0B, o1B; f2_t l2A = {0.f, 0.f}, l2B = {0.f, 0.f};
#pragma unroll
    for (int i = 0; i < 16; ++i) { o0A[i] = 0.f; o1A[i] = 0.f; o0B[i] = 0.f; o1B[i] = 0.f; }
    const bf16x8 ones = mk8(0x3f803f80u, 0x3f803f80u, 0x3f803f80u, 0x3f803f80u);
    int t5_ = (int)threadIdx.x; asm volatile("" : "+v"(t5_));
    const int lrow = t5_ >> 3, lcc = t5_ & 7;
    u32x4 rk, rv;
    {
        const u32x4 k0 = *(const u32x4*)(Kg + (size_t)lrow * 64 + lcc * 8), v0 = *(const u32x4*)(Vg + (size_t)lrow * SKV + lcc * 8);
        rk = *(const u32x4*)(Kg + (size_t)(64 + lrow) * 64 + lcc * 8); rv = *(const u32x4*)(Vg + (size_t)lrow * SKV + 64 + lcc * 8);
        __syncthreads();
        *(u32x4*)(Kl + lrow * 72 + lcc * 8) = k0; *(u32x4*)(Vl + lrow * 72 + lcc * 8) = v0;
    }
    __syncthreads();
    for (int kt = 0; kt < NT; ++kt) {
        const u16* Kc = Kl + (kt & 1) * 9216; const u16* Vc = Vl + (kt & 1) * 9216;
        if (kt + 1 < NT) {
            u16* Kn = Kl + ((kt + 1) & 1) * 9216; u16* Vn = Vl + ((kt + 1) & 1) * 9216;
            *(u32x4*)(Kn + lrow * 72 + lcc * 8) = rk; *(u32x4*)(Vn + lrow * 72 + lcc * 8) = rv;
        }
        if (kt + 2 < NT) { rk = *(const u32x4*)(Kg + (size_t)((kt + 2) * 64 + lrow) * 64 + lcc * 8); rv = *(const u32x4*)(Vg + (size_t)lrow * SKV + (kt + 2) * 64 + lcc * 8); }
#pragma unroll
        for (int sub = 0; sub < 2; ++sub) {
            f32x16 sA, sB;
#pragma unroll
            for (int i = 0; i < 16; ++i) { sA[i] = SHIFT ? -Mb : 0.f; sB[i] = SHIFT ? -Mb : 0.f; }
#pragma unroll
            for (int ks = 0; ks < 4; ++ks) {
                const bf16x8 kf = *(const bf16x8*)(Kc + (sub * 32 + l31) * 72 + 16 * ks + 8 * hh);
                sA = MFMA32(kf, qfA[ks], sA); sB = MFMA32(kf, qfB[ks], sB);
            }
#pragma unroll
            for (int i = 0; i < 16; ++i) { sA[i] = __builtin_amdgcn_exp2f(sA[i]); sB[i] = __builtin_amdgcn_exp2f(sB[i]); }
#pragma unroll
            for (int i = 0; i < 8; ++i) { l2A += (f2_t){sA[2 * i], sA[2 * i + 1]}; l2B += (f2_t){sB[2 * i], sB[2 * i + 1]}; }
#pragma unroll
            for (int sp = 0; sp < 2; ++sp) {
                const bf16x8 pA = mk8(pk2(sA[8 * sp], sA[8 * sp + 1]), pk2(sA[8 * sp + 2], sA[8 * sp + 3]), pk2(sA[8 * sp + 4], sA[8 * sp + 5]), pk2(sA[8 * sp + 6], sA[8 * sp + 7]));
                const bf16x8 pB = mk8(pk2(sB[8 * sp], sB[8 * sp + 1]), pk2(sB[8 * sp + 2], sB[8 * sp + 3]), pk2(sB[8 * sp + 4], sB[8 * sp + 5]), pk2(sB[8 * sp + 6], sB[8 * sp + 7]));
                const u16* v0 = Vc + l31 * 72 + sub * 32 + 16 * sp + 4 * hh;
                const bf16x8 vf0 = mk8(*(const u32x2*)v0, *(const u32x2*)(v0 + 8));
                const bf16x8 vf1 = mk8(*(const u32x2*)(v0 + 32 * 72), *(const u32x2*)(v0 + 32 * 72 + 8));
                o0A = MFMA32(vf0, pA, o0A); o0B = MFMA32(vf0, pB, o0B); o1A = MFMA32(vf1, pA, o1A); o1B = MFMA32(vf1, pB, o1B);
            }
        }
        __syncthreads();
    }
    float* LP = (float*)(ws + OFF_LP) + (size_t)kh * NLAT * 8;
    float lsA = l2A.x + l2A.y, lsB = l2B.x + l2B.y; lsA += __shfl_xor(lsA, 32); lsB += __shfl_xor(lsB, 32);
    int lane_o = lane; asm volatile("" : "+v"(lane_o));
    const int tokO = b * SEQ + qb * 64 + (lane_o & 31);
    if (hh == 0) { LP[(size_t)tokO * 8 + head] = lsA; LP[(size_t)(tokO + 32) * 8 + head] = lsB; }
    u16* OPA = (u16*)p.out + (size_t)kh * NLAT * 512 + (size_t)tokO * 512 + head * 64;
    u16* OPB = OPA + (size_t)32 * 512;
#pragma unroll
    for (int g = 0; g < 4; ++g) {
        { u32x2 w0 = {pk2(o0A[4 * g], o0A[4 * g + 1]), pk2(o0A[4 * g + 2], o0A[4 * g + 3])}; u32x2 w1 = {pk2(o1A[4 * g], o1A[4 * g + 1]), pk2(o1A[4 * g + 2], o1A[4 * g + 3])};
          *(u32x2*)(OPA + 8 * g + 4 * hh) = w0; *(u32x2*)(OPA + 32 + 8 * g + 4 * hh) = w1; }
        { u32x2 w0 = {pk2(o0B[4 * g], o0B[4 * g + 1]), pk2(o0B[4 * g + 2], o0B[4 * g + 3])}; u32x2 w1 = {pk2(o1B[4 * g], o1B[4 * g + 1]), pk2(o1B[4 * g + 2], o1B[4 * g + 3])};
          *(u32x2*)(OPB + 8 * g + 4 * hh) = w0; *(u32x2*)(OPB + 32 + 8 * g + 4 * hh) = w1; }
    }
}

namespace pg8 {
#define PG8_LAS __attribute__((address_space(3)))
typedef unsigned short bf16_t;
typedef short bf16x8 __attribute__((ext_vector_type(8)));
typedef float f32x4 __attribute__((ext_vector_type(4)));
typedef unsigned u32x4 __attribute__((ext_vector_type(4)));
constexpr int BM = 256, BK = 64, HALF = 128, HTB = HALF * BK * 2  , STAGE_BYTES = 8 * HTB, NXCD = 8, WGM = 8;

__host__ __device__ __forceinline__ int lds_byte(int r, int c) { const int st = (r >> 4) * 2 + (c >> 5), rr = r & 15, cc = c & 31, ob = rr * 64 + cc * 2; return st * 1024 + (ob ^ (((ob >> 9) & 1) << 5)); }
__host__ __device__ __forceinline__ void stage_rc(int b, int& R, int& C) { const int st = b / 1024, sb = b % 1024, swz = sb ^ (((sb >> 9) & 1) << 5); R = (st >> 1) * 16 + swz / 64; C = (st & 1) * 32 + (swz % 64) / 2; }
__host__ __device__ __forceinline__ int perm32(int rho) { const int n = rho >> 4, i = rho & 15; return 8 * (i >> 2) + 4 * n + (i & 3); }

struct Unit { int pm, pn; };
struct Gemm { const bf16_t* A; const bf16_t* Bt; int M, N, K; };

struct StaticOrder {
    int nM, nN, nwg, G, c;
    __host__ __device__ void init(int M, int N, int G_, int c_) { nM = M / BM; nN = N / BM; nwg = nM * nN; G = G_; c = c_; }
    __host__ __device__ bool next(int i, Unit& u) const {
        const long L = (long)i * G + c; if (L >= nwg) return false;
        int wgid = (int)L; { const int q = nwg / NXCD, r = nwg % NXCD, xcd = wgid % NXCD, off = wgid / NXCD; wgid = (xcd < r ? xcd * (q + 1) : r * (q + 1) + (xcd - r) * q) + off; }
        const int nig = WGM * nN, gid = wgid / nig, fm = gid * WGM, gsz = (nM - fm) < WGM ? (nM - fm) : WGM;
        u.pm = fm + ((wgid % nig) % gsz); u.pn = (wgid % nig) / gsz; return true;
    }
    __device__ __forceinline__ void a_ready(const Unit&) const {}
    __device__ __forceinline__ void done(const Unit&) const {}
};


template <class Epi, class Sched, bool ALIGN_EPI = false, bool SP2 = false>
__device__ __forceinline__ void gemm_phase(PG8_LAS unsigned char* lds, const Gemm g, const Sched& S, const Epi& E) {
    const int tid = threadIdx.x, wid = __builtin_amdgcn_readfirstlane(tid >> 6), lane = tid & 63, wr = wid >> 2, wc = wid & 3, fr = lane & 15, fq = lane >> 4;
    const int K = g.K, nt = K / BK;
    unsigned voffA[2], voffB[2];
#pragma unroll
    for (int i = 0; i < 2; ++i) { int R, C; stage_rc(tid * 16 + i * 8192, R, C); const int Rb = Epi::PERM ? ((R & ~31) + perm32(R & 31)) : R;
        voffA[i] = (unsigned)(R * K + C) * 2u; voffB[i] = (unsigned)(Rb * K + C) * 2u; }
    const size_t kstep = (size_t)(BK * 2);
    const size_t hstep = (size_t)HALF * K * 2;
    const size_t tstep = 2 * hstep;
    const unsigned ldsw = (unsigned)wid * 1024u;
    const int aoff = lds_byte(wr * 64 + fr, fq * 8), boff = lds_byte(wc * 32 + fr, fq * 8);
#define PG8_SA(b, h) (((b) * 2 + (h)) * HTB)
#define PG8_SB(b, h) ((4 + (b) * 2 + (h)) * HTB)
#define PG8_STAGE(bufoff, gbase, voff) do { _Pragma("unroll") for (int _i = 0; _i < 2; ++_i) \
        __builtin_amdgcn_global_load_lds((const unsigned*)((const char*)(gbase) + (voff)[_i]), (PG8_LAS unsigned*)(lds + (bufoff) + ldsw + _i * 8192), 16, 0, 0); } while (0)
#define PG8_LDA(dst, b, h) do { _Pragma("unroll") for (int m = 0; m < 4; ++m) _Pragma("unroll") for (int k = 0; k < 2; ++k) dst[m][k] = *(const PG8_LAS bf16x8*)(lds + PG8_SA(b, h) + aoff + m * 2048 + k * 1024); } while (0)
#define PG8_LDB(dst, b, h) do { _Pragma("unroll") for (int n = 0; n < 2; ++n) _Pragma("unroll") for (int k = 0; k < 2; ++k) dst[n][k] = *(const PG8_LAS bf16x8*)(lds + PG8_SB(b, h) + boff + n * 2048 + k * 1024); } while (0)
#define PG8_MMA(ai, bj, At, Bt) do { __builtin_amdgcn_s_setprio(1); _Pragma("unroll") for (int m = 0; m < 4; ++m) _Pragma("unroll") for (int n = 0; n < 2; ++n) _Pragma("unroll") for (int k = 0; k < 2; ++k) \
        acc[ai][bj][m][n] = __builtin_amdgcn_mfma_f32_16x16x32_bf16(Bt[n][k], At[m][k], acc[ai][bj][m][n], 0, 0, 0); __builtin_amdgcn_s_setprio(0); } while (0)
#define PG8_WAIT_V(n) asm volatile("s_waitcnt vmcnt(" #n ")" ::: "memory")
#define PG8_WAIT_L(n) asm volatile("s_waitcnt lgkmcnt(" #n ")" ::: "memory")
#define PG8_BAR __builtin_amdgcn_s_barrier()
#define PG8_SCHED __builtin_amdgcn_sched_barrier(0)
    Unit cur, nxt; int ui = 0;
    if (!S.next(0, cur)) return;
    f32x4 acc[2][2][4][2];
#pragma unroll
    for (int a = 0; a < 2; ++a)
#pragma unroll
        for (int b = 0; b < 2; ++b)
#pragma unroll
            for (int m = 0; m < 4; ++m)
#pragma unroll
                for (int n = 0; n < 2; ++n) acc[a][b][m][n] = (f32x4){0.f, 0.f, 0.f, 0.f};
    bf16x8 At[4][2], B0[2][2], B1[2][2];
    const char* cA = (const char*)g.A + (size_t)cur.pm * tstep; const char* cB = (const char*)g.Bt + (size_t)cur.pn * tstep;
    S.a_ready(cur);
    if constexpr (SP2) {
        PG8_STAGE(PG8_SB(0, 0), cB, voffB); PG8_STAGE(PG8_SB(0, 1), cB + hstep, voffB); PG8_STAGE(PG8_SA(0, 0), cA, voffA); PG8_STAGE(PG8_SA(0, 1), cA + hstep, voffA);
        if (wr == 1) PG8_BAR;
        PG8_WAIT_V(2); PG8_BAR;
        PG8_STAGE(PG8_SB(1, 0), cB + kstep, voffB); PG8_STAGE(PG8_SA(1, 0), cA + kstep, voffA); PG8_STAGE(PG8_SB(1, 1), cB + hstep + kstep, voffB);
        PG8_WAIT_V(6); PG8_BAR;
    } else {
        PG8_STAGE(PG8_SB(0, 0), cB, voffB); PG8_STAGE(PG8_SA(0, 0), cA, voffA); PG8_STAGE(PG8_SB(0, 1), cB + hstep, voffB); PG8_STAGE(PG8_SA(0, 1), cA + hstep, voffA);
        if (wr == 1) PG8_BAR;
        PG8_WAIT_V(4); PG8_BAR;
        PG8_STAGE(PG8_SB(1, 0), cB + kstep, voffB); PG8_STAGE(PG8_SA(1, 0), cA + kstep, voffA); PG8_STAGE(PG8_SB(1, 1), cB + hstep + kstep, voffB);
        PG8_WAIT_V(6); PG8_BAR;
    }
    for (;;) {
        const bool has_next = S.next(ui + 1, nxt);
        const char* nA = has_next ? (const char*)g.A + (size_t)nxt.pm * tstep : cA; const char* nB = has_next ? (const char*)g.Bt + (size_t)nxt.pn * tstep : cB;
        for (int t = 0; t < nt; t += 2) {
            const bool last = (t == nt - 2);
            const char* a1 = cA + (size_t)(t + 1) * kstep;
            const char* a2 = last ? nA : cA + (size_t)(t + 2) * kstep; const char* b2 = last ? nB : cB + (size_t)(t + 2) * kstep;
            const char* a3 = a2 + kstep; const char* b3 = b2 + kstep;
            if (last && has_next) S.a_ready(nxt);
            if constexpr (SP2) {
            PG8_LDB(B0, 0, 0); PG8_LDB(B1, 0, 1); PG8_SCHED; PG8_LDA(At, 0, 0); PG8_STAGE(PG8_SA(1, 1), a1 + hstep, voffA);
            PG8_WAIT_V(8); PG8_WAIT_L(0); PG8_BAR; PG8_MMA(0, 0, At, B0); PG8_MMA(0, 1, At, B1); PG8_BAR; PG8_SCHED;
            PG8_LDA(At, 0, 1); PG8_STAGE(PG8_SB(0, 0), b2, voffB); PG8_STAGE(PG8_SB(0, 1), b2 + hstep, voffB); PG8_STAGE(PG8_SA(0, 0), a2, voffA);
            PG8_WAIT_V(8); PG8_WAIT_L(0); PG8_BAR; PG8_MMA(1, 0, At, B0); PG8_MMA(1, 1, At, B1); PG8_BAR; PG8_SCHED;
            PG8_LDB(B0, 1, 0); PG8_LDB(B1, 1, 1); PG8_SCHED; PG8_LDA(At, 1, 0); PG8_STAGE(PG8_SA(0, 1), a2 + hstep, voffA);
            PG8_WAIT_V(8); PG8_WAIT_L(0); PG8_BAR; PG8_MMA(0, 0, At, B0); PG8_MMA(0, 1, At, B1); PG8_BAR; PG8_SCHED;
            PG8_LDA(At, 1, 1); PG8_STAGE(PG8_SB(1, 0), b3, voffB); PG8_STAGE(PG8_SB(1, 1), b3 + hstep, voffB); PG8_STAGE(PG8_SA(1, 0), a3, voffA);
            PG8_WAIT_V(8); PG8_WAIT_L(0); PG8_BAR; PG8_MMA(1, 0, At, B0); PG8_MMA(1, 1, At, B1); PG8_BAR; PG8_SCHED;
            } else {
            PG8_LDB(B0, 0, 0); PG8_SCHED; PG8_LDA(At, 0, 0); PG8_STAGE(PG8_SA(1, 1), a1 + hstep, voffA);
            PG8_WAIT_L(8); PG8_BAR; PG8_WAIT_L(0); PG8_MMA(0, 0, At, B0); PG8_BAR; PG8_SCHED;
            PG8_LDB(B1, 0, 1); PG8_STAGE(PG8_SB(0, 0), b2, voffB);
            PG8_BAR; PG8_WAIT_L(0); PG8_MMA(0, 1, At, B1); PG8_BAR;
            PG8_LDA(At, 0, 1); PG8_STAGE(PG8_SA(0, 0), a2, voffA);
            PG8_BAR; PG8_WAIT_L(0); PG8_MMA(1, 0, At, B0); PG8_BAR; PG8_SCHED;
            PG8_STAGE(PG8_SB(0, 1), b2 + hstep, voffB);
            PG8_WAIT_V(6); PG8_BAR; PG8_MMA(1, 1, At, B1); PG8_BAR;
            PG8_LDB(B0, 1, 0); PG8_SCHED; PG8_LDA(At, 1, 0); PG8_STAGE(PG8_SA(0, 1), a2 + hstep, voffA);
            PG8_WAIT_L(8); PG8_BAR; PG8_WAIT_L(0); PG8_MMA(0, 0, At, B0); PG8_BAR; PG8_SCHED;
            PG8_LDB(B1, 1, 1); PG8_STAGE(PG8_SB(1, 0), b3, voffB);
            PG8_BAR; PG8_WAIT_L(0); PG8_MMA(0, 1, At, B1); PG8_BAR;
            PG8_LDA(At, 1, 1); PG8_STAGE(PG8_SA(1, 0), a3, voffA);
            PG8_BAR; PG8_WAIT_L(0); PG8_MMA(1, 0, At, B0); PG8_BAR; PG8_SCHED;
            PG8_STAGE(PG8_SB(1, 1), b3 + hstep, voffB);
            PG8_WAIT_V(6); PG8_BAR; PG8_MMA(1, 1, At, B1); PG8_BAR;
            }
        }
        if constexpr (ALIGN_EPI) { if (wr == 0) PG8_BAR; }
        if constexpr (!Epi::AFTER_DRAIN) { E(acc, cur, wr, wc, fr, fq); S.done(cur); }
        if (!has_next) break;
#pragma unroll
        for (int a = 0; a < 2; ++a)
#pragma unroll
            for (int b = 0; b < 2; ++b)
#pragma unroll
                for (int m = 0; m < 4; ++m)
#pragma unroll
                    for (int n = 0; n < 2; ++n) acc[a][b][m][n] = (f32x4){0.f, 0.f, 0.f, 0.f};
        cur = nxt; cA = nA; cB = nB; ++ui;
        if constexpr (ALIGN_EPI) { if (wr == 1) PG8_BAR; }
    }
    PG8_WAIT_V(0);
    if constexpr (!ALIGN_EPI) { if (wr == 0) PG8_BAR; }
    PG8_BAR;
    if constexpr (Epi::AFTER_DRAIN) { E.fused(acc, cur, wr, wc, fr, fq, lds, wid, lane); S.done(cur); }
#undef PG8_SA
#undef PG8_SB
#undef PG8_STAGE
#undef PG8_LDA
#undef PG8_LDB
#undef PG8_MMA
#undef PG8_WAIT_V
#undef PG8_WAIT_L
#undef PG8_BAR
#undef PG8_SCHED
}

struct EpiRelu2 {
    static constexpr bool PERM = true, AFTER_DRAIN = false;
    bf16_t* O; int ldc;
    __device__ __forceinline__ void operator()(const f32x4 (&acc)[2][2][4][2], const Unit& u, int wr, int wc, int fr, int fq) const {
#pragma unroll
        for (int ai = 0; ai < 2; ++ai)
#pragma unroll
            for (int m = 0; m < 4; ++m) {
                bf16_t* rowp = O + (size_t)(u.pm * BM + ai * HALF + wr * 64 + m * 16 + fr) * ldc + u.pn * BM + wc * 32 + 8 * fq;
#pragma unroll
                for (int bj = 0; bj < 2; ++bj) {
                    f32x4 v0 = acc[ai][bj][m][0], v1 = acc[ai][bj][m][1];
#pragma unroll
                    for (int r = 0; r < 4; ++r) { const float a = fmaxf(v0[r], 0.f); v0[r] = a * a; const float c = fmaxf(v1[r], 0.f); v1[r] = c * c; }
                    u32x4 w = {::pk2(v0[0], v0[1]), ::pk2(v0[2], v0[3]), ::pk2(v1[0], v1[1]), ::pk2(v1[2], v1[3])};
                    *(u32x4*)(rowp + bj * HALF) = w;
                }
            }
    }
};
struct EpiGatedRes {
    static constexpr bool PERM = true, AFTER_DRAIN = false;
    const float* base; float* out; const float* gate; int gate_bstride; int ldc;
    __device__ __forceinline__ void operator()(const f32x4 (&acc)[2][2][4][2], const Unit& u, int wr, int wc, int fr, int fq) const {
        const float* g = gate + ((u.pm * BM) >> 13) * gate_bstride;
        const int col0 = u.pn * BM + wc * 32 + 8 * fq;
        f32x4 gv[2][2];
#pragma unroll
        for (int bj = 0; bj < 2; ++bj)
#pragma unroll
            for (int n = 0; n < 2; ++n) gv[bj][n] = *(const f32x4*)(g + col0 + bj * HALF + n * 4);
#pragma unroll
        for (int ai = 0; ai < 2; ++ai)
#pragma unroll
            for (int m = 0; m < 4; ++m) {
                const size_t off = (size_t)(u.pm * BM + ai * HALF + wr * 64 + m * 16 + fr) * ldc + col0;
#pragma unroll
                for (int bj = 0; bj < 2; ++bj)
#pragma unroll
                    for (int n = 0; n < 2; ++n) {
                        const f32x4 xv = *(const f32x4*)(base + off + bj * HALF + n * 4);
                        *(f32x4*)(out + off + bj * HALF + n * 4) = xv + gv[bj][n] * acc[ai][bj][m][n];
                    }
            }
    }
};
struct EpiInProj {
    static constexpr bool PERM = true, AFTER_DRAIN = false;
    bf16_t* MIX; bf16_t* Kb; bf16_t* Vt; bf16_t* DQ; float* GT; const float* a_log; const float* dt_bias;
    __device__ __forceinline__ void operator()(const f32x4 (&acc)[2][2][4][2], const Unit& u, int wr, int wc, int fr, int fq) const {
        const int pn = u.pn; const bool lat = u.pm < 64;
#pragma unroll
        for (int ai = 0; ai < 2; ++ai)
#pragma unroll
            for (int m = 0; m < 4; ++m) {
                const int gr = u.pm * BM + ai * HALF + wr * 64 + m * 16 + fr;
                int bb, kvpos;
                if (lat) { bb = gr >> 13; kvpos = 256 + (gr & 8191); } else { const int cr = gr - 16384; bb = cr >> 8; kvpos = cr & 255; }
#pragma unroll
                for (int bj = 0; bj < 2; ++bj) {
                    const int cl = bj * HALF + wc * 32 + 8 * fq;
                    const f32x4 v0 = acc[ai][bj][m][0], v1 = acc[ai][bj][m][1];
                    const u32x4 w = {::pk2(v0[0], v0[1]), ::pk2(v0[2], v0[3]), ::pk2(v1[0], v1[1]), ::pk2(v1[2], v1[3])};
                    if (pn < 2) { if (lat) *(u32x4*)(MIX + (size_t)gr * 1024 + pn * 256 + cl) = w; }
                    else if (pn == 2) {
                        if (bj == 0) { const int kvh = cl >> 6, d = cl & 63; *(u32x4*)(Kb + ((size_t)(bb * 2 + kvh) * 8448 + kvpos) * 64 + d) = w; }
                        else { const int c2 = cl - HALF, kvh = c2 >> 6, d = c2 & 63; bf16_t* vp = Vt + ((size_t)(bb * 2 + kvh) * 64 + d) * 8448 + kvpos;
#pragma unroll
                            for (int e = 0; e < 4; ++e) { vp[(2 * e) * 8448] = (bf16_t)(w[e] & 0xffffu); vp[(2 * e + 1) * 8448] = (bf16_t)(w[e] >> 16); } }
                    }
                    else if (pn < 9) *(u32x4*)(DQ + (size_t)gr * 1536 + (pn - 3) * 256 + cl) = w;
                    else { if (lat) *(u32x4*)(MIX + (size_t)gr * 1024 + 512 + (pn - 9) * 256 + cl) = w; }
                }
            }
    }
};
}

#define XB_TMO      128
#define XB_XCNT(j)  (256  + 64 * (j))
#define XB_XSUB(j)  (1280 + 64 * (j))
#define XB_XGEN(j)  (2304 + 64 * (j))
#define XB_TOP      3328
#define XB_TOPGEN   3392
#define XCD_BAR_WORDS 3456
#define XB_SPIN_CAP (1u << 22)
#define LAS __attribute__((address_space(3)))
DI unsigned xb_ld(unsigned* p)              { return __hip_atomic_load(p, __ATOMIC_RELAXED, __HIP_MEMORY_SCOPE_AGENT); }
DI unsigned xb_add(unsigned* p, unsigned v) { return __hip_atomic_fetch_add(p, v, __ATOMIC_RELAXED, __HIP_MEMORY_SCOPE_AGENT); }
DI unsigned xb_xcc_id() { return (unsigned)__builtin_amdgcn_s_getreg((3 << 11) | 20) & 0xFu; }
#define XB_SPIN(cond, bar) do { unsigned _sp = 0; while (cond) { __builtin_amdgcn_s_sleep(1); \
    if ((++_sp & 255u) == 0u) { if (xb_ld(&(bar)[XB_TMO])) break; if (_sp > XB_SPIN_CAP) { atomicAdd(&(bar)[XB_TMO], 1u); break; } } } } while (0)
struct XcdBarrier { unsigned* bar; unsigned x; volatile LAS unsigned* st; };
DI XcdBarrier xcd_barrier_post(unsigned* bar, volatile LAS unsigned* st) {
    XcdBarrier b; b.bar = bar; b.x = xb_xcc_id(); b.st = st;
    if (threadIdx.x == 0) (void)xb_add(&bar[XB_XCNT(b.x)], 1u);
    return b;
}
DI void xcd_barrier_complete(unsigned* bar, unsigned x, unsigned& nloc, unsigned& nx) {
    const unsigned G = gridDim.x * gridDim.y * gridDim.z;
    unsigned sum, cnt, mine, sp = 0u;
    for (;;) {
        sum = 0u; cnt = 0u; mine = 0u;
#pragma unroll
        for (unsigned j = 0; j < 16; ++j) { const unsigned c = xb_ld(&bar[XB_XCNT(j)]); sum += c; cnt += (c > 0u) ? 1u : 0u; mine = (j == x) ? c : mine; }
        if (sum == G) break;
        __builtin_amdgcn_s_sleep(1);
        if ((++sp & 255u) == 0u) { if (xb_ld(&bar[XB_TMO])) break; if (sp > XB_SPIN_CAP) { atomicAdd(&bar[XB_TMO], 1u); break; } }
    }
    nloc = mine > 0u ? mine : 1u; nx = cnt > 0u ? cnt : 1u;
}
DI void xcd_barrier(const XcdBarrier& b) {
    asm volatile("s_waitcnt vmcnt(0)" ::: "memory");
    __syncthreads();
    if (threadIdx.x == 0) {
        unsigned* bar = b.bar;
        __builtin_amdgcn_s_waitcnt(0);
        unsigned nloc = b.st[0], nx = b.st[1];
        if (nloc == 0u) { xcd_barrier_complete(bar, b.x, nloc, nx); b.st[0] = nloc; b.st[1] = nx; }
        const unsigned old = xb_add(&bar[XB_XSUB(b.x)], 1u);
        const unsigned gen = old / nloc;
        if (old + 1u == (gen + 1u) * nloc) {
            __builtin_amdgcn_fence(__ATOMIC_RELEASE, "agent");
            asm volatile("s_waitcnt vmcnt(0)" ::: "memory");
            const unsigned og = xb_add(&bar[XB_TOP], 1u);
            const unsigned tg = og / nx;
            if (og + 1u == (tg + 1u) * nx) xb_add(&bar[XB_TOPGEN], 1u);
            else XB_SPIN(xb_ld(&bar[XB_TOPGEN]) == tg, bar);
            __builtin_amdgcn_fence(__ATOMIC_ACQUIRE, "agent");
            xb_add(&bar[XB_XGEN(b.x)], 1u);
            asm volatile("s_waitcnt vmcnt(0)" ::: "memory");
        } else {
            XB_SPIN(xb_ld(&bar[XB_XGEN(b.x)]) == gen, bar);
            __builtin_amdgcn_fence(__ATOMIC_ACQUIRE, "agent");
            asm volatile("s_waitcnt vmcnt(0)" ::: "memory");
        }
    }
    __syncthreads();
}

__global__ void __launch_bounds__(512, 2) mega(Params p) {
    extern __shared__ __attribute__((aligned(16))) unsigned char lds_raw[];
    const int half = __builtin_amdgcn_readfirstlane(threadIdx.x >> 8);
    const int tid = threadIdx.x & 255, lane = tid & 63, wid = tid >> 6;
    const int nblk = gridDim.x * 2, bid = blockIdx.x * 2 + half;
    auto lwid = [&]() { int w_ = (int)((threadIdx.x & 255) >> 6); asm volatile("" : "+v"(w_)); return w_; };
    unsigned char* const lds_base = lds_raw; unsigned char* const lds = lds_raw + half * 73728;
    unsigned char* ws = p.ws;
    const int lo = p.ph_lo, hi = p.ph_hi;
#ifndef PH_MASK
#define PH_MASK 0x3ff
#endif
#define IN_PH(k) ((((PH_MASK) >> (k)) & 1) && lo <= (k) && (k) <= hi)
#define SEAM(k) do { if ((k) < hi) { xcd_barrier(xb); } } while (0)
    if (threadIdx.x < 4) ((volatile LAS unsigned*)(lds_base + 147456))[threadIdx.x] = 0u;
    __syncthreads();
    XcdBarrier xb = xcd_barrier_post((unsigned*)(ws + OFF_BAR), (volatile LAS unsigned*)(lds_base + 147456));
    if (hi > 1000) cg::this_grid().sync();
    float* MOD = (float*)(ws + OFF_MODZ);
    int* CNT = (int*)(ws + OFF_MISC);

    if (IN_PH(0)) {
        constexpr int T_MOD = 96 * 4;
        for (int t = bid; t < T_MOD + 2; t += nblk) {
            if (t < T_MOD) {
                const int j = t >> 2, kq = t & 3; float* sv = (float*)lds; float* red = sv + 768;
                __syncthreads();
                for (int i = tid; i < 768; i += 256) { const int which = i >> 8, k = kq * 256 + (i & 255); const float cv = which < 2 ? p.c[which * 1024 + k] : p.c_ctx[k]; sv[i] = silu_f(cv); }
                __syncthreads();
                const int col = j * 64 + lane; float a0 = 0.f, a1 = 0.f, a2 = 0.f;
#pragma unroll 8
                for (int k = 64 * wid; k < 64 * wid + 64; ++k) { const float wv = p.w_mod[(size_t)(kq * 256 + k) * 6144 + col]; a0 += sv[k] * wv; a1 += sv[256 + k] * wv; a2 += sv[512 + k] * wv; }
                red[(wid * 3 + 0) * 64 + lane] = a0; red[(wid * 3 + 1) * 64 + lane] = a1; red[(wid * 3 + 2) * 64 + lane] = a2;
                __syncthreads();
                if (tid < 192) { const int which = tid >> 6, cl = tid & 63; float sacc = kq == 0 ? p.b_mod[j * 64 + cl] : 0.f; for (int w = 0; w < 4; ++w) sacc += red[(w * 3 + which) * 64 + cl]; atomicAdd(&MOD[which * 6144 + j * 64 + cl], sacc); }
            } else if (t == T_MOD) {
                f2_t* RT = (f2_t*)(ws + OFF_ROPE);
                for (int i = tid; i < 2048; i += 256) {
                    const int pos = i >> 4, j = i & 15;
                    const float inv = exp2f(-(float)j * 0.8304820237218406f);
                    const float ang = (float)pos * inv;
                    const float n = rintf(ang * 0.15915494309189535f);
                    float r = fmaf(-n, 6.28125f, ang); r = fmaf(-n, 1.9353071795864769e-3f, r);
                    RT[i] = (f2_t){cosf(r), sinf(r)};
                }
            } else { if (tid == 0) CNT[0] = 0; }
        }
        for (int t = bid; t < 16 * (INP / 64); t += nblk) wconv_tile(p.w_in, DM, INC, INP, (u16*)(ws + OFF_WIN), t, (float*)lds);
        SEAM(0);
    }
    if (IN_PH(1)) {
        u16* H = (u16*)(ws + OFF_H);
        norm_rows([&](int r) { return r < NLAT ? p.x + (size_t)r * DM : p.ctx + (size_t)(r - NLAT) * DM; }, NROW, bid * 4 + lwid(), nblk * 4, p.norm1_w, MOD, 0, 1, H, lane);
        SEAM(1);
    }
    if (IN_PH(2)) {
        pg8::Gemm g{(const u16*)(ws + OFF_H), (const u16*)(ws + OFF_WIN), NROW, 2816, DM}; pg8::StaticOrder S; S.init(NROW, 2816, (int)gridDim.x, (int)blockIdx.x);
        pg8::EpiInProj E{(u16*)(ws + OFF_MIX), (u16*)(ws + OFF_K), (u16*)(ws + OFF_VT), (u16*)(ws + OFF_DQKV), (float*)(ws + OFF_GATE), p.a_log, p.dt_bias};
        pg8::gemm_phase<pg8::EpiInProj, pg8::StaticOrder, true, true>((PG8_LAS unsigned char*)lds_base, g, S, E);
        {
            const u16* H = (const u16*)(ws + OFF_H); const u16* Wg = (const u16*)(ws + OFF_WIN) + (size_t)2816 * DM; float* GT = (float*)(ws + OFF_GATE);
            const int l15 = lane & 15, quad = lane >> 4;
            for (int rb = (int)blockIdx.x * 8 + (int)(threadIdx.x >> 6); rb < NROW / 16; rb += (int)gridDim.x * 8) {
                f32x4 acc = {0.f, 0.f, 0.f, 0.f};
                const u16* ap = H + (size_t)(rb * 16 + l15) * DM + 8 * quad; const u16* bp = Wg + (size_t)l15 * DM + 8 * quad;
#pragma unroll 8
                for (int ks = 0; ks < 32; ++ks) acc = MFMA16(*(const bf16x8*)(ap + 32 * ks), *(const bf16x8*)(bp + 32 * ks), acc);
                const int ci = l15;
#pragma unroll
                for (int r = 0; r < 4; ++r) {
                    const float x = acc[r]; float o;
                    if (ci < 8) o = 1.f / (1.f + __expf(-x));
                    else { const float xx = x + p.dt_bias[ci - 8]; const float sp = xx > 20.f ? xx : log1pf(__expf(xx)); o = -__expf(p.a_log[ci - 8]) * sp; }
                    GT[(size_t)(rb * 16 + 4 * quad + r) * 16 + ci] = o;
                }
            }
        }
        SEAM(2);
    }
    if (IN_PH(3)) {
        if (bid < 32) { gdn_prep_unit(p, ((bid >> 4) * NCK + ((bid >> 2) & 3)) * 4 + (bid & 3), lds); } else {
        {
            u16* MIX = (u16*)(ws + OFF_MIX); u16* Kb = (u16*)(ws + OFF_K); const f2_t* RT = (const f2_t*)(ws + OFF_ROPE);
            const int l8 = lane & 7, sub = lane >> 3;
            for (int it = (bid - 32) * 4 + wid; it < NLAT + (NB * 2 * SKV) / 8; it += (nblk - 32) * 4) {
                u16* ptr; int t; bool rope; const float* nw; float scale;
                if (it < NLAT) { ptr = MIX + (size_t)it * DM + sub * 64 + l8 * 8; t = it & (SEQ - 1); rope = true; nw = p.q_norm_w; scale = QSCALE; }
                else { const int j = (it - NLAT) * 8 + sub, bk = j / SKV, pos = j - bk * SKV; ptr = Kb + ((size_t)bk * SKV + pos) * 64 + l8 * 8; rope = pos >= CTXL; t = pos >= CTXL ? pos - CTXL : 0; nw = p.k_norm_w; scale = 1.f; }
                const u32x4 raw = *(const u32x4*)ptr;
                float y[8];
#pragma unroll
                for (int e = 0; e < 4; ++e) { y[2 * e] = bflo(raw[e]); y[2 * e + 1] = bfhi(raw[e]); }
                float ss = 0.f;
#pragma unroll
                for (int e = 0; e < 8; ++e) ss += y[e] * y[e];
                ss += __shfl_xor(ss, 1); ss += __shfl_xor(ss, 2); ss += __shfl_xor(ss, 4);
                const float rinv = rsqrtf(ss * (1.f / 64.f) + EPS);
                const f32x4 wa = *(const f32x4*)(nw + 8 * l8), wb = *(const f32x4*)(nw + 8 * l8 + 4);
                const int ppos = (l8 & 4) ? (t & 63) : (t >> 6); const float sgn = (l8 & 2) ? 1.f : -1.f;
#pragma unroll
                for (int e = 0; e < 8; ++e) {
                    const float v = y[e] * rinv * (e < 4 ? wa[e] : wb[e - 4]);
                    const float pv = __shfl_xor(v, 2);
                    const f2_t cs = RT[ppos * 16 + 8 * (l8 & 1) + e];
                    const float vr = v * cs.x + sgn * pv * cs.y;
                    y[e] = (rope ? vr : v) * scale;
                }
                const u32x4 w = {pk2(y[0], y[1]), pk2(y[2], y[3]), pk2(y[4], y[5]), pk2(y[6], y[7])};
                *(u32x4*)ptr = w;
            }
        }
        constexpr int T_WO = 16 * 16, T_W1 = 16 * 64, T_W2 = 64 * 16;
        for (int t = bid - 32; t < T_WO + T_W1 + T_W2; t += nblk - 32) {
            if (t < T_WO) wconv_tile(p.w_out, DM, DM, DM, (u16*)(ws + OFF_WOUT), t, (float*)lds);
            else if (t < T_WO + T_W1) wconv_tile(p.w_mlp1, DM, DFF, DFF, (u16*)(ws + OFF_WM1), t - T_WO, (float*)lds);
            else wconv_tile(p.w_mlp2, DFF, DM, DM, (u16*)(ws + OFF_WM2), t - T_WO - T_W1, (float*)lds);
        }
        }
        for (int j = bid; j < 1024; j += nblk) gdn_prep_unit(p, ((j >> 9) * NCK + 4 + ((j & 511) >> 2)) * 4 + (j & 3), lds);
        SEAM(3);
    }
    if (IN_PH(4)) {
        if (blockIdx.x < 32) {
            gdn_scan_block(p, (int)blockIdx.x, lds_base, lds_base + 73728, half);
        }
        float Mb;
        { const float a = wave_max(fabsf(p.q_norm_w[lane])), bq = wave_max(fabsf(p.k_norm_w[lane])); Mb = 8.f * a * bq * 1.4426950408889634f; }
        int* su = (int*)(lds_base + 147456 + 8);
        __syncthreads();
        if (threadIdx.x == 0) *su = atomicAdd(CNT, 2);
        __syncthreads();
        int u0 = *su;
        while (u0 < 2048) {
            int nxt = 0;
            if (threadIdx.x == 0) nxt = atomicAdd(CNT, 2);
            if (Mb > 64.f) attn_unit<true>(p, u0 >> 1, half, lds_base, Mb); else attn_unit<false>(p, u0 >> 1, half, lds_base, Mb);
            if (threadIdx.x == 0) *su = nxt;
            __syncthreads();
            u0 = *su;
        }
        SEAM(4);
    }
    if (IN_PH(5)) {
        const u16* O0 = (const u16*)(ws + OFF_O01); const u16* O1 = O0 + (size_t)NLAT * 512; u16* MIX = (u16*)(ws + OFF_MIX);
        const int e0 = (8 * lane) & 127;
        const f32x4 nwa = *(const f32x4*)(p.dn_norm_w + e0), nwb = *(const f32x4*)(p.dn_norm_w + e0 + 4);
        {
            const u16* PP = (const u16*)p.out; const float* LL = (const float*)(ws + OFF_LP);
            for (int r = bid * 4 + lwid(); r < NLAT; r += nblk * 4) {
                const size_t off = (size_t)r * 512 + 8 * lane;
                float acc[8] = {0.f, 0.f, 0.f, 0.f, 0.f, 0.f, 0.f, 0.f}; float lsum = 0.f;
#pragma unroll
                for (int q = 0; q < 4; ++q) {
                    const u32x4 a = *(const u32x4*)(PP + (size_t)q * NLAT * 512 + off);
                    lsum += LL[(size_t)q * NLAT * 8 + (size_t)r * 8 + (lane >> 3)];
#pragma unroll
                    for (int i = 0; i < 4; ++i) { acc[2 * i] += bflo(a[i]); acc[2 * i + 1] += bfhi(a[i]); }
                }
                const float inv = 1.f / lsum;
                u32x4 w = {pk2(acc[0] * inv, acc[1] * inv), pk2(acc[2] * inv, acc[3] * inv), pk2(acc[4] * inv, acc[5] * inv), pk2(acc[6] * inv, acc[7] * inv)};
                *(u32x4*)(MIX + (size_t)r * DM + 8 * lane) = w;
            }
        }
        int r = bid * 4 + lwid(); const int rs = nblk * 4;
        u32x4 na = {0u, 0u, 0u, 0u}, nc = na, nz = na;
        if (r < NLAT) { na = *(const u32x4*)(O0 + (size_t)r * 512 + 8 * lane); nc = *(const u32x4*)(O1 + (size_t)r * 512 + 8 * lane); nz = *(const u32x4*)(MIX + (size_t)r * DM + 512 + 8 * lane); }
        for (; r < NLAT; r += rs) {
            const u32x4 a = na, c = nc, z = nz;
            if (r + rs < NLAT) { const int r2 = r + rs; na = *(const u32x4*)(O0 + (size_t)r2 * 512 + 8 * lane); nc = *(const u32x4*)(O1 + (size_t)r2 * 512 + 8 * lane); nz = *(const u32x4*)(MIX + (size_t)r2 * DM + 512 + 8 * lane); }
            float o[8], zz[8];
#pragma unroll
            for (int i = 0; i < 4; ++i) { o[2 * i] = bflo(a[i]) + bflo(c[i]); o[2 * i + 1] = bfhi(a[i]) + bfhi(c[i]); zz[2 * i] = bflo(z[i]); zz[2 * i + 1] = bfhi(z[i]); }
            float ss = 0.f;
#pragma unroll
            for (int i = 0; i < 8; ++i) ss += o[i] * o[i];
            ss += __shfl_xor(ss, 1); ss += __shfl_xor(ss, 2); ss += __shfl_xor(ss, 4); ss += __shfl_xor(ss, 8);
            const float rinv = rsqrtf(ss * (1.f / 128.f) + EPS);
            float y[8];
#pragma unroll
            for (int i = 0; i < 8; ++i) y[i] = o[i] * rinv * (i < 4 ? nwa[i] : nwb[i - 4]) * silu_f(zz[i]);
            u32x4 w = {pk2(y[0], y[1]), pk2(y[2], y[3]), pk2(y[4], y[5]), pk2(y[6], y[7])};
            *(u32x4*)(MIX + (size_t)r * DM + 512 + 8 * lane) = w;
        }
        SEAM(5);
    }
    if (IN_PH(6)) {
        pg8::Gemm g{(const u16*)(ws + OFF_MIX), (const u16*)(ws + OFF_WOUT), NLAT, DM, DM}; pg8::StaticOrder S; S.init(NLAT, DM, (int)gridDim.x, (int)blockIdx.x);
        pg8::EpiGatedRes E{p.x, p.out, MOD + 2 * 1024, 6144, DM};
        pg8::gemm_phase<pg8::EpiGatedRes, pg8::StaticOrder, true, true>((PG8_LAS unsigned char*)lds_base, g, S, E);
        SEAM(6);
    }
    if (IN_PH(7)) {
        u16* H2 = (u16*)(ws + OFF_H2);
        norm_rows([&](int r) { return (const float*)p.out + (size_t)r * DM; }, NLAT, bid * 4 + lwid(), nblk * 4, p.norm2_w, MOD, 3, 4, H2, lane);
        SEAM(7);
    }
    if (IN_PH(8)) {
        pg8::Gemm g{(const u16*)(ws + OFF_H2), (const u16*)(ws + OFF_WM1), NLAT, DFF, DM}; pg8::StaticOrder S; S.init(NLAT, DFF, (int)gridDim.x, (int)blockIdx.x);
        pg8::EpiRelu2 E{(u16*)(ws + OFF_HID), DFF};
        pg8::gemm_phase<pg8::EpiRelu2, pg8::StaticOrder, true, true>((PG8_LAS unsigned char*)lds_base, g, S, E);
        SEAM(8);
    }
    if (IN_PH(9)) {
        pg8::Gemm g{(const u16*)(ws + OFF_HID), (const u16*)(ws + OFF_WM2), NLAT, DM, DFF}; pg8::StaticOrder S; S.init(NLAT, DM, (int)gridDim.x, (int)blockIdx.x);
        pg8::EpiGatedRes E{p.out, p.out, MOD + 5 * 1024, 6144, DM};
        pg8::gemm_phase<pg8::EpiGatedRes, pg8::StaticOrder, true, true>((PG8_LAS unsigned char*)lds_base, g, S, E);
    }
}

extern "C" void kernel_launch(void* const* d_in, const int* in_sizes, int n_in, void* d_out, int out_size, void* d_ws, size_t ws_size, hipStream_t stream) {
    static int grid = 0;
    if (grid == 0) {
        if (ws_size < WS_NEED) { fprintf(stderr, "kernel_launch: workspace too small (%zu < %zu)\n", ws_size, (size_t)WS_END); grid = -1; return; }
        int dev = 0, cus = 0, per_cu = 0;
        hipGetDevice(&dev);
        hipDeviceGetAttribute(&cus, hipDeviceAttributeMultiprocessorCount, dev);
        hipFuncSetAttribute((const void*)mega, hipFuncAttributeMaxDynamicSharedMemorySize, LDS_BYTES);
        hipOccupancyMaxActiveBlocksPerMultiprocessor(&per_cu, (const void*)mega, 512, LDS_BYTES);
        if (per_cu < 1) per_cu = 1;
        if (per_cu > 1) per_cu = 1;
        grid = cus * per_cu;
        fprintf(stderr, "kernel_launch: cus %d per_cu %d grid %d ws %zu need %zu\n", cus, per_cu, grid, ws_size, (size_t)WS_END);
    }
    if (grid < 0) return;
    if (hipMemsetAsync((unsigned char*)d_ws + OFF_BAR, 0, ZERO_BYTES, stream) != hipSuccess) { fprintf(stderr, "kernel_launch: memset of barrier words failed\n"); return; }
    Params p{};
    const float** pp = (const float**)&p;
    for (int i = 0; i < 18; ++i) pp[i] = (const float*)d_in[i];
    p.out = (float*)d_out; p.ws = (unsigned char*)d_ws;
#if ONE_LAUNCH
    p.ph_lo = 0; p.ph_hi = 9;
    void* args[] = {&p};
    hipError_t e = hipLaunchCooperativeKernel((const void*)mega, dim3(grid), dim3(512), args, LDS_BYTES, stream);
    if (e != hipSuccess) fprintf(stderr, "cooperative launch failed: %s (grid %d)\n", hipGetErrorString(e), grid);
#else
#ifndef DUP_PH
#define DUP_PH -1
#endif
    for (int ph = 0; ph <= 9; ++ph) {
        p.ph_lo = ph; p.ph_hi = ph;
        hipLaunchKernelGGL(mega, dim3(grid), dim3(512), LDS_BYTES, stream, p);
        if (ph == DUP_PH) hipLaunchKernelGGL(mega, dim3(grid), dim3(512), LDS_BYTES, stream, p);
    }
#endif
}
```

```cpp
#include <hip/hip_runtime.h>
#include <hip/hip_cooperative_groups.h>
#include <stdint.h>
#include <cstdio>
namespace cg = cooperative_groups;

#ifndef ONE_LAUNCH
#define ONE_LAUNCH 1
#endif

typedef unsigned short u16;
typedef __bf16 bf2_t __attribute__((ext_vector_type(2)));
typedef float f2_t __attribute__((ext_vector_type(2)));
typedef short bf16x8 __attribute__((ext_vector_type(8)));
typedef float f32x4 __attribute__((ext_vector_type(4)));
typedef float f32x16 __attribute__((ext_vector_type(16)));
typedef unsigned u32x2 __attribute__((ext_vector_type(2)));
typedef unsigned u32x4 __attribute__((ext_vector_type(4)));

#define DI __device__ __forceinline__
DI unsigned pk2(float lo, float hi) { f2_t v = {lo, hi}; return __builtin_bit_cast(unsigned, __builtin_convertvector(v, bf2_t)); }
DI u16 f2bf(float x) { return (u16)(pk2(x, 0.f) & 0xffffu); }
DI float bf2f(u16 v) { return __uint_as_float(((unsigned)v) << 16); }
DI float bflo(unsigned v) { return __uint_as_float(v << 16); }
DI float bfhi(unsigned v) { return __uint_as_float(v & 0xffff0000u); }
DI bf16x8 mk8(unsigned a, unsigned b, unsigned c, unsigned d) { u32x4 v = {a, b, c, d}; return __builtin_bit_cast(bf16x8, v); }
DI bf16x8 mk8(u32x2 lo, u32x2 hi) { u32x4 v = {lo.x, lo.y, hi.x, hi.y}; return __builtin_bit_cast(bf16x8, v); }
#define MFMA16(a, b, c) __builtin_amdgcn_mfma_f32_16x16x32_bf16((a), (b), (c), 0, 0, 0)
#define MFMA32(a, b, c) __builtin_amdgcn_mfma_f32_32x32x16_bf16((a), (b), (c), 0, 0, 0)

constexpr int DM = 1024, NB = 2, SEQ = 8192, NLAT = NB * SEQ, CTXL = 256, NCTX = NB * CTXL, NROW = NLAT + NCTX;
constexpr int INC = 2832, INP = 3072, DFF = 4096, SKV = CTXL + SEQ;
constexpr int NCK = 132;
constexpr int NCU = NB * NCK * 4;
constexpr float EPS = 1e-6f;
constexpr float QSCALE = 0.125f * 1.4426950408889634f;

constexpr size_t OFF_WIN = 0;
constexpr size_t OFF_MOD = OFF_WIN + (size_t)INP * DM * 2;
constexpr size_t OFF_ROPE = OFF_MOD + 3 * 6144 * 4;
constexpr size_t OFF_MISC = OFF_ROPE + 128 * 16 * 8;
constexpr size_t OFF_H = OFF_MISC + 256;
constexpr size_t OFF_WOUT = OFF_H;
constexpr size_t OFF_WM1 = OFF_WOUT + (size_t)DM * DM * 2;
constexpr size_t OFF_WM2 = OFF_WM1 + (size_t)DFF * DM * 2;
constexpr size_t OFF_DQKV = OFF_H + (size_t)NROW * DM * 2;
constexpr size_t OFF_O01 = OFF_DQKV;
constexpr size_t OFF_H2 = OFF_DQKV;
constexpr size_t OFF_MIX = OFF_DQKV + (size_t)NROW * 1536 * 2;
constexpr size_t OFF_HID = OFF_MIX;
constexpr size_t OFF_K = OFF_MIX + (size_t)NLAT * DM * 2;
constexpr size_t OFF_VT = OFF_K + (size_t)NB * 2 * SKV * 64 * 2;
constexpr size_t OFF_GATE = OFF_VT + (size_t)NB * 2 * SKV * 64 * 2;
constexpr size_t OFF_QN = OFF_GATE + (size_t)NROW * 16 * 4;
constexpr size_t OFF_KNT = OFF_QN + (size_t)NCU * 8192 * 2;
constexpr size_t OFF_WNEG = OFF_KNT + (size_t)NCU * 8192 * 2;
constexpr size_t OFF_UT = OFF_WNEG + (size_t)2 * NCU * 8192 * 2;
constexpr size_t OFF_INTRA = OFF_UT + (size_t)2 * NCU * 8192 * 2;
constexpr size_t OFF_SCAL = OFF_INTRA + (size_t)2 * NCU * 4096 * 2;
constexpr size_t WS_END = OFF_SCAL + (size_t)2 * NCU * 192 * 4;
static_assert(OFF_HID + (size_t)NLAT * DFF * 2 <= WS_END, "hid overlay");
static_assert(WS_END + 16384 + 3 * 6144 * 4 + 4 * 16384 * 8 * 4 <= (size_t)256 * 1024 * 1024, "ws budget");

constexpr int LDS_BYTES = 2 * 73728 + 16;
constexpr size_t OFF_BAR = WS_END;
constexpr size_t OFF_MODZ = OFF_BAR + 16384;
constexpr size_t ZERO_BYTES = 16384 + 3 * 6144 * 4;
constexpr size_t OFF_LP = OFF_MODZ + 3 * 6144 * 4;
constexpr size_t WS_NEED = OFF_LP + (size_t)4 * NLAT * 8 * 4;


struct Params {
    const float *x, *c, *ctx, *c_ctx, *w_mod, *b_mod, *norm1_w, *w_in, *q_norm_w, *k_norm_w, *conv_w, *a_log, *dt_bias, *dn_norm_w, *w_out, *norm2_w, *w_mlp1, *w_mlp2;
    float* out; unsigned char* ws; int ph_lo, ph_hi;
};

DI void wconv_tile(const float* __restrict__ W, int K, int N, int Npad, u16* __restrict__ Wt, int tile, float* st) {
    const int ntn = Npad / 64, kt = tile / ntn, nt = tile % ntn, k0 = kt * 64, n0 = nt * 64;
    const int tid = (threadIdx.x & 255), c = tid & 63, r4 = tid >> 6;
    __syncthreads();
#pragma unroll 4
    for (int i = 0; i < 16; ++i) { const int k = i * 4 + r4, n = n0 + c; st[k * 65 + c] = (n < N) ? W[(size_t)(k0 + k) * N + n] : 0.f; }
    __syncthreads();
#pragma unroll 4
    for (int i = 0; i < 16; ++i) { const int n = i * 4 + r4; Wt[(size_t)(n0 + n) * K + k0 + c] = f2bf(st[c * 65 + n]); }
}

template <class Epi>
DI void gemm_tile(const u16* __restrict__ A, int lda, const u16* __restrict__ Bt, int ldb, int K, int m0, int n0, unsigned char* lds, Epi&& epi) {
    const int tid = (threadIdx.x & 255), lane = tid & 63, wid = tid >> 6, wr = wid >> 1, wc = wid & 1, l15 = lane & 15, quad = lane >> 4;
    u16* As = (u16*)lds; u16* Bs = (u16*)(lds + 18432);
    f32x4 acc[4][4];
#pragma unroll
    for (int m = 0; m < 4; ++m)
#pragma unroll
        for (int n = 0; n < 4; ++n) acc[m][n] = (f32x4){0.f, 0.f, 0.f, 0.f};
    u32x4 ra[4], rb[4];
    const int lrow = tid >> 3, lcc = tid & 7;
    const u16* Ap = A + (size_t)(m0 + lrow) * lda + lcc * 8;
    const u16* Bp = Bt + (size_t)(n0 + lrow) * ldb + lcc * 8;
    const int nk = K / 64;
#pragma unroll
    for (int i = 0; i < 4; ++i) { ra[i] = *(const u32x4*)(Ap + (size_t)(32 * i) * lda); rb[i] = *(const u32x4*)(Bp + (size_t)(32 * i) * ldb); }
    __syncthreads();
#pragma unroll
    for (int i = 0; i < 4; ++i) { *(u32x4*)(As + (lrow + 32 * i) * 72 + lcc * 8) = ra[i]; *(u32x4*)(Bs + (lrow + 32 * i) * 72 + lcc * 8) = rb[i]; }
#pragma unroll
    for (int i = 0; i < 4; ++i) { ra[i] = *(const u32x4*)(Ap + (size_t)(32 * i) * lda + 64); rb[i] = *(const u32x4*)(Bp + (size_t)(32 * i) * ldb + 64); }
    __syncthreads();
    for (int kt = 0; kt < nk; ++kt) {
        const u16* Ac = As + (kt & 1) * 18432; const u16* Bc = Bs + (kt & 1) * 18432;
        if (kt + 1 < nk) {
            u16* An = As + ((kt + 1) & 1) * 18432; u16* Bn = Bs + ((kt + 1) & 1) * 18432;
#pragma unroll
            for (int i = 0; i < 4; ++i) { *(u32x4*)(An + (lrow + 32 * i) * 72 + lcc * 8) = ra[i]; *(u32x4*)(Bn + (lrow + 32 * i) * 72 + lcc * 8) = rb[i]; }
        }
        if (kt + 2 < nk) {
#pragma unroll
            for (int i = 0; i < 4; ++i) { ra[i] = *(const u32x4*)(Ap + (size_t)(32 * i) * lda + (kt + 2) * 64); rb[i] = *(const u32x4*)(Bp + (size_t)(32 * i) * ldb + (kt + 2) * 64); }
        }
#pragma unroll
        for (int ks = 0; ks < 2; ++ks) {
            bf16x8 af[4], bfr[4];
#pragma unroll
            for (int m = 0; m < 4; ++m) af[m] = *(const bf16x8*)(Ac + (64 * wr + 16 * m + l15) * 72 + 32 * ks + 8 * quad);
#pragma unroll
            for (int n = 0; n < 4; ++n) bfr[n] = *(const bf16x8*)(Bc + (64 * wc + 16 * n + l15) * 72 + 32 * ks + 8 * quad);
#pragma unroll
            for (int m = 0; m < 4; ++m)
#pragma unroll
                for (int n = 0; n < 4; ++n) acc[m][n] = MFMA16(bfr[n], af[m], acc[m][n]);
        }
        __syncthreads();
    }
    epi(acc, m0 + 64 * wr, n0 + 64 * wc, l15, quad);
}

DI float silu_f(float v) { return v / (1.f + __expf(-v)); }
DI int permpos(int c) { const int k = c & 31; return (c & ~31) | (8 * ((k & 15) >> 2) + 4 * (k >> 4) + (k & 3)); }
DI float wave_max(float v) {
#pragma unroll
    for (int o = 32; o > 0; o >>= 1) v = fmaxf(v, __shfl_xor(v, o));
    return v;
}
DI float wave_sum(float v) {
#pragma unroll
    for (int o = 32; o > 0; o >>= 1) v += __shfl_xor(v, o);
    return v;
}

template <class SrcF>
DI void norm_rows(SrcF srcf, int nrows, int row0, int rstride, const float* __restrict__ nw, const float* __restrict__ MOD, int shift_idx, int scale_idx, u16* __restrict__ dst, int lane) {
    f32x4 w[4], sh[4], sc[4]; int cur = -1;
    f32x4 v[4], nx[4];
    int r = row0;
    if (r < nrows) {
        const float* src = srcf(r);
#pragma unroll
        for (int i = 0; i < 4; ++i) nx[i] = *(const f32x4*)(src + 4 * lane + 256 * i);
    }
    for (; r < nrows; r += rstride) {
#pragma unroll
        for (int i = 0; i < 4; ++i) v[i] = nx[i];
        if (r + rstride < nrows) {
            const float* src = srcf(r + rstride);
#pragma unroll
            for (int i = 0; i < 4; ++i) nx[i] = *(const f32x4*)(src + 4 * lane + 256 * i);
        }
        const int which = r < NLAT ? (r >> 13) : 2;
        if (which != cur) {
            cur = which;
#pragma unroll
            for (int i = 0; i < 4; ++i) {
                const int c = 4 * lane + 256 * i;
                w[i] = *(const f32x4*)(nw + c); sh[i] = *(const f32x4*)(MOD + which * 6144 + shift_idx * 1024 + c); sc[i] = *(const f32x4*)(MOD + which * 6144 + scale_idx * 1024 + c);
                w[i] = w[i] * (sc[i] + 1.f);
            }
        }
        float ss = 0.f;
#pragma unroll
        for (int i = 0; i < 4; ++i) ss += v[i][0] * v[i][0] + v[i][1] * v[i][1] + v[i][2] * v[i][2] + v[i][3] * v[i][3];
        ss = wave_sum(ss);
        const float rinv = rsqrtf(ss * (1.f / 1024.f) + EPS);
#pragma unroll
        for (int i = 0; i < 4; ++i) {
            const f32x4 yv = v[i] * rinv * w[i] + sh[i];
            u32x2 o = {pk2(yv[0], yv[1]), pk2(yv[2], yv[3])};
            *(u32x2*)(dst + (size_t)r * DM + 4 * lane + 256 * i) = o;
        }
    }
}

DI void gdn_prep_unit(const Params& p, int unit, unsigned char* lds) {
    int tid_in = (threadIdx.x & 255); asm volatile("" : "+v"(tid_in));
    const int tid = tid_in, lane = tid & 63, wid = tid >> 6, l15 = lane & 15, quad = lane >> 4;
    const int h = unit & 3, bc = unit >> 2, b = bc / NCK, ck = bc % NCK;
    const bool isctx = ck < 4;
    const int seqlen = isctx ? CTXL : SEQ;
    const int c0 = isctx ? ck * 64 : (ck - 4) * 64;
    const int rowbase = isctx ? (NLAT + b * CTXL) : b * SEQ;
    unsigned char* ws = p.ws;
    const u16* DQ = (const u16*)(ws + OFF_DQKV);
    const float* GT = (const float*)(ws + OFF_GATE);
    u16* Qs = (u16*)lds; u16* Ks = (u16*)(lds + 17408); float* stage = (float*)(lds + 34816);
    float* gs = (float*)(lds + 67840); float* gcs = (float*)(lds + 71936); float* rbs = (float*)(lds + 72448); float* rbe = (float*)(lds + 72960); float* rn = (float*)(lds + 73472);
    u16* QNg = (u16*)(ws + OFF_QN) + (size_t)unit * 8192;
    u16* KNTg = (u16*)(ws + OFF_KNT) + (size_t)unit * 8192;
    __syncthreads();
    {
        const int t = tid >> 2, q4 = tid & 3;
        *(f32x4*)(gs + t * 16 + q4 * 4) = *(const f32x4*)(GT + (size_t)(rowbase + c0 + t) * 16 + q4 * 4);
    }
    const int cch = tid & 127, th = tid >> 7;
    float* part = rbs;
    u32x4 rawreg[5];
    auto raw_fetch = [&](int wh) {
#pragma unroll
        for (int i = 0; i < 5; ++i) {
            const int idx = tid + 256 * i; const int row = idx >> 4, cc = idx & 15, s = c0 - 2 + row;
            u32x4 v = {0u, 0u, 0u, 0u};
            if (idx < 68 * 16 && s >= 0 && s < seqlen) v = *(const u32x4*)(DQ + (size_t)(rowbase + s) * 1536 + wh * 512 + h * 128 + cc * 8);
            rawreg[i] = v;
        }
    };
    raw_fetch(2);
#pragma unroll 1
    for (int wi = 0; wi < 3; ++wi) {
        const int which = wi == 0 ? 2 : wi - 1;
        if (isctx && wi == 1) continue;
        u16* raw = (wi == 0) ? Qs : Ks;
        __syncthreads();
#pragma unroll
        for (int i = 0; i < 5; ++i) {
            const int idx = tid + 256 * i;
            if (idx < 68 * 16) { const int row = idx >> 4, cc = idx & 15; *(u32x4*)(raw + row * 128 + cc * 8) = rawreg[i]; }
        }
        if (wi < 2) raw_fetch((isctx || wi == 1) ? 1 : 0);
        const int col = which * 512 + h * 128 + cch;
        const float w0 = p.conv_w[0 * 1536 + col], w1 = p.conv_w[1 * 1536 + col], w2 = p.conv_w[2 * 1536 + col], w3 = p.conv_w[3 * 1536 + col], w4 = p.conv_w[4 * 1536 + col];
        __syncthreads();
        float y[32];
        {
            const u16* rp = raw + (32 * th) * 128 + cch;
            float xa = bf2f(rp[0]), xb = bf2f(rp[128]), xc = bf2f(rp[256]), xd = bf2f(rp[384]);
#pragma unroll
            for (int i = 0; i < 32; ++i) {
                const float xe = bf2f(rp[(i + 4) * 128]);
                y[i] = silu_f(w0 * xa + w1 * xb + w2 * xc + w3 * xd + w4 * xe);
                xa = xb; xb = xc; xc = xd; xd = xe;
            }
        }
        if (which == 2) {
#pragma unroll
            for (int i = 0; i < 32; ++i) stage[(32 * th + i) * 129 + cch] = y[i];
        } else {
            float mine = 0.f;
#pragma unroll
            for (int i = 0; i < 32; ++i) { const float ssum = wave_sum(y[i] * y[i]); if (lane == i) mine = ssum; }
            if (lane < 32) part[wid * 32 + lane] = mine;
            __syncthreads();
            if (which == 0) {
#pragma unroll
                for (int i = 0; i < 32; ++i) {
                    const int t = 32 * th + i; const float rinv = rsqrtf(part[(2 * th) * 32 + i] + part[(2 * th + 1) * 32 + i] + EPS);
                    const u16 v = f2bf(y[i] * rinv); Qs[t * 136 + cch] = v; QNg[t * 128 + permpos(cch)] = v;
                }
            } else {
                unsigned pkd[16];
#pragma unroll
                for (int i = 0; i < 16; ++i) {
                    const int t = 32 * th + 2 * i;
                    const float r0 = rsqrtf(part[(2 * th) * 32 + 2 * i] + part[(2 * th + 1) * 32 + 2 * i] + EPS), r1 = rsqrtf(part[(2 * th) * 32 + 2 * i + 1] + part[(2 * th + 1) * 32 + 2 * i + 1] + EPS);
                    const unsigned v = pk2(y[2 * i] * r0, y[2 * i + 1] * r1); pkd[i] = v;
                    Ks[t * 136 + cch] = (u16)(v & 0xffffu); Ks[(t + 1) * 136 + cch] = (u16)(v >> 16);
                }
#pragma unroll
                for (int i = 0; i < 4; ++i) { u32x4 v = {pkd[2 * i], pkd[2 * i + 1], pkd[8 + 2 * i], pkd[8 + 2 * i + 1]}; *(u32x4*)(KNTg + cch * 64 + 32 * th + 8 * i) = v; }
            }
        }
    }
    __syncthreads();
    int unit_l = unit, tid_l = tid_in;
    asm volatile("" : "+s"(unit_l)); asm volatile("" : "+v"(tid_l));
    {
    const int unit = unit_l, tid = tid_l, lane = tid & 63, wid = tid >> 6, l15 = lane & 15, quad = lane >> 4;
    if (tid < 128) {
        const int d = tid >> 6, t = tid & 63; float s = 0.f;
        if (d == 0) { for (int u = 0; u <= t; ++u) s += gs[u * 16 + 8 + h]; }
        else        { for (int u = t; u < 64; ++u) s += gs[u * 16 + 12 + h]; }
        gcs[d * 64 + t] = s;
    }
    __syncthreads();
    if (tid < 128) {
        const int d = tid >> 6, t = tid & 63;
        const float gc = gcs[d * 64 + t], gl = gcs[d * 64 + (d ? 0 : 63)], be = gs[t * 16 + d * 4 + h];
        rbs[d * 64 + t] = be; rbe[d * 64 + t] = be * __expf(gc);
        float* SC = (float*)(ws + OFF_SCAL) + ((size_t)d * NCU + unit) * 192;
        SC[t] = __expf(gc) * 0.08838834764831845f; SC[64 + t] = __expf(gl - gc);
        if (t == 0) SC[128] = __expf(gl);
    }
    if (!isctx) {
        f32x4 QK[4];
#pragma unroll
        for (int n = 0; n < 4; ++n) QK[n] = (f32x4){0.f, 0.f, 0.f, 0.f};
#pragma unroll
        for (int ks = 0; ks < 4; ++ks) {
            const bf16x8 aq = *(const bf16x8*)(Qs + (16 * wid + l15) * 136 + 32 * ks + 8 * quad);
#pragma unroll
            for (int n = 0; n < 4; ++n) {
                const bf16x8 bb = *(const bf16x8*)(Ks + (16 * n + l15) * 136 + 32 * ks + 8 * quad);
                QK[n] = MFMA16(aq, bb, QK[n]);
            }
        }
#pragma unroll
        for (int d = 0; d < 2; ++d) {
            u16* INg = (u16*)(ws + OFF_INTRA) + ((size_t)d * NCU + unit) * 4096;
#pragma unroll
            for (int n = 0; n < 4; ++n)
#pragma unroll
                for (int r = 0; r < 4; ++r) {
                    const int i = 16 * wid + 4 * quad + r, j = 16 * n + l15;
                    const bool keep = d ? (j >= i) : (j <= i);
                    const float iv = keep ? QK[n][r] * 0.08838834764831845f * __expf(gcs[d * 64 + i] - gcs[d * 64 + j]) : 0.f;
                    INg[i * 64 + permpos(j)] = f2bf(iv);
                }
        }
    }
    __syncthreads();
    {
        f32x4 G[4];
#pragma unroll
        for (int n = 0; n < 4; ++n) G[n] = (f32x4){0.f, 0.f, 0.f, 0.f};
#pragma unroll
        for (int ks = 0; ks < 4; ++ks) {
            const bf16x8 ak = *(const bf16x8*)(Ks + (16 * wid + l15) * 136 + 32 * ks + 8 * quad);
#pragma unroll
            for (int n = 0; n < 4; ++n) {
                const bf16x8 bb = *(const bf16x8*)(Ks + (16 * n + l15) * 136 + 32 * ks + 8 * quad);
                G[n] = MFMA16(ak, bb, G[n]);
            }
        }
        const int dd = __builtin_amdgcn_readfirstlane(tid >> 7), cc = tid & 127;
        float xwp[64];
#pragma unroll
        for (int ip = 0; ip < 64; ++ip) xwp[ip] = 0.f;
        if (dd == 0) {
#pragma unroll
            for (int ip = 0; ip < 64; ++ip) xwp[ip] = bf2f(Ks[ip * 136 + cc]) * rbe[ip];
        } else {
#pragma unroll
            for (int ip = 0; ip < 64; ++ip) xwp[ip] = bf2f(Ks[(63 - ip) * 136 + cc]) * rbe[64 + 63 - ip];
        }
        asm volatile("" ::: "memory");
        __syncthreads();
        float* Ls0 = (float*)lds; float* Ls1 = (float*)(lds + 17408);
#pragma unroll
        for (int d = 0; d < 2; ++d)
#pragma unroll
            for (int n = 0; n < 4; ++n)
#pragma unroll
                for (int r = 0; r < 4; ++r) {
                    const int i = 16 * wid + 4 * quad + r, j = 16 * n + l15;
                    const int ip = d ? 63 - i : i, jp = d ? 63 - j : j;
                    if (jp < ip) (d ? Ls1 : Ls0)[ip * 64 + jp] = rbs[d * 64 + i] * G[n][r] * __expf(gcs[d * 64 + i] - gcs[d * 64 + j]);
                }
        __syncthreads();
        const float* Lsel = dd ? Ls1 : Ls0;
        f2_t x2[64];
#pragma unroll
        for (int ip = 0; ip < 64; ++ip) x2[ip] = (f2_t){0.f, xwp[ip]};
        if (dd == 0) {
#pragma unroll
            for (int ip = 0; ip < 64; ++ip) x2[ip].x = stage[ip * 129 + cc] * rbs[ip];
        } else {
#pragma unroll
            for (int ip = 0; ip < 64; ++ip) x2[ip].x = stage[(63 - ip) * 129 + cc] * rbs[64 + 63 - ip];
        }
        asm volatile("" ::: "memory");
#pragma unroll
        for (int ip = 0; ip < 64; ++ip) {
            f2_t a2 = x2[ip];
#pragma unroll
            for (int jp = 0; jp < ip; ++jp) { const float l = Lsel[ip * 64 + jp]; a2 -= x2[jp] * l; if ((jp & 15) == 15) asm volatile("" ::: "memory"); }
            x2[ip] = a2;
            asm volatile("" ::: "memory");
        }
        {
            int unit_o = unit, cc_o = cc; asm volatile("" : "+s"(unit_o)); asm volatile("" : "+v"(cc_o));
            u16* WNg = (u16*)(ws + OFF_WNEG) + ((size_t)dd * NCU + unit_o) * 8192 + permpos(cc_o);
#pragma unroll
            for (int ip = 0; ip < 1; ++ip) {}
            if (dd == 0) {
#pragma unroll
                for (int ip = 0; ip < 64; ++ip) { WNg[ip * 128] = f2bf(-x2[ip].y); if ((ip & 7) == 7) asm volatile("" ::: "memory"); }
            } else {
#pragma unroll
                for (int ip = 0; ip < 64; ++ip) { WNg[(63 - ip) * 128] = f2bf(-x2[ip].y); if ((ip & 7) == 7) asm volatile("" ::: "memory"); }
            }
            asm volatile("" ::: "memory");
            u16* UTg = (u16*)(ws + OFF_UT) + ((size_t)dd * NCU + unit_o) * 8192 + cc_o * 64;
            if (dd == 0) {
#pragma unroll
                for (int i = 0; i < 8; ++i) { u32x4 v = {pk2(x2[8 * i].x, x2[8 * i + 1].x), pk2(x2[8 * i + 2].x, x2[8 * i + 3].x), pk2(x2[8 * i + 4].x, x2[8 * i + 5].x), pk2(x2[8 * i + 6].x, x2[8 * i + 7].x)}; *(u32x4*)(UTg + 8 * i) = v; }
            } else {
#pragma unroll
                for (int i = 0; i < 8; ++i) { u32x4 v = {pk2(x2[63 - 8 * i].x, x2[62 - 8 * i].x), pk2(x2[61 - 8 * i].x, x2[60 - 8 * i].x), pk2(x2[59 - 8 * i].x, x2[58 - 8 * i].x), pk2(x2[57 - 8 * i].x, x2[56 - 8 * i].x)}; *(u32x4*)(UTg + 8 * i) = v; }
            }
        }
        __syncthreads();
    }
    }
}

DI void gdn_scan_block(const Params& p, int sb, unsigned char* lds0, unsigned char* lds1, int role) {
    const int tid = (threadIdx.x & 255), lane = tid & 63, wid = tid >> 6, l15 = lane & 15, quad = lane >> 4;
    const int chain = sb >> 1, half = sb & 1, b = chain >> 3, h = (chain >> 1) & 3, d = chain & 1, slice = half * 4 + wid;
    unsigned char* ws = p.ws;
    if (role == 1) {
        u32x4 pre[16]; float presc = 0.f;
        auto issue = [&](int step) {
            const int ck = d ? (step < 4 ? 3 - step : 135 - step) : step;
            const size_t cu = (size_t)(b * NCK + ck) * 4 + h, dcu = (size_t)d * NCU + cu;
            const u32x4* WN = (const u32x4*)(ws + OFF_WNEG + dcu * 16384);
            const u32x4* QN = (const u32x4*)(ws + OFF_QN + cu * 16384);
            const u32x4* KT = (const u32x4*)(ws + OFF_KNT + cu * 16384);
            const u32x4* IN = (const u32x4*)(ws + OFF_INTRA + dcu * 8192);
            const u32x4* UT = (const u32x4*)(ws + OFF_UT + dcu * 16384 + (size_t)half * 8192);
            const float* SC = (const float*)(ws + OFF_SCAL) + dcu * 192;
#pragma unroll
            for (int i = 0; i < 4; ++i) { pre[i] = WN[tid + 256 * i]; pre[4 + i] = QN[tid + 256 * i]; pre[8 + i] = KT[tid + 256 * i]; }
#pragma unroll
            for (int i = 0; i < 2; ++i) { pre[12 + i] = IN[tid + 256 * i]; pre[14 + i] = UT[tid + 256 * i]; }
            if (tid < 192) presc = SC[tid];
        };
        auto commit = [&](unsigned char* L) {
#pragma unroll
            for (int i = 0; i < 4; ++i) {
                const int r16 = (tid >> 4) + 16 * i, c16 = tid & 15;
                *(u32x4*)(L + r16 * 272 + c16 * 16) = pre[i];
                *(u32x4*)(L + 17408 + r16 * 272 + c16 * 16) = pre[4 + i];
                const int r8 = (tid >> 3) + 32 * i, c8 = tid & 7;
                *(u32x4*)(L + 34816 + r8 * 144 + c8 * 16) = pre[8 + i];
            }
#pragma unroll
            for (int i = 0; i < 2; ++i) {
                const int r8 = (tid >> 3) + 32 * i, c8 = tid & 7;
                *(u32x4*)(L + 53248 + r8 * 144 + c8 * 16) = pre[12 + i];
                *(u32x4*)(L + 62464 + r8 * 144 + c8 * 16) = pre[14 + i];
            }
            if (tid < 192) ((float*)(L + 71680))[tid] = presc;
        };
        issue(0); commit(lds0); issue(1);
        __syncthreads();
        for (int step = 0; step < NCK; ++step) {
            if (step + 1 < NCK) { commit(((step + 1) & 1) ? lds1 : lds0); if (step + 2 < NCK) issue(step + 2); }
            __syncthreads();
        }
        return;
    }
    f32x4 S[8];
#pragma unroll
    for (int i = 0; i < 8; ++i) S[i] = (f32x4){0.f, 0.f, 0.f, 0.f};
    u16* Og = (u16*)(ws + OFF_O01) + (size_t)d * NLAT * 512;
    __syncthreads();
    for (int step = 0; step < NCK; ++step) {
        const int ck = d ? (step < 4 ? 3 - step : 135 - step) : step;
        const bool isctx = ck < 4;
        const unsigned char* L = (step & 1) ? lds1 : lds0;
        const u16* WNl = (const u16*)L; const u16* QNl = (const u16*)(L + 17408); const u16* KTl = (const u16*)(L + 34816); const u16* INl = (const u16*)(L + 53248); const u16* UTl = (const u16*)(L + 62464); const float* SCl = (const float*)(L + 71680);
        bf16x8 Sb[4];
#pragma unroll
        for (int ks = 0; ks < 4; ++ks) Sb[ks] = mk8(pk2(S[2 * ks][0], S[2 * ks][1]), pk2(S[2 * ks][2], S[2 * ks][3]), pk2(S[2 * ks + 1][0], S[2 * ks + 1][1]), pk2(S[2 * ks + 1][2], S[2 * ks + 1][3]));
        f32x4 vn[4], o[4];
#pragma unroll
        for (int mt = 0; mt < 4; ++mt) {
            const u32x2 raw = *(const u32x2*)(UTl + (16 * wid + l15) * 72 + 16 * mt + 4 * quad);
            vn[mt] = (f32x4){bflo(raw.x), bfhi(raw.x), bflo(raw.y), bfhi(raw.y)};
#pragma unroll
            for (int ks = 0; ks < 4; ++ks) {
                const bf16x8 a = *(const bf16x8*)(WNl + (16 * mt + l15) * 136 + 32 * ks + 8 * quad);
                vn[mt] = MFMA16(a, Sb[ks], vn[mt]);
            }
        }
        if (!isctx) {
#pragma unroll
            for (int mt = 0; mt < 4; ++mt) {
                o[mt] = (f32x4){0.f, 0.f, 0.f, 0.f};
#pragma unroll
                for (int ks = 0; ks < 4; ++ks) {
                    const bf16x8 a = *(const bf16x8*)(QNl + (16 * mt + l15) * 136 + 32 * ks + 8 * quad);
                    o[mt] = MFMA16(a, Sb[ks], o[mt]);
                }
                const f32x4 qs = *(const f32x4*)(SCl + 16 * mt + 4 * quad);
                o[mt] = o[mt] * qs;
            }
        }
        bf16x8 vb[2], vsb[2];
        {
            f32x4 kc[4];
#pragma unroll
            for (int mt = 0; mt < 4; ++mt) kc[mt] = *(const f32x4*)(SCl + 64 + 16 * mt + 4 * quad);
#pragma unroll
            for (int k2 = 0; k2 < 2; ++k2) {
                const f32x4 a = vn[2 * k2], c = vn[2 * k2 + 1];
                vb[k2] = mk8(pk2(a[0], a[1]), pk2(a[2], a[3]), pk2(c[0], c[1]), pk2(c[2], c[3]));
                const f32x4 as = a * kc[2 * k2], cs = c * kc[2 * k2 + 1];
                vsb[k2] = mk8(pk2(as[0], as[1]), pk2(as[2], as[3]), pk2(cs[0], cs[1]), pk2(cs[2], cs[3]));
            }
        }
        const float egl = SCl[128];
#pragma unroll
        for (int st = 0; st < 8; ++st) {
            S[st] = S[st] * egl;
#pragma unroll
            for (int k2 = 0; k2 < 2; ++k2) {
                const bf16x8 a = *(const bf16x8*)(KTl + (16 * st + l15) * 72 + 32 * k2 + 8 * quad);
                S[st] = MFMA16(a, vsb[k2], S[st]);
            }
        }
        if (!isctx) {
            const int tok0 = b * SEQ + (ck - 4) * 64;
#pragma unroll
            for (int mt = 0; mt < 4; ++mt) {
#pragma unroll
                for (int k2 = 0; k2 < 2; ++k2) {
                    const bf16x8 a = *(const bf16x8*)(INl + (16 * mt + l15) * 72 + 32 * k2 + 8 * quad);
                    o[mt] = MFMA16(a, vb[k2], o[mt]);
                }
#pragma unroll
                for (int r = 0; r < 4; ++r) Og[(size_t)(tok0 + 16 * mt + 4 * quad + r) * 512 + h * 128 + 16 * slice + l15] = f2bf(o[mt][r]);
            }
        }
        __syncthreads();
    }
}

template <bool SHIFT>
DI void attn_unit(const Params& p, int P, int half, unsigned char* lds, float Mb) {
    const int tid = (threadIdx.x & 255), lane = tid & 63, wid = tid >> 6, l31 = lane & 31, hh = lane >> 5;
    const int kh = P & 3, qb = 2 * ((P >> 2) & 63) + half, bk = P >> 8, b = bk >> 1, kvh = bk & 1, head = kvh * 4 + wid;
    unsigned char* ws = p.ws;
    const u16* MIX = (const u16*)(ws + OFF_MIX);
    constexpr int NT = SKV / 64 / 4;
    const u16* Kg = (const u16*)(ws + OFF_K) + (size_t)bk * SKV * 64 + (size_t)kh * NT * 64 * 64;
    const u16* Vg = (const u16*)(ws + OFF_VT) + (size_t)bk * 64 * SKV + (size_t)kh * NT * 64;
    u16* Kl = (u16*)lds; u16* Vl = (u16*)(lds + 36864);
    const int tokA = b * SEQ + qb * 64 + l31;
    const size_t qrowA = (size_t)tokA * DM + head * 64, qrowB = qrowA + (size_t)32 * DM;
    bf16x8 qfA[4], qfB[4];
#pragma unroll
    for (int ks = 0; ks < 4; ++ks) { qfA[ks] = *(const bf16x8*)(MIX + qrowA + 16 * ks + 8 * hh); qfB[ks] = *(const bf16x8*)(MIX + qrowB + 16 * ks + 8 * hh); }
    f32x16 o0A, o1A, o0B, o1B; f2_t l2A = {0.f, 0.f}, l2B = {0.f, 0.f};
#pragma unroll
    for (int i = 0; i < 16; ++i) { o0A[i] = 0.f; o1A[i] = 0.f; o0B[i] = 0.f; o1B[i] = 0.f; }
    const bf16x8 ones = mk8(0x3f803f80u, 0x3f803f80u, 0x3f803f80u, 0x3f803f80u);
    int t5_ = (int)threadIdx.x; asm volatile("" : "+v"(t5_));
    const int lrow = t5_ >> 3, lcc = t5_ & 7;
    u32x4 rk, rv;
    {
        const u32x4 k0 = *(const u32x4*)(Kg + (size_t)lrow * 64 + lcc * 8), v0 = *(const u32x4*)(Vg + (size_t)lrow * SKV + lcc * 8);
        rk = *(const u32x4*)(Kg + (size_t)(64 + lrow) * 64 + lcc * 8); rv = *(const u32x4*)(Vg + (size_t)lrow * SKV + 64 + lcc * 8);
        __syncthreads();
        *(u32x4*)(Kl + lrow * 72 + lcc * 8) = k0; *(u32x4*)(Vl + lrow * 72 + lcc * 8) = v0;
    }
    __syncthreads();
    for (int kt = 0; kt < NT; ++kt) {
        const u16* Kc = Kl + (kt & 1) * 9216; const u16* Vc = Vl + (kt & 1) * 9216;
        if (kt + 1 < NT) {
            u16* Kn = Kl + ((kt + 1) & 1) * 9216; u16* Vn = Vl + ((kt + 1) & 1) * 9216;
            *(u32x4*)(Kn + lrow * 72 + lcc * 8) = rk; *(u32x4*)(Vn + lrow * 72 + lcc * 8) = rv;
        }
        if (kt + 2 < NT) { rk = *(const u32x4*)(Kg + (size_t)((kt + 2) * 64 + lrow) * 64 + lcc * 8); rv = *(const u32x4*)(Vg + (size_t)lrow * SKV + (kt + 2) * 64 + lcc * 8); }
#pragma unroll
        for (int sub = 0; sub < 2; ++sub) {
            f32x16 sA, sB;
#pragma unroll
            for (int i = 0; i < 16; ++i) { sA[i] = SHIFT ? -Mb : 0.f; sB[i] = SHIFT ? -Mb : 0.f; }
#pragma unroll
            for (int ks = 0; ks < 4; ++ks) {
                const bf16x8 kf = *(const bf16x8*)(Kc + (sub * 32 + l31) * 72 + 16 * ks + 8 * hh);
                sA = MFMA32(kf, qfA[ks], sA); sB = MFMA32(kf, qfB[ks], sB);
            }
#pragma unroll
            for (int i = 0; i < 16; ++i) { sA[i] = __builtin_amdgcn_exp2f(sA[i]); sB[i] = __builtin_amdgcn_exp2f(sB[i]); }
#pragma unroll
            for (int i = 0; i < 8; ++i) { l2A += (f2_t){sA[2 * i], sA[2 * i + 1]}; l2B += (f2_t){sB[2 * i], sB[2 * i + 1]}; }
#pragma unroll
            for (int sp = 0; sp < 2; ++sp) {
                const bf16x8 pA = mk8(pk2(sA[8 * sp], sA[8 * sp + 1]), pk2(sA[8 * sp + 2], sA[8 * sp + 3]), pk2(sA[8 * sp + 4], sA[8 * sp + 5]), pk2(sA[8 * sp + 6], sA[8 * sp + 7]));
                const bf16x8 pB = mk8(pk2(sB[8 * sp], sB[8 * sp + 1]), pk2(sB[8 * sp + 2], sB[8 * sp + 3]), pk2(sB[8 * sp + 4], sB[8 * sp + 5]), pk2(sB[8 * sp + 6], sB[8 * sp + 7]));
                const u16* v0 = Vc + l31 * 72 + sub * 32 + 16 * sp + 4 * hh;
                const bf16x8 vf0 = mk8(*(const u32x2*)v0, *(const u32x2*)(v0 + 8));
                const bf16x8 vf1 = mk8(*(const u32x2*)(v0 + 32 * 72), *(const u32x2*)(v0 + 32 * 72 + 8));
                o0A = MFMA32(vf0, pA, o0A); o0B = MFMA32(vf0, pB, o0B); o1A = MFMA32(vf1, pA, o1A); o1B = MFMA32(vf1, pB, o1B);
            }
        }
        __syncthreads();
    }
    float* LP = (float*)(ws + OFF_LP) + (size_t)kh * NLAT * 8;
    float lsA = l2A.x + l2A.y, lsB = l2B.x + l2B.y; lsA += __shfl_xor(lsA, 32); lsB += __shfl_xor(lsB, 32);
    int lane_o = lane; asm volatile("" : "+v"(lane_o));
    const int tokO = b * SEQ + qb * 64 + (lane_o & 31);
    if (hh == 0) { LP[(size_t)tokO * 8 + head] = lsA; LP[(size_t)(tokO + 32) * 8 + head] = lsB; }
    u16* OPA = (u16*)p.out + (size_t)kh * NLAT * 512 + (size_t)tokO * 512 + head * 64;
    u16* OPB = OPA + (size_t)32 * 512;
#pragma unroll
    for (int g = 0; g < 4; ++g) {
        { u32x2 w0 = {pk2(o0A[4 * g], o0A[4 * g + 1]), pk2(o0A[4 * g + 2], o0A[4 * g + 3])}; u32x2 w1 = {pk2(o1A[4 * g], o1A[4 * g + 1]), pk2(o1A[4 * g + 2], o1A[4 * g + 3])};
          *(u32x2*)(OPA + 8 * g + 4 * hh) = w0; *(u32x2*)(OPA + 32 + 8 * g + 4 * hh) = w1; }
        { u32x2 w0 = {pk2(o0B[4 * g], o0B[4 * g + 1]), pk2(o0B[4 * g + 2], o0B[4 * g + 3])}; u32x2 w1 = {pk2(o1B[4 * g], o1B[4 * g + 1]), pk2(o1B[4 * g + 2], o1B[4 * g + 3])};
          *(u32x2*)(OPB + 8 * g + 4 * hh) = w0; *(u32x2*)(OPB + 32 + 8 * g + 4 * hh) = w1; }
    }
}

namespace pg8 {
#define PG8_LAS __attribute__((address_space(3)))
typedef unsigned short bf16_t;
typedef short bf16x8 __attribute__((ext_vector_type(8)));
typedef float f32x4 __attribute__((ext_vector_type(4)));
typedef unsigned u32x4 __attribute__((ext_vector_type(4)));
constexpr int BM = 256, BK = 64, HALF = 128, HTB = HALF * BK * 2  , STAGE_BYTES = 8 * HTB, NXCD = 8, WGM = 8;

__host__ __device__ __forceinline__ int lds_byte(int r, int c) { const int st = (r >> 4) * 2 + (c >> 5), rr = r & 15, cc = c & 31, ob = rr * 64 + cc * 2; return st * 1024 + (ob ^ (((ob >> 9) & 1) << 5)); }
__host__ __device__ __forceinline__ void stage_rc(int b, int& R, int& C) { const int st = b / 1024, sb = b % 1024, swz = sb ^ (((sb >> 9) & 1) << 5); R = (st >> 1) * 16 + swz / 64; C = (st & 1) * 32 + (swz % 64) / 2; }
__host__ __device__ __forceinline__ int perm32(int rho) { const int n = rho >> 4, i = rho & 15; return 8 * (i >> 2) + 4 * n + (i & 3); }

struct Unit { int pm, pn; };
struct Gemm { const bf16_t* A; const bf16_t* Bt; int M, N, K; };

struct StaticOrder {
    int nM, nN, nwg, G, c;
    __host__ __device__ void init(int M, int N, int G_, int c_) { nM = M / BM; nN = N / BM; nwg = nM * nN; G = G_; c = c_; }
    __host__ __device__ bool next(int i, Unit& u) const {
        const long L = (long)i * G + c; if (L >= nwg) return false;
        int wgid = (int)L; { const int q = nwg / NXCD, r = nwg % NXCD, xcd = wgid % NXCD, off = wgid / NXCD; wgid = (xcd < r ? xcd * (q + 1) : r * (q + 1) + (xcd - r) * q) + off; }
        const int nig = WGM * nN, gid = wgid / nig, fm = gid * WGM, gsz = (nM - fm) < WGM ? (nM - fm) : WGM;
        u.pm = fm + ((wgid % nig) % gsz); u.pn = (wgid % nig) / gsz; return true;
    }
    __device__ __forceinline__ void a_ready(const Unit&) const {}
    __device__ __forceinline__ void done(const Unit&) const {}
};


template <class Epi, class Sched, bool ALIGN_EPI = false, bool SP2 = false>
__device__ __forceinline__ void gemm_phase(PG8_LAS unsigned char* lds, const Gemm g, const Sched& S, const Epi& E) {
    const int tid = threadIdx.x, wid = __builtin_amdgcn_readfirstlane(tid >> 6), lane = tid & 63, wr = wid >> 2, wc = wid & 3, fr = lane & 15, fq = lane >> 4;
    const int K = g.K, nt = K / BK;
    unsigned voffA[2], voffB[2];
#pragma unroll
    for (int i = 0; i < 2; ++i) { int R, C; stage_rc(tid * 16 + i * 8192, R, C); const int Rb = Epi::PERM ? ((R & ~31) + perm32(R & 31)) : R;
        voffA[i] = (unsigned)(R * K + C) * 2u; voffB[i] = (unsigned)(Rb * K + C) * 2u; }
    const size_t kstep = (size_t)(BK * 2);
    const size_t hstep = (size_t)HALF * K * 2;
    const size_t tstep = 2 * hstep;
    const unsigned ldsw = (unsigned)wid * 1024u;
    const int aoff = lds_byte(wr * 64 + fr, fq * 8), boff = lds_byte(wc * 32 + fr, fq * 8);
#define PG8_SA(b, h) (((b) * 2 + (h)) * HTB)
#define PG8_SB(b, h) ((4 + (b) * 2 + (h)) * HTB)
#define PG8_STAGE(bufoff, gbase, voff) do { _Pragma("unroll") for (int _i = 0; _i < 2; ++_i) \
        __builtin_amdgcn_global_load_lds((const unsigned*)((const char*)(gbase) + (voff)[_i]), (PG8_LAS unsigned*)(lds + (bufoff) + ldsw + _i * 8192), 16, 0, 0); } while (0)
#define PG8_LDA(dst, b, h) do { _Pragma("unroll") for (int m = 0; m < 4; ++m) _Pragma("unroll") for (int k = 0; k < 2; ++k) dst[m][k] = *(const PG8_LAS bf16x8*)(lds + PG8_SA(b, h) + aoff + m * 2048 + k * 1024); } while (0)
#define PG8_LDB(dst, b, h) do { _Pragma("unroll") for (int n = 0; n < 2; ++n) _Pragma("unroll") for (int k = 0; k < 2; ++k) dst[n][k] = *(const PG8_LAS bf16x8*)(lds + PG8_SB(b, h) + boff + n * 2048 + k * 1024); } while (0)
#define PG8_MMA(ai, bj, At, Bt) do { __builtin_amdgcn_s_setprio(1); _Pragma("unroll") for (int m = 0; m < 4; ++m) _Pragma("unroll") for (int n = 0; n < 2; ++n) _Pragma("unroll") for (int k = 0; k < 2; ++k) \
        acc[ai][bj][m][n] = __builtin_amdgcn_mfma_f32_16x16x32_bf16(Bt[n][k], At[m][k], acc[ai][bj][m][n], 0, 0, 0); __builtin_amdgcn_s_setprio(0); } while (0)
#define PG8_WAIT_V(n) asm volatile("s_waitcnt vmcnt(" #n ")" ::: "memory")
#define PG8_WAIT_L(n) asm volatile("s_waitcnt lgkmcnt(" #n ")" ::: "memory")
#define PG8_BAR __builtin_amdgcn_s_barrier()
#define PG8_SCHED __builtin_amdgcn_sched_barrier(0)
    Unit cur, nxt; int ui = 0;
    if (!S.next(0, cur)) return;
    f32x4 acc[2][2][4][2];
#pragma unroll
    for (int a = 0; a < 2; ++a)
#pragma unroll
        for (int b = 0; b < 2; ++b)
#pragma unroll
            for (int m = 0; m < 4; ++m)
#pragma unroll
                for (int n = 0; n < 2; ++n) acc[a][b][m][n] = (f32x4){0.f, 0.f, 0.f, 0.f};
    bf16x8 At[4][2], B0[2][2], B1[2][2];
    const char* cA = (const char*)g.A + (size_t)cur.pm * tstep; const char* cB = (const char*)g.Bt + (size_t)cur.pn * tstep;
    S.a_ready(cur);
    if constexpr (SP2) {
        PG8_STAGE(PG8_SB(0, 0), cB, voffB); PG8_STAGE(PG8_SB(0, 1), cB + hstep, voffB); PG8_STAGE(PG8_SA(0, 0), cA, voffA); PG8_STAGE(PG8_SA(0, 1), cA + hstep, voffA);
        if (wr == 1) PG8_BAR;
        PG8_WAIT_V(2); PG8_BAR;
        PG8_STAGE(PG8_SB(1, 0), cB + kstep, voffB); PG8_STAGE(PG8_SA(1, 0), cA + kstep, voffA); PG8_STAGE(PG8_SB(1, 1), cB + hstep + kstep, voffB);
        PG8_WAIT_V(6); PG8_BAR;
    } else {
        PG8_STAGE(PG8_SB(0, 0), cB, voffB); PG8_STAGE(PG8_SA(0, 0), cA, voffA); PG8_STAGE(PG8_SB(0, 1), cB + hstep, voffB); PG8_STAGE(PG8_SA(0, 1), cA + hstep, voffA);
        if (wr == 1) PG8_BAR;
        PG8_WAIT_V(4); PG8_BAR;
        PG8_STAGE(PG8_SB(1, 0), cB + kstep, voffB); PG8_STAGE(PG8_SA(1, 0), cA + kstep, voffA); PG8_STAGE(PG8_SB(1, 1), cB + hstep + kstep, voffB);
        PG8_WAIT_V(6); PG8_BAR;
    }
    for (;;) {
        const bool has_next = S.next(ui + 1, nxt);
        const char* nA = has_next ? (const char*)g.A + (size_t)nxt.pm * tstep : cA; const char* nB = has_next ? (const char*)g.Bt + (size_t)nxt.pn * tstep : cB;
        for (int t = 0; t < nt; t += 2) {
            const bool last = (t == nt - 2);
            const char* a1 = cA + (size_t)(t + 1) * kstep;
            const char* a2 = last ? nA : cA + (size_t)(t + 2) * kstep; const char* b2 = last ? nB : cB + (size_t)(t + 2) * kstep;
            const char* a3 = a2 + kstep; const char* b3 = b2 + kstep;
            if (last && has_next) S.a_ready(nxt);
            if constexpr (SP2) {
            PG8_LDB(B0, 0, 0); PG8_LDB(B1, 0, 1); PG8_SCHED; PG8_LDA(At, 0, 0); PG8_STAGE(PG8_SA(1, 1), a1 + hstep, voffA);
            PG8_WAIT_V(8); PG8_WAIT_L(0); PG8_BAR; PG8_MMA(0, 0, At, B0); PG8_MMA(0, 1, At, B1); PG8_BAR; PG8_SCHED;
            PG8_LDA(At, 0, 1); PG8_STAGE(PG8_SB(0, 0), b2, voffB); PG8_STAGE(PG8_SB(0, 1), b2 + hstep, voffB); PG8_STAGE(PG8_SA(0, 0), a2, voffA);
            PG8_WAIT_V(8); PG8_WAIT_L(0); PG8_BAR; PG8_MMA(1, 0, At, B0); PG8_MMA(1, 1, At, B1); PG8_BAR; PG8_SCHED;
            PG8_LDB(B0, 1, 0); PG8_LDB(B1, 1, 1); PG8_SCHED; PG8_LDA(At, 1, 0); PG8_STAGE(PG8_SA(0, 1), a2 + hstep, voffA);
            PG8_WAIT_V(8); PG8_WAIT_L(0); PG8_BAR; PG8_MMA(0, 0, At, B0); PG8_MMA(0, 1, At, B1); PG8_BAR; PG8_SCHED;
            PG8_LDA(At, 1, 1); PG8_STAGE(PG8_SB(1, 0), b3, voffB); PG8_STAGE(PG8_SB(1, 1), b3 + hstep, voffB); PG8_STAGE(PG8_SA(1, 0), a3, voffA);
            PG8_WAIT_V(8); PG8_WAIT_L(0); PG8_BAR; PG8_MMA(1, 0, At, B0); PG8_MMA(1, 1, At, B1); PG8_BAR; PG8_SCHED;
            } else {
            PG8_LDB(B0, 0, 0); PG8_SCHED; PG8_LDA(At, 0, 0); PG8_STAGE(PG8_SA(1, 1), a1 + hstep, voffA);
            PG8_WAIT_L(8); PG8_BAR; PG8_WAIT_L(0); PG8_MMA(0, 0, At, B0); PG8_BAR; PG8_SCHED;
            PG8_LDB(B1, 0, 1); PG8_STAGE(PG8_SB(0, 0), b2, voffB);
            PG8_BAR; PG8_WAIT_L(0); PG8_MMA(0, 1, At, B1); PG8_BAR;
            PG8_LDA(At, 0, 1); PG8_STAGE(PG8_SA(0, 0), a2, voffA);
            PG8_BAR; PG8_WAIT_L(0); PG8_MMA(1, 0, At, B0); PG8_BAR; PG8_SCHED;
            PG8_STAGE(PG8_SB(0, 1), b2 + hstep, voffB);
            PG8_WAIT_V(6); PG8_BAR; PG8_MMA(1, 1, At, B1); PG8_BAR;
            PG8_LDB(B0, 1, 0); PG8_SCHED; PG8_LDA(At, 1, 0); PG8_STAGE(PG8_SA(0, 1), a2 + hstep, voffA);
            PG8_WAIT_L(8); PG8_BAR; PG8_WAIT_L(0); PG8_MMA(0, 0, At, B0); PG8_BAR; PG8_SCHED;
            PG8_LDB(B1, 1, 1); PG8_STAGE(PG8_SB(1, 0), b3, voffB);
            PG8_BAR; PG8_WAIT_L(0); PG8_MMA(0, 1, At, B1); PG8_BAR;
            PG8_LDA(At, 1, 1); PG8_STAGE(PG8_SA(1, 0), a3, voffA);
            PG8_BAR; PG8_WAIT_L(0); PG8_MMA(1, 0, At, B0); PG8_BAR; PG8_SCHED;
            PG8_STAGE(PG8_SB(1, 1), b3 + hstep, voffB);
            PG8_WAIT_V(6); PG8_BAR; PG8_MMA(1, 1, At, B1); PG8_BAR;
            }
        }
        if constexpr (ALIGN_EPI) { if (wr == 0) PG8_BAR; }
        if constexpr (!Epi::AFTER_DRAIN) { E(acc, cur, wr, wc, fr, fq); S.done(cur); }
        if (!has_next) break;
#pragma unroll
        for (int a = 0; a < 2; ++a)
#pragma unroll
            for (int b = 0; b < 2; ++b)
#pragma unroll
                for (int m = 0; m < 4; ++m)
#pragma unroll
                    for (int n = 0; n < 2; ++n) acc[a][b][m][n] = (f32x4){0.f, 0.f, 0.f, 0.f};
        cur = nxt; cA = nA; cB = nB; ++ui;
        if constexpr (ALIGN_EPI) { if (wr == 1) PG8_BAR; }
    }
    PG8_WAIT_V(0);
    if constexpr (!ALIGN_EPI) { if (wr == 0) PG8_BAR; }
    PG8_BAR;
    if constexpr (Epi::AFTER_DRAIN) { E.fused(acc, cur, wr, wc, fr, fq, lds, wid, lane); S.done(cur); }
#undef PG8_SA
#undef PG8_SB
#undef PG8_STAGE
#undef PG8_LDA
#undef PG8_LDB
#undef PG8_MMA
#undef PG8_WAIT_V
#undef PG8_WAIT_L
#undef PG8_BAR
#undef PG8_SCHED
}

struct EpiRelu2 {
    static constexpr bool PERM = true, AFTER_DRAIN = false;
    bf16_t* O; int ldc;
    __device__ __forceinline__ void operator()(const f32x4 (&acc)[2][2][4][2], const Unit& u, int wr, int wc, int fr, int fq) const {
#pragma unroll
        for (int ai = 0; ai < 2; ++ai)
#pragma unroll
            for (int m = 0; m < 4; ++m) {
                bf16_t* rowp = O + (size_t)(u.pm * BM + ai * HALF + wr * 64 + m * 16 + fr) * ldc + u.pn * BM + wc * 32 + 8 * fq;
#pragma unroll
                for (int bj = 0; bj < 2; ++bj) {
                    f32x4 v0 = acc[ai][bj][m][0], v1 = acc[ai][bj][m][1];
#pragma unroll
                    for (int r = 0; r < 4; ++r) { const float a = fmaxf(v0[r], 0.f); v0[r] = a * a; const float c = fmaxf(v1[r], 0.f); v1[r] = c * c; }
                    u32x4 w = {::pk2(v0[0], v0[1]), ::pk2(v0[2], v0[3]), ::pk2(v1[0], v1[1]), ::pk2(v1[2], v1[3])};
                    *(u32x4*)(rowp + bj * HALF) = w;
                }
            }
    }
};
struct EpiGatedRes {
    static constexpr bool PERM = true, AFTER_DRAIN = false;
    const float* base; float* out; const float* gate; int gate_bstride; int ldc;
    __device__ __forceinline__ void operator()(const f32x4 (&acc)[2][2][4][2], const Unit& u, int wr, int wc, int fr, int fq) const {
        const float* g = gate + ((u.pm * BM) >> 13) * gate_bstride;
        const int col0 = u.pn * BM + wc * 32 + 8 * fq;
        f32x4 gv[2][2];
#pragma unroll
        for (int bj = 0; bj < 2; ++bj)
#pragma unroll
            for (int n = 0; n < 2; ++n) gv[bj][n] = *(const f32x4*)(g + col0 + bj * HALF + n * 4);
#pragma unroll
        for (int ai = 0; ai < 2; ++ai)
#pragma unroll
            for (int m = 0; m < 4; ++m) {
                const size_t off = (size_t)(u.pm * BM + ai * HALF + wr * 64 + m * 16 + fr) * ldc + col0;
#pragma unroll
                for (int bj = 0; bj < 2; ++bj)
#pragma unroll
                    for (int n = 0; n < 2; ++n) {
                        const f32x4 xv = *(const f32x4*)(base + off + bj * HALF + n * 4);
                        *(f32x4*)(out + off + bj * HALF + n * 4) = xv + gv[bj][n] * acc[ai][bj][m][n];
                    }
            }
    }
};
struct EpiInProj {
    static constexpr bool PERM = true, AFTER_DRAIN = false;
    bf16_t* MIX; bf16_t* Kb; bf16_t* Vt; bf16_t* DQ; float* GT; const float* a_log; const float* dt_bias;
    __device__ __forceinline__ void operator()(const f32x4 (&acc)[2][2][4][2], const Unit& u, int wr, int wc, int fr, int fq) const {
        const int pn = u.pn; const bool lat = u.pm < 64;
#pragma unroll
        for (int ai = 0; ai < 2; ++ai)
#pragma unroll
            for (int m = 0; m < 4; ++m) {
                const int gr = u.pm * BM + ai * HALF + wr * 64 + m * 16 + fr;
                int bb, kvpos;
                if (lat) { bb = gr >> 13; kvpos = 256 + (gr & 8191); } else { const int cr = gr - 16384; bb = cr >> 8; kvpos = cr & 255; }
#pragma unroll
                for (int bj = 0; bj < 2; ++bj) {
                    const int cl = bj * HALF + wc * 32 + 8 * fq;
                    const f32x4 v0 = acc[ai][bj][m][0], v1 = acc[ai][bj][m][1];
                    const u32x4 w = {::pk2(v0[0], v0[1]), ::pk2(v0[2], v0[3]), ::pk2(v1[0], v1[1]), ::pk2(v1[2], v1[3])};
                    if (pn < 2) { if (lat) *(u32x4*)(MIX + (size_t)gr * 1024 + pn * 256 + cl) = w; }
                    else if (pn == 2) {
                        if (bj == 0) { const int kvh = cl >> 6, d = cl & 63; *(u32x4*)(Kb + ((size_t)(bb * 2 + kvh) * 8448 + kvpos) * 64 + d) = w; }
                        else { const int c2 = cl - HALF, kvh = c2 >> 6, d = c2 & 63; bf16_t* vp = Vt + ((size_t)(bb * 2 + kvh) * 64 + d) * 8448 + kvpos;
#pragma unroll
                            for (int e = 0; e < 4; ++e) { vp[(2 * e) * 8448] = (bf16_t)(w[e] & 0xffffu); vp[(2 * e + 1) * 8448] = (bf16_t)(w[e] >> 16); } }
                    }
                    else if (pn < 9) *(u32x4*)(DQ + (size_t)gr * 1536 + (pn - 3) * 256 + cl) = w;
                    else { if (lat) *(u32x4*)(MIX + (size_t)gr * 1024 + 512 + (pn - 9) * 256 + cl) = w; }
                }
            }
    }
};
}

#define XB_TMO      128
#define XB_XCNT(j)  (256  + 64 * (j))
#define XB_XSUB(j)  (1280 + 64 * (j))
#define XB_XGEN(j)  (2304 + 64 * (j))
#define XB_TOP      3328
#define XB_TOPGEN   3392
#define XCD_BAR_WORDS 3456
#define XB_SPIN_CAP (1u << 22)
#define LAS __attribute__((address_space(3)))
DI unsigned xb_ld(unsigned* p)              { return __hip_atomic_load(p, __ATOMIC_RELAXED, __HIP_MEMORY_SCOPE_AGENT); }
DI unsigned xb_add(unsigned* p, unsigned v) { return __hip_atomic_fetch_add(p, v, __ATOMIC_RELAXED, __HIP_MEMORY_SCOPE_AGENT); }
DI unsigned xb_xcc_id() { return (unsigned)__builtin_amdgcn_s_getreg((3 << 11) | 20) & 0xFu; }
#define XB_SPIN(cond, bar) do { unsigned _sp = 0; while (cond) { __builtin_amdgcn_s_sleep(1); \
    if ((++_sp & 255u) == 0u) { if (xb_ld(&(bar)[XB_TMO])) break; if (_sp > XB_SPIN_CAP) { atomicAdd(&(bar)[XB_TMO], 1u); break; } } } } while (0)
struct XcdBarrier { unsigned* bar; unsigned x; volatile LAS unsigned* st; };
DI XcdBarrier xcd_barrier_post(unsigned* bar, volatile LAS unsigned* st) {
    XcdBarrier b; b.bar = bar; b.x = xb_xcc_id(); b.st = st;
    if (threadIdx.x == 0) (void)xb_add(&bar[XB_XCNT(b.x)], 1u);
    return b;
}
DI void xcd_barrier_complete(unsigned* bar, unsigned x, unsigned& nloc, unsigned& nx) {
    const unsigned G = gridDim.x * gridDim.y * gridDim.z;
    unsigned sum, cnt, mine, sp = 0u;
    for (;;) {
        sum = 0u; cnt = 0u; mine = 0u;
#pragma unroll
        for (unsigned j = 0; j < 16; ++j) { const unsigned c = xb_ld(&bar[XB_XCNT(j)]); sum += c; cnt += (c > 0u) ? 1u : 0u; mine = (j == x) ? c : mine; }
        if (sum == G) break;
        __builtin_amdgcn_s_sleep(1);
        if ((++sp & 255u) == 0u) { if (xb_ld(&bar[XB_TMO])) break; if (sp > XB_SPIN_CAP) { atomicAdd(&bar[XB_TMO], 1u); break; } }
    }
    nloc = mine > 0u ? mine : 1u; nx = cnt > 0u ? cnt : 1u;
}
DI void xcd_barrier(const XcdBarrier& b) {
    asm volatile("s_waitcnt vmcnt(0)" ::: "memory");
    __syncthreads();
    if (threadIdx.x == 0) {
        unsigned* bar = b.bar;
        __builtin_amdgcn_s_waitcnt(0);
        unsigned nloc = b.st[0], nx = b.st[1];
        if (nloc == 0u) { xcd_barrier_complete(bar, b.x, nloc, nx); b.st[0] = nloc; b.st[1] = nx; }
        const unsigned old = xb_add(&bar[XB_XSUB(b.x)], 1u);
        const unsigned gen = old / nloc;
        if (old + 1u == (gen + 1u) * nloc) {
            __builtin_amdgcn_fence(__ATOMIC_RELEASE, "agent");
            asm volatile("s_waitcnt vmcnt(0)" ::: "memory");
            const unsigned og = xb_add(&bar[XB_TOP], 1u);
            const unsigned tg = og / nx;
            if (og + 1u == (tg + 1u) * nx) xb_add(&bar[XB_TOPGEN], 1u);
            else XB_SPIN(xb_ld(&bar[XB_TOPGEN]) == tg, bar);
            __builtin_amdgcn_fence(__ATOMIC_ACQUIRE, "agent");
            xb_add(&bar[XB_XGEN(b.x)], 1u);
            asm volatile("s_waitcnt vmcnt(0)" ::: "memory");
        } else {
            XB_SPIN(xb_ld(&bar[XB_XGEN(b.x)]) == gen, bar);
            __builtin_amdgcn_fence(__ATOMIC_ACQUIRE, "agent");
            asm volatile("s_waitcnt vmcnt(0)" ::: "memory");
        }
    }
    __syncthreads();
}

__global__ void __launch_bounds__(512, 2) mega(Params p) {
    extern __shared__ __attribute__((aligned(16))) unsigned char lds_raw[];
    const int half = __builtin_amdgcn_readfirstlane(threadIdx.x >> 8);
    const int tid = threadIdx.x & 255, lane = tid & 63, wid = tid >> 6;
    const int nblk = gridDim.x * 2, bid = blockIdx.x * 2 + half;
    auto lwid = [&]() { int w_ = (int)((threadIdx.x & 255) >> 6); asm volatile("" : "+v"(w_)); return w_; };
    unsigned char* const lds_base = lds_raw; unsigned char* const lds = lds_raw + half * 73728;
    unsigned char* ws = p.ws;
    const int lo = p.ph_lo, hi = p.ph_hi;
#ifndef PH_MASK
#define PH_MASK 0x3ff
#endif
#define IN_PH(k) ((((PH_MASK) >> (k)) & 1) && lo <= (k) && (k) <= hi)
#define SEAM(k) do { if ((k) < hi) { xcd_barrier(xb); } } while (0)
    if (threadIdx.x < 4) ((volatile LAS unsigned*)(lds_base + 147456))[threadIdx.x] = 0u;
    __syncthreads();
    XcdBarrier xb = xcd_barrier_post((unsigned*)(ws + OFF_BAR), (volatile LAS unsigned*)(lds_base + 147456));
    if (hi > 1000) cg::this_grid().sync();
    float* MOD = (float*)(ws + OFF_MODZ);
    int* CNT = (int*)(ws + OFF_MISC);

    if (IN_PH(0)) {
        constexpr int T_MOD = 96 * 4;
        for (int t = bid; t < T_MOD + 2; t += nblk) {
            if (t < T_MOD) {
                const int j = t >> 2, kq = t & 3; float* sv = (float*)lds; float* red = sv + 768;
                __syncthreads();
                for (int i = tid; i < 768; i += 256) { const int which = i >> 8, k = kq * 256 + (i & 255); const float cv = which < 2 ? p.c[which * 1024 + k] : p.c_ctx[k]; sv[i] = silu_f(cv); }
                __syncthreads();
                const int col = j * 64 + lane; float a0 = 0.f, a1 = 0.f, a2 = 0.f;
#pragma unroll 8
                for (int k = 64 * wid; k < 64 * wid + 64; ++k) { const float wv = p.w_mod[(size_t)(kq * 256 + k) * 6144 + col]; a0 += sv[k] * wv; a1 += sv[256 + k] * wv; a2 += sv[512 + k] * wv; }
                red[(wid * 3 + 0) * 64 + lane] = a0; red[(wid * 3 + 1) * 64 + lane] = a1; red[(wid * 3 + 2) * 64 + lane] = a2;
                __syncthreads();
                if (tid < 192) { const int which = tid >> 6, cl = tid & 63; float sacc = kq == 0 ? p.b_mod[j * 64 + cl] : 0.f; for (int w = 0; w < 4; ++w) sacc += red[(w * 3 + which) * 64 + cl]; atomicAdd(&MOD[which * 6144 + j * 64 + cl], sacc); }
            } else if (t == T_MOD) {
                f2_t* RT = (f2_t*)(ws + OFF_ROPE);
                for (int i = tid; i < 2048; i += 256) {
                    const int pos = i >> 4, j = i & 15;
                    const float inv = exp2f(-(float)j * 0.8304820237218406f);
                    const float ang = (float)pos * inv;
                    const float n = rintf(ang * 0.15915494309189535f);
                    float r = fmaf(-n, 6.28125f, ang); r = fmaf(-n, 1.9353071795864769e-3f, r);
                    RT[i] = (f2_t){cosf(r), sinf(r)};
                }
            } else { if (tid == 0) CNT[0] = 0; }
        }
        for (int t = bid; t < 16 * (INP / 64); t += nblk) wconv_tile(p.w_in, DM, INC, INP, (u16*)(ws + OFF_WIN), t, (float*)lds);
        SEAM(0);
    }
    if (IN_PH(1)) {
        u16* H = (u16*)(ws + OFF_H);
        norm_rows([&](int r) { return r < NLAT ? p.x + (size_t)r * DM : p.ctx + (size_t)(r - NLAT) * DM; }, NROW, bid * 4 + lwid(), nblk * 4, p.norm1_w, MOD, 0, 1, H, lane);
        SEAM(1);
    }
    if (IN_PH(2)) {
        pg8::Gemm g{(const u16*)(ws + OFF_H), (const u16*)(ws + OFF_WIN), NROW, 2816, DM}; pg8::StaticOrder S; S.init(NROW, 2816, (int)gridDim.x, (int)blockIdx.x);
        pg8::EpiInProj E{(u16*)(ws + OFF_MIX), (u16*)(ws + OFF_K), (u16*)(ws + OFF_VT), (u16*)(ws + OFF_DQKV), (float*)(ws + OFF_GATE), p.a_log, p.dt_bias};
        pg8::gemm_phase<pg8::EpiInProj, pg8::StaticOrder, true, true>((PG8_LAS unsigned char*)lds_base, g, S, E);
        {
            const u16* H = (const u16*)(ws + OFF_H); const u16* Wg = (const u16*)(ws + OFF_WIN) + (size_t)2816 * DM; float* GT = (float*)(ws + OFF_GATE);
            const int l15 = lane & 15, quad = lane >> 4;
            for (int rb = (int)blockIdx.x * 8 + (int)(threadIdx.x >> 6); rb < NROW / 16; rb += (int)gridDim.x * 8) {
                f32x4 acc = {0.f, 0.f, 0.f, 0.f};
                const u16* ap = H + (size_t)(rb * 16 + l15) * DM + 8 * quad; const u16* bp = Wg + (size_t)l15 * DM + 8 * quad;
#pragma unroll 8
                for (int ks = 0; ks < 32; ++ks) acc = MFMA16(*(const bf16x8*)(ap + 32 * ks), *(const bf16x8*)(bp + 32 * ks), acc);
                const int ci = l15;
#pragma unroll
                for (int r = 0; r < 4; ++r) {
                    const float x = acc[r]; float o;
                    if (ci < 8) o = 1.f / (1.f + __expf(-x));
                    else { const float xx = x + p.dt_bias[ci - 8]; const float sp = xx > 20.f ? xx : log1pf(__expf(xx)); o = -__expf(p.a_log[ci - 8]) * sp; }
                    GT[(size_t)(rb * 16 + 4 * quad + r) * 16 + ci] = o;
                }
            }
        }
        SEAM(2);
    }
    if (IN_PH(3)) {
        if (bid < 32) { gdn_prep_unit(p, ((bid >> 4) * NCK + ((bid >> 2) & 3)) * 4 + (bid & 3), lds); } else {
        {
            u16* MIX = (u16*)(ws + OFF_MIX); u16* Kb = (u16*)(ws + OFF_K); const f2_t* RT = (const f2_t*)(ws + OFF_ROPE);
            const int l8 = lane & 7, sub = lane >> 3;
            for (int it = (bid - 32) * 4 + wid; it < NLAT + (NB * 2 * SKV) / 8; it += (nblk - 32) * 4) {
                u16* ptr; int t; bool rope; const float* nw; float scale;
                if (it < NLAT) { ptr = MIX + (size_t)it * DM + sub * 64 + l8 * 8; t = it & (SEQ - 1); rope = true; nw = p.q_norm_w; scale = QSCALE; }
                else { const int j = (it - NLAT) * 8 + sub, bk = j / SKV, pos = j - bk * SKV; ptr = Kb + ((size_t)bk * SKV + pos) * 64 + l8 * 8; rope = pos >= CTXL; t = pos >= CTXL ? pos - CTXL : 0; nw = p.k_norm_w; scale = 1.f; }
                const u32x4 raw = *(const u32x4*)ptr;
                float y[8];
#pragma unroll
                for (int e = 0; e < 4; ++e) { y[2 * e] = bflo(raw[e]); y[2 * e + 1] = bfhi(raw[e]); }
                float ss = 0.f;
#pragma unroll
                for (int e = 0; e < 8; ++e) ss += y[e] * y[e];
                ss += __shfl_xor(ss, 1); ss += __shfl_xor(ss, 2); ss += __shfl_xor(ss, 4);
                const float rinv = rsqrtf(ss * (1.f / 64.f) + EPS);
                const f32x4 wa = *(const f32x4*)(nw + 8 * l8), wb = *(const f32x4*)(nw + 8 * l8 + 4);
                const int ppos = (l8 & 4) ? (t & 63) : (t >> 6); const float sgn = (l8 & 2) ? 1.f : -1.f;
#pragma unroll
                for (int e = 0; e < 8; ++e) {
                    const float v = y[e] * rinv * (e < 4 ? wa[e] : wb[e - 4]);
                    const float pv = __shfl_xor(v, 2);
                    const f2_t cs = RT[ppos * 16 + 8 * (l8 & 1) + e];
                    const float vr = v * cs.x + sgn * pv * cs.y;
                    y[e] = (rope ? vr : v) * scale;
                }
                const u32x4 w = {pk2(y[0], y[1]), pk2(y[2], y[3]), pk2(y[4], y[5]), pk2(y[6], y[7])};
                *(u32x4*)ptr = w;
            }
        }
        constexpr int T_WO = 16 * 16, T_W1 = 16 * 64, T_W2 = 64 * 16;
        for (int t = bid - 32; t < T_WO + T_W1 + T_W2; t += nblk - 32) {
            if (t < T_WO) wconv_tile(p.w_out, DM, DM, DM, (u16*)(ws + OFF_WOUT), t, (float*)lds);
            else if (t < T_WO + T_W1) wconv_tile(p.w_mlp1, DM, DFF, DFF, (u16*)(ws + OFF_WM1), t - T_WO, (float*)lds);
            else wconv_tile(p.w_mlp2, DFF, DM, DM, (u16*)(ws + OFF_WM2), t - T_WO - T_W1, (float*)lds);
        }
        }
        for (int j = bid; j < 1024; j += nblk) gdn_prep_unit(p, ((j >> 9) * NCK + 4 + ((j & 511) >> 2)) * 4 + (j & 3), lds);
        SEAM(3);
    }
    if (IN_PH(4)) {
        if (blockIdx.x < 32) {
            gdn_scan_block(p, (int)blockIdx.x, lds_base, lds_base + 73728, half);
        }
        float Mb;
        { const float a = wave_max(fabsf(p.q_norm_w[lane])), bq = wave_max(fabsf(p.k_norm_w[lane])); Mb = 8.f * a * bq * 1.4426950408889634f; }
        int* su = (int*)(lds_base + 147456 + 8);
        __syncthreads();
        if (threadIdx.x == 0) *su = atomicAdd(CNT, 2);
        __syncthreads();
        int u0 = *su;
        while (u0 < 2048) {
            int nxt = 0;
            if (threadIdx.x == 0) nxt = atomicAdd(CNT, 2);
            if (Mb > 64.f) attn_unit<true>(p, u0 >> 1, half, lds_base, Mb); else attn_unit<false>(p, u0 >> 1, half, lds_base, Mb);
            if (threadIdx.x == 0) *su = nxt;
            __syncthreads();
            u0 = *su;
        }
        SEAM(4);
    }
    if (IN_PH(5)) {
        const u16* O0 = (const u16*)(ws + OFF_O01); const u16* O1 = O0 + (size_t)NLAT * 512; u16* MIX = (u16*)(ws + OFF_MIX);
        const int e0 = (8 * lane) & 127;
        const f32x4 nwa = *(const f32x4*)(p.dn_norm_w + e0), nwb = *(const f32x4*)(p.dn_norm_w + e0 + 4);
        {
            const u16* PP = (const u16*)p.out; const float* LL = (const float*)(ws + OFF_LP);
            for (int r = bid * 4 + lwid(); r < NLAT; r += nblk * 4) {
                const size_t off = (size_t)r * 512 + 8 * lane;
                float acc[8] = {0.f, 0.f, 0.f, 0.f, 0.f, 0.f, 0.f, 0.f}; float lsum = 0.f;
#pragma unroll
                for (int q = 0; q < 4; ++q) {
                    const u32x4 a = *(const u32x4*)(PP + (size_t)q * NLAT * 512 + off);
                    lsum += LL[(size_t)q * NLAT * 8 + (size_t)r * 8 + (lane >> 3)];
#pragma unroll
                    for (int i = 0; i < 4; ++i) { acc[2 * i] += bflo(a[i]); acc[2 * i + 1] += bfhi(a[i]); }
                }
                const float inv = 1.f / lsum;
                u32x4 w = {pk2(acc[0] * inv, acc[1] * inv), pk2(acc[2] * inv, acc[3] * inv), pk2(acc[4] * inv, acc[5] * inv), pk2(acc[6] * inv, acc[7] * inv)};
                *(u32x4*)(MIX + (size_t)r * DM + 8 * lane) = w;
            }
        }
        int r = bid * 4 + lwid(); const int rs = nblk * 4;
        u32x4 na = {0u, 0u, 0u, 0u}, nc = na, nz = na;
        if (r < NLAT) { na = *(const u32x4*)(O0 + (size_t)r * 512 + 8 * lane); nc = *(const u32x4*)(O1 + (size_t)r * 512 + 8 * lane); nz = *(const u32x4*)(MIX + (size_t)r * DM + 512 + 8 * lane); }
        for (; r < NLAT; r += rs) {
            const u32x4 a = na, c = nc, z = nz;
            if (r + rs < NLAT) { const int r2 = r + rs; na = *(const u32x4*)(O0 + (size_t)r2 * 512 + 8 * lane); nc = *(const u32x4*)(O1 + (size_t)r2 * 512 + 8 * lane); nz = *(const u32x4*)(MIX + (size_t)r2 * DM + 512 + 8 * lane); }
            float o[8], zz[8];
#pragma unroll
            for (int i = 0; i < 4; ++i) { o[2 * i] = bflo(a[i]) + bflo(c[i]); o[2 * i + 1] = bfhi(a[i]) + bfhi(c[i]); zz[2 * i] = bflo(z[i]); zz[2 * i + 1] = bfhi(z[i]); }
            float ss = 0.f;
#pragma unroll
            for (int i = 0; i < 8; ++i) ss += o[i] * o[i];
            ss += __shfl_xor(ss, 1); ss += __shfl_xor(ss, 2); ss += __shfl_xor(ss, 4); ss += __shfl_xor(ss, 8);
            const float rinv = rsqrtf(ss * (1.f / 128.f) + EPS);
            float y[8];
#pragma unroll
            for (int i = 0; i < 8; ++i) y[i] = o[i] * rinv * (i < 4 ? nwa[i] : nwb[i - 4]) * silu_f(zz[i]);
            u32x4 w = {pk2(y[0], y[1]), pk2(y[2], y[3]), pk2(y[4], y[5]), pk2(y[6], y[7])};
            *(u32x4*)(MIX + (size_t)r * DM + 512 + 8 * lane) = w;
        }
        SEAM(5);
    }
    if (IN_PH(6)) {
        pg8::Gemm g{(const u16*)(ws + OFF_MIX), (const u16*)(ws + OFF_WOUT), NLAT, DM, DM}; pg8::StaticOrder S; S.init(NLAT, DM, (int)gridDim.x, (int)blockIdx.x);
        pg8::EpiGatedRes E{p.x, p.out, MOD + 2 * 1024, 6144, DM};
        pg8::gemm_phase<pg8::EpiGatedRes, pg8::StaticOrder, true, true>((PG8_LAS unsigned char*)lds_base, g, S, E);
        SEAM(6);
    }
    if (IN_PH(7)) {
        u16* H2 = (u16*)(ws + OFF_H2);
        norm_rows([&](int r) { return (const float*)p.out + (size_t)r * DM; }, NLAT, bid * 4 + lwid(), nblk * 4, p.norm2_w, MOD, 3, 4, H2, lane);
        SEAM(7);
    }
    if (IN_PH(8)) {
        pg8::Gemm g{(const u16*)(ws + OFF_H2), (const u16*)(ws + OFF_WM1), NLAT, DFF, DM}; pg8::StaticOrder S; S.init(NLAT, DFF, (int)gridDim.x, (int)blockIdx.x);
        pg8::EpiRelu2 E{(u16*)(ws + OFF_HID), DFF};
        pg8::gemm_phase<pg8::EpiRelu2, pg8::StaticOrder, true, true>((PG8_LAS unsigned char*)lds_base, g, S, E);
        SEAM(8);
    }
    if (IN_PH(9)) {
        pg8::Gemm g{(const u16*)(ws + OFF_HID), (const u16*)(ws + OFF_WM2), NLAT, DM, DFF}; pg8::StaticOrder S; S.init(NLAT, DM, (int)gridDim.x, (int)blockIdx.x);
        pg8::EpiGatedRes E{p.out, p.out, MOD + 5 * 1024, 6144, DM};
        pg8::gemm_phase<pg8::EpiGatedRes, pg8::StaticOrder, true, true>((PG8_LAS unsigned char*)lds_base, g, S, E);
    }
}

extern "C" void kernel_launch(void* const* d_in, const int* in_sizes, int n_in, void* d_out, int out_size, void* d_ws, size_t ws_size, hipStream_t stream) {
    static int grid = 0;
    if (grid == 0) {
        if (ws_size < WS_NEED) { fprintf(stderr, "kernel_launch: workspace too small (%zu < %zu)\n", ws_size, (size_t)WS_END); grid = -1; return; }
        int dev = 0, cus = 0, per_cu = 0;
        hipGetDevice(&dev);
        hipDeviceGetAttribute(&cus, hipDeviceAttributeMultiprocessorCount, dev);
        hipFuncSetAttribute((const void*)mega, hipFuncAttributeMaxDynamicSharedMemorySize, LDS_BYTES);
        hipOccupancyMaxActiveBlocksPerMultiprocessor(&per_cu, (const void*)mega, 512, LDS_BYTES);
        if (per_cu < 1) per_cu = 1;
        if (per_cu > 1) per_cu = 1;
        grid = cus * per_cu;
        fprintf(stderr, "kernel_launch: cus %d per_cu %d grid %d ws %zu need %zu\n", cus, per_cu, grid, ws_size, (size_t)WS_END);
    }
    if (grid < 0) return;
    if (hipMemsetAsync((unsigned char*)d_ws + OFF_BAR, 0, ZERO_BYTES, stream) != hipSuccess) { fprintf(stderr, "kernel_launch: memset of barrier words failed\n"); return; }
    Params p{};
    const float** pp = (const float**)&p;
    for (int i = 0; i < 18; ++i) pp[i] = (const float*)d_in[i];
    p.out = (float*)d_out; p.ws = (unsigned char*)d_ws;
#if ONE_LAUNCH
    p.ph_lo = 0; p.ph_hi = 9;
    void* args[] = {&p};
    hipError_t e = hipLaunchCooperativeKernel((const void*)mega, dim3(grid), dim3(512), args, LDS_BYTES, stream);
    if (e != hipSuccess) fprintf(stderr, "cooperative launch failed: %s (grid %d)\n", hipGetErrorString(e), grid);
#else
#ifndef DUP_PH
#define DUP_PH -1
#endif
    for (int ph = 0; ph <= 9; ++ph) {
        p.ph_lo = ph; p.ph_hi = ph;
        hipLaunchKernelGGL(mega, dim3(grid), dim3(512), LDS_BYTES, stream, p);
        if (ph == DUP_PH) hipLaunchKernelGGL(mega, dim3(grid), dim3(512), LDS_BYTES, stream, p);
    }
#endif
}
```

```cpp
#include <hip/hip_runtime.h>
#include <hip/hip_cooperative_groups.h>
#include <stdint.h>
#include <cstdio>
namespace cg = cooperative_groups;

#ifndef ONE_LAUNCH
#define ONE_LAUNCH 1
#endif

typedef unsigned short u16;
typedef __bf16 bf2_t __attribute__((ext_vector_type(2)));
typedef float f2_t __attribute__((ext_vector_type(2)));
typedef short bf16x8 __attribute__((ext_vector_type(8)));
typedef float f32x4 __attribute__((ext_vector_type(4)));
typedef float f32x16 __attribute__((ext_vector_type(16)));
typedef unsigned u32x2 __attribute__((ext_vector_type(2)));
typedef unsigned u32x4 __attribute__((ext_vector_type(4)));

#define DI __device__ __forceinline__
DI unsigned pk2(float lo, float hi) { f2_t v = {lo, hi}; return __builtin_bit_cast(unsigned, __builtin_convertvector(v, bf2_t)); }
DI u16 f2bf(float x) { return (u16)(pk2(x, 0.f) & 0xffffu); }
DI float bf2f(u16 v) { return __uint_as_float(((unsigned)v) << 16); }
DI float bflo(unsigned v) { return __uint_as_float(v << 16); }
DI float bfhi(unsigned v) { return __uint_as_float(v & 0xffff0000u); }
DI bf16x8 mk8(unsigned a, unsigned b, unsigned c, unsigned d) { u32x4 v = {a, b, c, d}; return __builtin_bit_cast(bf16x8, v); }
DI bf16x8 mk8(u32x2 lo, u32x2 hi) { u32x4 v = {lo.x, lo.y, hi.x, hi.y}; return __builtin_bit_cast(bf16x8, v); }
#define MFMA16(a, b, c) __builtin_amdgcn_mfma_f32_16x16x32_bf16((a), (b), (c), 0, 0, 0)
#define MFMA32(a, b, c) __builtin_amdgcn_mfma_f32_32x32x16_bf16((a), (b), (c), 0, 0, 0)

constexpr int DM = 1024, NB = 2, SEQ = 8192, NLAT = NB * SEQ, CTXL = 256, NCTX = NB * CTXL, NROW = NLAT + NCTX;
constexpr int INC = 2832, INP = 3072, DFF = 4096, SKV = CTXL + SEQ;
constexpr int NCK = 132;
constexpr int NCU = NB * NCK * 4;
constexpr float EPS = 1e-6f;
constexpr float QSCALE = 0.125f * 1.4426950408889634f;

constexpr size_t OFF_WIN = 0;
constexpr size_t OFF_MOD = OFF_WIN + (size_t)INP * DM * 2;
constexpr size_t OFF_ROPE = OFF_MOD + 3 * 6144 * 4;
constexpr size_t OFF_MISC = OFF_ROPE + 128 * 16 * 8;
constexpr size_t OFF_H = OFF_MISC + 256;
constexpr size_t OFF_WOUT = OFF_H;
constexpr size_t OFF_WM1 = OFF_WOUT + (size_t)DM * DM * 2;
constexpr size_t OFF_WM2 = OFF_WM1 + (size_t)DFF * DM * 2;
constexpr size_t OFF_DQKV = OFF_H + (size_t)NROW * DM * 2;
constexpr size_t OFF_O01 = OFF_DQKV;
constexpr size_t OFF_H2 = OFF_DQKV;
constexpr size_t OFF_MIX = OFF_DQKV + (size_t)NROW * 1536 * 2;
constexpr size_t OFF_HID = OFF_MIX;
constexpr size_t OFF_K = OFF_MIX + (size_t)NLAT * DM * 2;
constexpr size_t OFF_VT = OFF_K + (size_t)NB * 2 * SKV * 64 * 2;
constexpr size_t OFF_GATE = OFF_VT + (size_t)NB * 2 * SKV * 64 * 2;
constexpr size_t OFF_QN = OFF_GATE + (size_t)NROW * 16 * 4;
constexpr size_t OFF_KNT = OFF_QN + (size_t)NCU * 8192 * 2;
constexpr size_t OFF_WNEG = OFF_KNT + (size_t)NCU * 8192 * 2;
constexpr size_t OFF_UT = OFF_WNEG + (size_t)2 * NCU * 8192 * 2;
constexpr size_t OFF_INTRA = OFF_UT + (size_t)2 * NCU * 8192 * 2;
constexpr size_t OFF_SCAL = OFF_INTRA + (size_t)2 * NCU * 4096 * 2;
constexpr size_t WS_END = OFF_SCAL + (size_t)2 * NCU * 192 * 4;
static_assert(OFF_HID + (size_t)NLAT * DFF * 2 <= WS_END, "hid overlay");
static_assert(WS_END + 16384 + 3 * 6144 * 4 + 4 * 16384 * 8 * 4 <= (size_t)256 * 1024 * 1024, "ws budget");

constexpr int LDS_BYTES = 2 * 73728 + 16;
constexpr size_t OFF_BAR = WS_END;
constexpr size_t OFF_MODZ = OFF_BAR + 16384;
constexpr size_t ZERO_BYTES = 16384 + 3 * 6144 * 4;
constexpr size_t OFF_LP = OFF_MODZ + 3 * 6144 * 4;
constexpr size_t WS_NEED = OFF_LP + (size_t)4 * NLAT * 8 * 4;


struct Params {
    const float *x, *c, *ctx, *c_ctx, *w_mod, *b_mod, *norm1_w, *w_in, *q_norm_w, *k_norm_w, *conv_w, *a_log, *dt_bias, *dn_norm_w, *w_out, *norm2_w, *w_mlp1, *w_mlp2;
    float* out; unsigned char* ws; int ph_lo, ph_hi;
};

DI void wconv_tile(const float* __restrict__ W, int K, int N, int Npad, u16* __restrict__ Wt, int tile, float* st) {
    const int ntn = Npad / 64, kt = tile / ntn, nt = tile % ntn, k0 = kt * 64, n0 = nt * 64;
    const int tid = (threadIdx.x & 255), c = tid & 63, r4 = tid >> 6;
    __syncthreads();
#pragma unroll 4
    for (int i = 0; i < 16; ++i) { const int k = i * 4 + r4, n = n0 + c; st[k * 65 + c] = (n < N) ? W[(size_t)(k0 + k) * N + n] : 0.f; }
    __syncthreads();
#pragma unroll 4
    for (int i = 0; i < 16; ++i) { const int n = i * 4 + r4; Wt[(size_t)(n0 + n) * K + k0 + c] = f2bf(st[c * 65 + n]); }
}

template <class Epi>
DI void gemm_tile(const u16* __restrict__ A, int lda, const u16* __restrict__ Bt, int ldb, int K, int m0, int n0, unsigned char* lds, Epi&& epi) {
    const int tid = (threadIdx.x & 255), lane = tid & 63, wid = tid >> 6, wr = wid >> 1, wc = wid & 1, l15 = lane & 15, quad = lane >> 4;
    u16* As = (u16*)lds; u16* Bs = (u16*)(lds + 18432);
    f32x4 acc[4][4];
#pragma unroll
    for (int m = 0; m < 4; ++m)
#pragma unroll
        for (int n = 0; n < 4; ++n) acc[m][n] = (f32x4){0.f, 0.f, 0.f, 0.f};
    u32x4 ra[4], rb[4];
    const int lrow = tid >> 3, lcc = tid & 7;
    const u16* Ap = A + (size_t)(m0 + lrow) * lda + lcc * 8;
    const u16* Bp = Bt + (size_t)(n0 + lrow) * ldb + lcc * 8;
    const int nk = K / 64;
#pragma unroll
    for (int i = 0; i < 4; ++i) { ra[i] = *(const u32x4*)(Ap + (size_t)(32 * i) * lda); rb[i] = *(const u32x4*)(Bp + (size_t)(32 * i) * ldb); }
    __syncthreads();
#pragma unroll
    for (int i = 0; i < 4; ++i) { *(u32x4*)(As + (lrow + 32 * i) * 72 + lcc * 8) = ra[i]; *(u32x4*)(Bs + (lrow + 32 * i) * 72 + lcc * 8) = rb[i]; }
#pragma unroll
    for (int i = 0; i < 4; ++i) { ra[i] = *(const u32x4*)(Ap + (size_t)(32 * i) * lda + 64); rb[i] = *(const u32x4*)(Bp + (size_t)(32 * i) * ldb + 64); }
    __syncthreads();
    for (int kt = 0; kt < nk; ++kt) {
        const u16* Ac = As + (kt & 1) * 18432; const u16* Bc = Bs + (kt & 1) * 18432;
        if (kt + 1 < nk) {
            u16* An = As + ((kt + 1) & 1) * 18432; u16* Bn = Bs + ((kt + 1) & 1) * 18432;
#pragma unroll
            for (int i = 0; i < 4; ++i) { *(u32x4*)(An + (lrow + 32 * i) * 72 + lcc * 8) = ra[i]; *(u32x4*)(Bn + (lrow + 32 * i) * 72 + lcc * 8) = rb[i]; }
        }
        if (kt + 2 < nk) {
#pragma unroll
            for (int i = 0; i < 4; ++i) { ra[i] = *(const u32x4*)(Ap + (size_t)(32 * i) * lda + (kt + 2) * 64); rb[i] = *(const u32x4*)(Bp + (size_t)(32 * i) * ldb + (kt + 2) * 64); }
        }
#pragma unroll
        for (int ks = 0; ks < 2; ++ks) {
            bf16x8 af[4], bfr[4];
#pragma unroll
            for (int m = 0; m < 4; ++m) af[m] = *(const bf16x8*)(Ac + (64 * wr + 16 * m + l15) * 72 + 32 * ks + 8 * quad);
#pragma unroll
            for (int n = 0; n < 4; ++n) bfr[n] = *(const bf16x8*)(Bc + (64 * wc + 16 * n + l15) * 72 + 32 * ks + 8 * quad);
#pragma unroll
            for (int m = 0; m < 4; ++m)
#pragma unroll
                for (int n = 0; n < 4; ++n) acc[m][n] = MFMA16(bfr[n], af[m], acc[m][n]);
        }
        __syncthreads();
    }
    epi(acc, m0 + 64 * wr, n0 + 64 * wc, l15, quad);
}

DI float silu_f(float v) { return v * __builtin_amdgcn_rcpf(1.f + __expf(-v)); }
DI int permpos(int c) { const int k = c & 31; return (c & ~31) | (8 * ((k & 15) >> 2) + 4 * (k >> 4) + (k & 3)); }
DI float wave_max(float v) {
#pragma unroll
    for (int o = 32; o > 0; o >>= 1) v = fmaxf(v, __shfl_xor(v, o));
    return v;
}
DI float wave_sum(float v) {
#pragma unroll
    for (int o = 32; o > 0; o >>= 1) v += __shfl_xor(v, o);
    return v;
}

template <class SrcF>
DI void norm_rows(SrcF srcf, int nrows, int row0, int rstride, const float* __restrict__ nw, const float* __restrict__ MOD, int shift_idx, int scale_idx, u16* __restrict__ dst, int lane) {
    f32x4 w[4], sh[4], sc[4]; int cur = -1;
    f32x4 v[4], nx[4];
    int r = row0;
    if (r < nrows) {
        const float* src = srcf(r);
#pragma unroll
        for (int i = 0; i < 4; ++i) nx[i] = *(const f32x4*)(src + 4 * lane + 256 * i);
    }
    for (; r < nrows; r += rstride) {
#pragma unroll
        for (int i = 0; i < 4; ++i) v[i] = nx[i];
        if (r + rstride < nrows) {
            const float* src = srcf(r + rstride);
#pragma unroll
            for (int i = 0; i < 4; ++i) nx[i] = *(const f32x4*)(src + 4 * lane + 256 * i);
        }
        const int which = r < NLAT ? (r >> 13) : 2;
        if (which != cur) {
            cur = which;
#pragma unroll
            for (int i = 0; i < 4; ++i) {
                const int c = 4 * lane + 256 * i;
                w[i] = *(const f32x4*)(nw + c); sh[i] = *(const f32x4*)(MOD + which * 6144 + shift_idx * 1024 + c); sc[i] = *(const f32x4*)(MOD + which * 6144 + scale_idx * 1024 + c);
                w[i] = w[i] * (sc[i] + 1.f);
            }
        }
        float ss = 0.f;
#pragma unroll
        for (int i = 0; i < 4; ++i) ss += v[i][0] * v[i][0] + v[i][1] * v[i][1] + v[i][2] * v[i][2] + v[i][3] * v[i][3];
        ss = wave_sum(ss);
        const float rinv = rsqrtf(ss * (1.f / 1024.f) + EPS);
#pragma unroll
        for (int i = 0; i < 4; ++i) {
            const f32x4 yv = v[i] * rinv * w[i] + sh[i];
            u32x2 o = {pk2(yv[0], yv[1]), pk2(yv[2], yv[3])};
            *(u32x2*)(dst + (size_t)r * DM + 4 * lane + 256 * i) = o;
        }
    }
}

DI void gdn_prep_unit(const Params& p, int unit, unsigned char* lds) {
    int tid_in = (threadIdx.x & 255); asm volatile("" : "+v"(tid_in));
    const int tid = tid_in, lane = tid & 63, wid = tid >> 6, l15 = lane & 15, quad = lane >> 4;
    const int h = unit & 3, bc = unit >> 2, b = bc / NCK, ck = bc % NCK;
    const bool isctx = ck < 4;
    const int seqlen = isctx ? CTXL : SEQ;
    const int c0 = isctx ? ck * 64 : (ck - 4) * 64;
    const int rowbase = isctx ? (NLAT + b * CTXL) : b * SEQ;
    unsigned char* ws = p.ws;
    const u16* DQ = (const u16*)(ws + OFF_DQKV);
    const float* GT = (const float*)(ws + OFF_GATE);
    u16* Qs = (u16*)lds; u16* Ks = (u16*)(lds + 17408); float* stage = (float*)(lds + 34816);
    float* gs = (float*)(lds + 67840); float* gcs = (float*)(lds + 71936); float* rbs = (float*)(lds + 72448); float* rbe = (float*)(lds + 72960); float* rn = (float*)(lds + 73472);
    u16* QNg = (u16*)(ws + OFF_QN) + (size_t)unit * 8192;
    u16* KNTg = (u16*)(ws + OFF_KNT) + (size_t)unit * 8192;
    __syncthreads();
    {
        const int t = tid >> 2, q4 = tid & 3;
        *(f32x4*)(gs + t * 16 + q4 * 4) = *(const f32x4*)(GT + (size_t)(rowbase + c0 + t) * 16 + q4 * 4);
    }
    const int cch = tid & 127, th = tid >> 7;
    float* part = rbs;
    u32x4 rawreg[5];
    auto raw_fetch = [&](int wh) {
#pragma unroll
        for (int i = 0; i < 5; ++i) {
            const int idx = tid + 256 * i; const int row = idx >> 4, cc = idx & 15, s = c0 - 2 + row;
            u32x4 v = {0u, 0u, 0u, 0u};
            if (idx < 68 * 16 && s >= 0 && s < seqlen) v = *(const u32x4*)(DQ + (size_t)(rowbase + s) * 1536 + wh * 512 + h * 128 + cc * 8);
            rawreg[i] = v;
        }
    };
    raw_fetch(2);
#pragma unroll 1
    for (int wi = 0; wi < 3; ++wi) {
        const int which = wi == 0 ? 2 : wi - 1;
        if (isctx && wi == 1) continue;
        u16* raw = (wi == 0) ? Qs : Ks;
        __syncthreads();
#pragma unroll
        for (int i = 0; i < 5; ++i) {
            const int idx = tid + 256 * i;
            if (idx < 68 * 16) { const int row = idx >> 4, cc = idx & 15; *(u32x4*)(raw + row * 128 + cc * 8) = rawreg[i]; }
        }
        if (wi < 2) raw_fetch((isctx || wi == 1) ? 1 : 0);
        const int col = which * 512 + h * 128 + cch;
        const float w0 = p.conv_w[0 * 1536 + col], w1 = p.conv_w[1 * 1536 + col], w2 = p.conv_w[2 * 1536 + col], w3 = p.conv_w[3 * 1536 + col], w4 = p.conv_w[4 * 1536 + col];
        __syncthreads();
        float y[32];
        {
            const u16* rp = raw + (32 * th) * 128 + cch;
            float xa = bf2f(rp[0]), xb = bf2f(rp[128]), xc = bf2f(rp[256]), xd = bf2f(rp[384]);
#pragma unroll
            for (int i = 0; i < 32; ++i) {
                const float xe = bf2f(rp[(i + 4) * 128]);
                y[i] = silu_f(w0 * xa + w1 * xb + w2 * xc + w3 * xd + w4 * xe);
                xa = xb; xb = xc; xc = xd; xd = xe;
            }
        }
        if (which == 2) {
#pragma unroll
            for (int i = 0; i < 32; ++i) stage[(32 * th + i) * 129 + cch] = y[i];
        } else {
            float mine = 0.f;
#pragma unroll
            for (int i = 0; i < 32; ++i) { const float ssum = wave_sum(y[i] * y[i]); if (lane == i) mine = ssum; }
            if (lane < 32) part[wid * 32 + lane] = mine;
            __syncthreads();
            if (which == 0) {
#pragma unroll
                for (int i = 0; i < 32; ++i) {
                    const int t = 32 * th + i; const float rinv = rsqrtf(part[(2 * th) * 32 + i] + part[(2 * th + 1) * 32 + i] + EPS);
                    const u16 v = f2bf(y[i] * rinv); Qs[t * 136 + cch] = v; QNg[t * 128 + permpos(cch)] = v;
                }
            } else {
                unsigned pkd[16];
#pragma unroll
                for (int i = 0; i < 16; ++i) {
                    const int t = 32 * th + 2 * i;
                    const float r0 = rsqrtf(part[(2 * th) * 32 + 2 * i] + part[(2 * th + 1) * 32 + 2 * i] + EPS), r1 = rsqrtf(part[(2 * th) * 32 + 2 * i + 1] + part[(2 * th + 1) * 32 + 2 * i + 1] + EPS);
                    const unsigned v = pk2(y[2 * i] * r0, y[2 * i + 1] * r1); pkd[i] = v;
                    Ks[t * 136 + cch] = (u16)(v & 0xffffu); Ks[(t + 1) * 136 + cch] = (u16)(v >> 16);
                }
#pragma unroll
                for (int i = 0; i < 4; ++i) { u32x4 v = {pkd[2 * i], pkd[2 * i + 1], pkd[8 + 2 * i], pkd[8 + 2 * i + 1]}; *(u32x4*)(KNTg + cch * 64 + 32 * th + 8 * i) = v; }
            }
        }
    }
    __syncthreads();
    int unit_l = unit, tid_l = tid_in;
    asm volatile("" : "+s"(unit_l)); asm volatile("" : "+v"(tid_l));
    {
    const int unit = unit_l, tid = tid_l, lane = tid & 63, wid = tid >> 6, l15 = lane & 15, quad = lane >> 4;
    if (tid < 128) {
        const int d = tid >> 6, t = tid & 63; float s = 0.f;
        if (d == 0) { for (int u = 0; u <= t; ++u) s += gs[u * 16 + 8 + h]; }
        else        { for (int u = t; u < 64; ++u) s += gs[u * 16 + 12 + h]; }
        gcs[d * 64 + t] = s;
    }
    __syncthreads();
    if (tid < 128) {
        const int d = tid >> 6, t = tid & 63;
        const float gc = gcs[d * 64 + t], gl = gcs[d * 64 + (d ? 0 : 63)], be = gs[t * 16 + d * 4 + h];
        rbs[d * 64 + t] = be; rbe[d * 64 + t] = be * __expf(gc);
        float* SC = (float*)(ws + OFF_SCAL) + ((size_t)d * NCU + unit) * 192;
        SC[t] = __expf(gc) * 0.08838834764831845f; SC[64 + t] = __expf(gl - gc);
        if (t == 0) SC[128] = __expf(gl);
    }
    if (!isctx) {
        f32x4 QK[4];
#pragma unroll
        for (int n = 0; n < 4; ++n) QK[n] = (f32x4){0.f, 0.f, 0.f, 0.f};
#pragma unroll
        for (int ks = 0; ks < 4; ++ks) {
            const bf16x8 aq = *(const bf16x8*)(Qs + (16 * wid + l15) * 136 + 32 * ks + 8 * quad);
#pragma unroll
            for (int n = 0; n < 4; ++n) {
                const bf16x8 bb = *(const bf16x8*)(Ks + (16 * n + l15) * 136 + 32 * ks + 8 * quad);
                QK[n] = MFMA16(aq, bb, QK[n]);
            }
        }
#pragma unroll
        for (int d = 0; d < 2; ++d) {
            u16* INg = (u16*)(ws + OFF_INTRA) + ((size_t)d * NCU + unit) * 4096;
#pragma unroll
            for (int n = 0; n < 4; ++n)
#pragma unroll
                for (int r = 0; r < 4; ++r) {
                    const int i = 16 * wid + 4 * quad + r, j = 16 * n + l15;
                    const bool keep = d ? (j >= i) : (j <= i);
                    const float iv = keep ? QK[n][r] * 0.08838834764831845f * __expf(gcs[d * 64 + i] - gcs[d * 64 + j]) : 0.f;
                    INg[i * 64 + permpos(j)] = f2bf(iv);
                }
        }
    }
    __syncthreads();
    {
        f32x4 G[4];
#pragma unroll
        for (int n = 0; n < 4; ++n) G[n] = (f32x4){0.f, 0.f, 0.f, 0.f};
#pragma unroll
        for (int ks = 0; ks < 4; ++ks) {
            const bf16x8 ak = *(const bf16x8*)(Ks + (16 * wid + l15) * 136 + 32 * ks + 8 * quad);
#pragma unroll
            for (int n = 0; n < 4; ++n) {
                const bf16x8 bb = *(const bf16x8*)(Ks + (16 * n + l15) * 136 + 32 * ks + 8 * quad);
                G[n] = MFMA16(ak, bb, G[n]);
            }
        }
        const int dd = __builtin_amdgcn_readfirstlane(tid >> 7), cc = tid & 127;
        float xwp[64];
#pragma unroll
        for (int ip = 0; ip < 64; ++ip) xwp[ip] = 0.f;
        if (dd == 0) {
#pragma unroll
            for (int ip = 0; ip < 64; ++ip) xwp[ip] = bf2f(Ks[ip * 136 + cc]) * rbe[ip];
        } else {
#pragma unroll
            for (int ip = 0; ip < 64; ++ip) xwp[ip] = bf2f(Ks[(63 - ip) * 136 + cc]) * rbe[64 + 63 - ip];
        }
        asm volatile("" ::: "memory");
        __syncthreads();
        float* Ls0 = (float*)lds; float* Ls1 = (float*)(lds + 17408);
#pragma unroll
        for (int d = 0; d < 2; ++d)
#pragma unroll
            for (int n = 0; n < 4; ++n)
#pragma unroll
                for (int r = 0; r < 4; ++r) {
                    const int i = 16 * wid + 4 * quad + r, j = 16 * n + l15;
                    const int ip = d ? 63 - i : i, jp = d ? 63 - j : j;
                    if (jp < ip) (d ? Ls1 : Ls0)[ip * 64 + jp] = rbs[d * 64 + i] * G[n][r] * __expf(gcs[d * 64 + i] - gcs[d * 64 + j]);
                }
        __syncthreads();
        const float* Lsel = dd ? Ls1 : Ls0;
        f2_t x2[64];
#pragma unroll
        for (int ip = 0; ip < 64; ++ip) x2[ip] = (f2_t){0.f, xwp[ip]};
        if (dd == 0) {
#pragma unroll
            for (int ip = 0; ip < 64; ++ip) x2[ip].x = stage[ip * 129 + cc] * rbs[ip];
        } else {
#pragma unroll
            for (int ip = 0; ip < 64; ++ip) x2[ip].x = stage[(63 - ip) * 129 + cc] * rbs[64 + 63 - ip];
        }
        asm volatile("" ::: "memory");
#pragma unroll
        for (int ip = 0; ip < 64; ++ip) {
            f2_t a2 = x2[ip];
#pragma unroll
            for (int jp = 0; jp < ip; ++jp) { const float l = Lsel[ip * 64 + jp]; a2 -= x2[jp] * l; if ((jp & 15) == 15) asm volatile("" ::: "memory"); }
            x2[ip] = a2;
            asm volatile("" ::: "memory");
        }
        {
            int unit_o = unit, cc_o = cc; asm volatile("" : "+s"(unit_o)); asm volatile("" : "+v"(cc_o));
            u16* WNg = (u16*)(ws + OFF_WNEG) + ((size_t)dd * NCU + unit_o) * 8192 + permpos(cc_o);
#pragma unroll
            for (int ip = 0; ip < 1; ++ip) {}
            if (dd == 0) {
#pragma unroll
                for (int ip = 0; ip < 64; ++ip) { WNg[ip * 128] = f2bf(-x2[ip].y); if ((ip & 7) == 7) asm volatile("" ::: "memory"); }
            } else {
#pragma unroll
                for (int ip = 0; ip < 64; ++ip) { WNg[(63 - ip) * 128] = f2bf(-x2[ip].y); if ((ip & 7) == 7) asm volatile("" ::: "memory"); }
            }
            asm volatile("" ::: "memory");
            u16* UTg = (u16*)(ws + OFF_UT) + ((size_t)dd * NCU + unit_o) * 8192 + cc_o * 64;
            if (dd == 0) {
#pragma unroll
                for (int i = 0; i < 8; ++i) { u32x4 v = {pk2(x2[8 * i].x, x2[8 * i + 1].x), pk2(x2[8 * i + 2].x, x2[8 * i + 3].x), pk2(x2[8 * i + 4].x, x2[8 * i + 5].x), pk2(x2[8 * i + 6].x, x2[8 * i + 7].x)}; *(u32x4*)(UTg + 8 * i) = v; }
            } else {
#pragma unroll
                for (int i = 0; i < 8; ++i) { u32x4 v = {pk2(x2[63 - 8 * i].x, x2[62 - 8 * i].x), pk2(x2[61 - 8 * i].x, x2[60 - 8 * i].x), pk2(x2[59 - 8 * i].x, x2[58 - 8 * i].x), pk2(x2[57 - 8 * i].x, x2[56 - 8 * i].x)}; *(u32x4*)(UTg + 8 * i) = v; }
            }
        }
        __syncthreads();
    }
    }
}

DI void gdn_scan_block(const Params& p, int sb, unsigned char* lds0, unsigned char* lds1, int role) {
    const int tid = (threadIdx.x & 255), lane = tid & 63, wid = tid >> 6, l15 = lane & 15, quad = lane >> 4;
    const int chain = sb >> 1, half = sb & 1, b = chain >> 3, h = (chain >> 1) & 3, d = chain & 1, slice = half * 4 + wid;
    unsigned char* ws = p.ws;
    if (role == 1) {
        u32x4 pre[16]; float presc = 0.f;
        auto issue = [&](int step) {
            const int ck = d ? (step < 4 ? 3 - step : 135 - step) : step;
            const size_t cu = (size_t)(b * NCK + ck) * 4 + h, dcu = (size_t)d * NCU + cu;
            const u32x4* WN = (const u32x4*)(ws + OFF_WNEG + dcu * 16384);
            const u32x4* QN = (const u32x4*)(ws + OFF_QN + cu * 16384);
            const u32x4* KT = (const u32x4*)(ws + OFF_KNT + cu * 16384);
            const u32x4* IN = (const u32x4*)(ws + OFF_INTRA + dcu * 8192);
            const u32x4* UT = (const u32x4*)(ws + OFF_UT + dcu * 16384 + (size_t)half * 8192);
            const float* SC = (const float*)(ws + OFF_SCAL) + dcu * 192;
#pragma unroll
            for (int i = 0; i < 4; ++i) { pre[i] = WN[tid + 256 * i]; pre[4 + i] = QN[tid + 256 * i]; pre[8 + i] = KT[tid + 256 * i]; }
#pragma unroll
            for (int i = 0; i < 2; ++i) { pre[12 + i] = IN[tid + 256 * i]; pre[14 + i] = UT[tid + 256 * i]; }
            if (tid < 192) presc = SC[tid];
        };
        auto commit = [&](unsigned char* L) {
#pragma unroll
            for (int i = 0; i < 4; ++i) {
                const int r16 = (tid >> 4) + 16 * i, c16 = tid & 15;
                *(u32x4*)(L + r16 * 272 + c16 * 16) = pre[i];
                *(u32x4*)(L + 17408 + r16 * 272 + c16 * 16) = pre[4 + i];
                const int r8 = (tid >> 3) + 32 * i, c8 = tid & 7;
                *(u32x4*)(L + 34816 + r8 * 144 + c8 * 16) = pre[8 + i];
            }
#pragma unroll
            for (int i = 0; i < 2; ++i) {
                const int r8 = (tid >> 3) + 32 * i, c8 = tid & 7;
                *(u32x4*)(L + 53248 + r8 * 144 + c8 * 16) = pre[12 + i];
                *(u32x4*)(L + 62464 + r8 * 144 + c8 * 16) = pre[14 + i];
            }
            if (tid < 192) ((float*)(L + 71680))[tid] = presc;
        };
        issue(0); commit(lds0); issue(1);
        __syncthreads();
        for (int step = 0; step < NCK; ++step) {
            if (step + 1 < NCK) { commit(((step + 1) & 1) ? lds1 : lds0); if (step + 2 < NCK) issue(step + 2); }
            __syncthreads();
        }
        return;
    }
    f32x4 S[8];
#pragma unroll
    for (int i = 0; i < 8; ++i) S[i] = (f32x4){0.f, 0.f, 0.f, 0.f};
    u16* Og = (u16*)(ws + OFF_O01) + (size_t)d * NLAT * 512;
    __syncthreads();
    for (int step = 0; step < NCK; ++step) {
        const int ck = d ? (step < 4 ? 3 - step : 135 - step) : step;
        const bool isctx = ck < 4;
        const unsigned char* L = (step & 1) ? lds1 : lds0;
        const u16* WNl = (const u16*)L; const u16* QNl = (const u16*)(L + 17408); const u16* KTl = (const u16*)(L + 34816); const u16* INl = (const u16*)(L + 53248); const u16* UTl = (const u16*)(L + 62464); const float* SCl = (const float*)(L + 71680);
        bf16x8 Sb[4];
#pragma unroll
        for (int ks = 0; ks < 4; ++ks) Sb[ks] = mk8(pk2(S[2 * ks][0], S[2 * ks][1]), pk2(S[2 * ks][2], S[2 * ks][3]), pk2(S[2 * ks + 1][0], S[2 * ks + 1][1]), pk2(S[2 * ks + 1][2], S[2 * ks + 1][3]));
        f32x4 vn[4], o[4];
#pragma unroll
        for (int mt = 0; mt < 4; ++mt) {
            const u32x2 raw = *(const u32x2*)(UTl + (16 * wid + l15) * 72 + 16 * mt + 4 * quad);
            vn[mt] = (f32x4){bflo(raw.x), bfhi(raw.x), bflo(raw.y), bfhi(raw.y)};
#pragma unroll
            for (int ks = 0; ks < 4; ++ks) {
                const bf16x8 a = *(const bf16x8*)(WNl + (16 * mt + l15) * 136 + 32 * ks + 8 * quad);
                vn[mt] = MFMA16(a, Sb[ks], vn[mt]);
            }
        }
        if (!isctx) {
#pragma unroll
            for (int mt = 0; mt < 4; ++mt) {
                o[mt] = (f32x4){0.f, 0.f, 0.f, 0.f};
#pragma unroll
                for (int ks = 0; ks < 4; ++ks) {
                    const bf16x8 a = *(const bf16x8*)(QNl + (16 * mt + l15) * 136 + 32 * ks + 8 * quad);
                    o[mt] = MFMA16(a, Sb[ks], o[mt]);
                }
                const f32x4 qs = *(const f32x4*)(SCl + 16 * mt + 4 * quad);
                o[mt] = o[mt] * qs;
            }
        }
        bf16x8 vb[2], vsb[2];
        {
            f32x4 kc[4];
#pragma unroll
            for (int mt = 0; mt < 4; ++mt) kc[mt] = *(const f32x4*)(SCl + 64 + 16 * mt + 4 * quad);
#pragma unroll
            for (int k2 = 0; k2 < 2; ++k2) {
                const f32x4 a = vn[2 * k2], c = vn[2 * k2 + 1];
                vb[k2] = mk8(pk2(a[0], a[1]), pk2(a[2], a[3]), pk2(c[0], c[1]), pk2(c[2], c[3]));
                const f32x4 as = a * kc[2 * k2], cs = c * kc[2 * k2 + 1];
                vsb[k2] = mk8(pk2(as[0], as[1]), pk2(as[2], as[3]), pk2(cs[0], cs[1]), pk2(cs[2], cs[3]));
            }
        }
        const float egl = SCl[128];
#pragma unroll
        for (int st = 0; st < 8; ++st) {
            S[st] = S[st] * egl;
#pragma unroll
            for (int k2 = 0; k2 < 2; ++k2) {
                const bf16x8 a = *(const bf16x8*)(KTl + (16 * st + l15) * 72 + 32 * k2 + 8 * quad);
                S[st] = MFMA16(a, vsb[k2], S[st]);
            }
        }
        if (!isctx) {
            const int tok0 = b * SEQ + (ck - 4) * 64;
#pragma unroll
            for (int mt = 0; mt < 4; ++mt) {
#pragma unroll
                for (int k2 = 0; k2 < 2; ++k2) {
                    const bf16x8 a = *(const bf16x8*)(INl + (16 * mt + l15) * 72 + 32 * k2 + 8 * quad);
                    o[mt] = MFMA16(a, vb[k2], o[mt]);
                }
#pragma unroll
                for (int r = 0; r < 4; ++r) Og[(size_t)(tok0 + 16 * mt + 4 * quad + r) * 512 + h * 128 + 16 * slice + l15] = f2bf(o[mt][r]);
            }
        }
        __syncthreads();
    }
}

template <bool SHIFT>
DI void attn_unit(const Params& p, int P, int half, unsigned char* lds, float Mb) {
    const int tid = (threadIdx.x & 255), lane = tid & 63, wid = tid >> 6, l31 = lane & 31, hh = lane >> 5;
    const int kh = P & 3, qb = 2 * ((P >> 2) & 63) + half, bk = P >> 8, b = bk >> 1, kvh = bk & 1, head = kvh * 4 + wid;
    unsigned char* ws = p.ws;
    const u16* MIX = (const u16*)(ws + OFF_MIX);
    constexpr int NT = SKV / 64 / 4;
    const u16* Kg = (const u16*)(ws + OFF_K) + (size_t)bk * SKV * 64 + (size_t)kh * NT * 64 * 64;
    const u16* Vg = (const u16*)(ws + OFF_VT) + (size_t)bk * 64 * SKV + (size_t)kh * NT * 64;
    u16* Kl = (u16*)lds; u16* Vl = (u16*)(lds + 36864);
    const int tokA = b * SEQ + qb * 64 + l31;
    const size_t qrowA = (size_t)tokA * DM + head * 64, qrowB = qrowA + (size_t)32 * DM;
    bf16x8 qfA[4], qfB[4];
#pragma unroll
    for (int ks = 0; ks < 4; ++ks) { qfA[ks] = *(const bf16x8*)(MIX + qrowA + 16 * ks + 8 * hh); qfB[ks] = *(const bf16x8*)(MIX + qrowB + 16 * ks + 8 * hh); }
    f32x16 o0A, o1A, o0B, o1B; f2_t l2A = {0.f, 0.f}, l2B = {0.f, 0.f};
#pragma unroll
    for (int i = 0; i < 16; ++i) { o0A[i] = 0.f; o1A[i] = 0.f; o0B[i] = 0.f; o1B[i] = 0.f; }
    const bf16x8 ones = mk8(0x3f803f80u, 0x3f803f80u, 0x3f803f80u, 0x3f803f80u);
    int t5_ = (int)threadIdx.x; asm volatile("" : "+v"(t5_));
    const int lrow = t5_ >> 3, lcc = t5_ & 7;
    u32x4 rk, rv;
    {
        const u32x4 k0 = *(const u32x4*)(Kg + (size_t)lrow * 64 + lcc * 8), v0 = *(const u32x4*)(Vg + (size_t)lrow * SKV + lcc * 8);
        rk = *(const u32x4*)(Kg + (size_t)(64 + lrow) * 64 + lcc * 8); rv = *(const u32x4*)(Vg + (size_t)lrow * SKV + 64 + lcc * 8);
        __syncthreads();
        *(u32x4*)(Kl + lrow * 72 + lcc * 8) = k0; *(u32x4*)(Vl + lrow * 72 + lcc * 8) = v0;
    }
    __syncthreads();
    for (int kt = 0; kt < NT; ++kt) {
        const u16* Kc = Kl + (kt & 1) * 9216; const u16* Vc = Vl + (kt & 1) * 9216;
        if (kt + 1 < NT) {
            u16* Kn = Kl + ((kt + 1) & 1) * 9216; u16* Vn = Vl + ((kt + 1) & 1) * 9216;
            *(u32x4*)(Kn + lrow * 72 + lcc * 8) = rk; *(u32x4*)(Vn + lrow * 72 + lcc * 8) = rv;
        }
        if (kt + 2 < NT) { rk = *(const u32x4*)(Kg + (size_t)((kt + 2) * 64 + lrow) * 64 + lcc * 8); rv = *(const u32x4*)(Vg + (size_t)lrow * SKV + (kt + 2) * 64 + lcc * 8); }
#pragma unroll
        for (int sub = 0; sub < 2; ++sub) {
            f32x16 sA, sB;
#pragma unroll
            for (int i = 0; i < 16; ++i) { sA[i] = SHIFT ? -Mb : 0.f; sB[i] = SHIFT ? -Mb : 0.f; }
#pragma unroll
            for (int ks = 0; ks < 4; ++ks) {
                const bf16x8 kf = *(const bf16x8*)(Kc + (sub * 32 + l31) * 72 + 16 * ks + 8 * hh);
                sA = MFMA32(kf, qfA[ks], sA); sB = MFMA32(kf, qfB[ks], sB);
            }
#pragma unroll
            for (int i = 0; i < 16; ++i) { sA[i] = __builtin_amdgcn_exp2f(sA[i]); sB[i] = __builtin_amdgcn_exp2f(sB[i]); }
#pragma unroll
            for (int i = 0; i < 8; ++i) { l2A += (f2_t){sA[2 * i], sA[2 * i + 1]}; l2B += (f2_t){sB[2 * i], sB[2 * i + 1]}; }
#pragma unroll
            for (int sp = 0; sp < 2; ++sp) {
                const bf16x8 pA = mk8(pk2(sA[8 * sp], sA[8 * sp + 1]), pk2(sA[8 * sp + 2], sA[8 * sp + 3]), pk2(sA[8 * sp + 4], sA[8 * sp + 5]), pk2(sA[8 * sp + 6], sA[8 * sp + 7]));
                const bf16x8 pB = mk8(pk2(sB[8 * sp], sB[8 * sp + 1]), pk2(sB[8 * sp + 2], sB[8 * sp + 3]), pk2(sB[8 * sp + 4], sB[8 * sp + 5]), pk2(sB[8 * sp + 6], sB[8 * sp + 7]));
                const u16* v0 = Vc + l31 * 72 + sub * 32 + 16 * sp + 4 * hh;
                const bf16x8 vf0 = mk8(*(const u32x2*)v0, *(const u32x2*)(v0 + 8));
                const bf16x8 vf1 = mk8(*(const u32x2*)(v0 + 32 * 72), *(const u32x2*)(v0 + 32 * 72 + 8));
                o0A = MFMA32(vf0, pA, o0A); o0B = MFMA32(vf0, pB, o0B); o1A = MFMA32(vf1, pA, o1A); o1B = MFMA32(vf1, pB, o1B);
            }
        }
        __syncthreads();
    }
    float* LP = (float*)(ws + OFF_LP) + (size_t)kh * NLAT * 8;
    float lsA = l2A.x + l2A.y, lsB = l2B.x + l2B.y; lsA += __shfl_xor(lsA, 32); lsB += __shfl_xor(lsB, 32);
    int lane_o = lane; asm volatile("" : "+v"(lane_o));
    const int tokO = b * SEQ + qb * 64 + (lane_o & 31);
    if (hh == 0) { LP[(size_t)tokO * 8 + head] = lsA; LP[(size_t)(tokO + 32) * 8 + head] = lsB; }
    u16* OPA = (u16*)p.out + (size_t)kh * NLAT * 512 + (size_t)tokO * 512 + head * 64;
    u16* OPB = OPA + (size_t)32 * 512;
#pragma unroll
    for (int g = 0; g < 4; ++g) {
        { u32x2 w0 = {pk2(o0A[4 * g], o0A[4 * g + 1]), pk2(o0A[4 * g + 2], o0A[4 * g + 3])}; u32x2 w1 = {pk2(o1A[4 * g], o1A[4 * g + 1]), pk2(o1A[4 * g + 2], o1A[4 * g + 3])};
          *(u32x2*)(OPA + 8 * g + 4 * hh) = w0; *(u32x2*)(OPA + 32 + 8 * g + 4 * hh) = w1; }
        { u32x2 w0 = {pk2(o0B[4 * g], o0B[4 * g + 1]), pk2(o0B[4 * g + 2], o0B[4 * g + 3])}; u32x2 w1 = {pk2(o1B[4 * g], o1B[4 * g + 1]), pk2(o1B[4 * g + 2], o1B[4 * g + 3])};
          *(u32x2*)(OPB + 8 * g + 4 * hh) = w0; *(u32x2*)(OPB + 32 + 8 * g + 4 * hh) = w1; }
    }
}

namespace pg8 {
#define PG8_LAS __attribute__((address_space(3)))
typedef unsigned short bf16_t;
typedef short bf16x8 __attribute__((ext_vector_type(8)));
typedef float f32x4 __attribute__((ext_vector_type(4)));
typedef unsigned u32x4 __attribute__((ext_vector_type(4)));
constexpr int BM = 256, BK = 64, HALF = 128, HTB = HALF * BK * 2  , STAGE_BYTES = 8 * HTB, NXCD = 8, WGM = 8;

__host__ __device__ __forceinline__ int lds_byte(int r, int c) { const int st = (r >> 4) * 2 + (c >> 5), rr = r & 15, cc = c & 31, ob = rr * 64 + cc * 2; return st * 1024 + (ob ^ (((ob >> 9) & 1) << 5)); }
__host__ __device__ __forceinline__ void stage_rc(int b, int& R, int& C) { const int st = b / 1024, sb = b % 1024, swz = sb ^ (((sb >> 9) & 1) << 5); R = (st >> 1) * 16 + swz / 64; C = (st & 1) * 32 + (swz % 64) / 2; }
__host__ __device__ __forceinline__ int perm32(int rho) { const int n = rho >> 4, i = rho & 15; return 8 * (i >> 2) + 4 * n + (i & 3); }

struct Unit { int pm, pn; };
struct Gemm { const bf16_t* A; const bf16_t* Bt; int M, N, K; };

struct StaticOrder {
    int nM, nN, nwg, G, c;
    __host__ __device__ void init(int M, int N, int G_, int c_) { nM = M / BM; nN = N / BM; nwg = nM * nN; G = G_; c = c_; }
    __host__ __device__ bool next(int i, Unit& u) const {
        const long L = (long)i * G + c; if (L >= nwg) return false;
        int wgid = (int)L; { const int q = nwg / NXCD, r = nwg % NXCD, xcd = wgid % NXCD, off = wgid / NXCD; wgid = (xcd < r ? xcd * (q + 1) : r * (q + 1) + (xcd - r) * q) + off; }
        const int nig = WGM * nN, gid = wgid / nig, fm = gid * WGM, gsz = (nM - fm) < WGM ? (nM - fm) : WGM;
        u.pm = fm + ((wgid % nig) % gsz); u.pn = (wgid % nig) / gsz; return true;
    }
    __device__ __forceinline__ void a_ready(const Unit&) const {}
    __device__ __forceinline__ void done(const Unit&) const {}
};


template <class Epi, class Sched, bool ALIGN_EPI = false, bool SP2 = false>
__device__ __forceinline__ void gemm_phase(PG8_LAS unsigned char* lds, const Gemm g, const Sched& S, const Epi& E) {
    const int tid = threadIdx.x, wid = __builtin_amdgcn_readfirstlane(tid >> 6), lane = tid & 63, wr = wid >> 2, wc = wid & 3, fr = lane & 15, fq = lane >> 4;
    const int K = g.K, nt = K / BK;
    unsigned voffA[2], voffB[2];
#pragma unroll
    for (int i = 0; i < 2; ++i) { int R, C; stage_rc(tid * 16 + i * 8192, R, C); const int Rb = Epi::PERM ? ((R & ~31) + perm32(R & 31)) : R;
        voffA[i] = (unsigned)(R * K + C) * 2u; voffB[i] = (unsigned)(Rb * K + C) * 2u; }
    const size_t kstep = (size_t)(BK * 2);
    const size_t hstep = (size_t)HALF * K * 2;
    const size_t tstep = 2 * hstep;
    const unsigned ldsw = (unsigned)wid * 1024u;
    const int aoff = lds_byte(wr * 64 + fr, fq * 8), boff = lds_byte(wc * 32 + fr, fq * 8);
#define PG8_SA(b, h) (((b) * 2 + (h)) * HTB)
#define PG8_SB(b, h) ((4 + (b) * 2 + (h)) * HTB)
#define PG8_STAGE(bufoff, gbase, voff) do { _Pragma("unroll") for (int _i = 0; _i < 2; ++_i) \
        __builtin_amdgcn_global_load_lds((const unsigned*)((const char*)(gbase) + (voff)[_i]), (PG8_LAS unsigned*)(lds + (bufoff) + ldsw + _i * 8192), 16, 0, 0); } while (0)
#define PG8_LDA(dst, b, h) do { _Pragma("unroll") for (int m = 0; m < 4; ++m) _Pragma("unroll") for (int k = 0; k < 2; ++k) dst[m][k] = *(const PG8_LAS bf16x8*)(lds + PG8_SA(b, h) + aoff + m * 2048 + k * 1024); } while (0)
#define PG8_LDB(dst, b, h) do { _Pragma("unroll") for (int n = 0; n < 2; ++n) _Pragma("unroll") for (int k = 0; k < 2; ++k) dst[n][k] = *(const PG8_LAS bf16x8*)(lds + PG8_SB(b, h) + boff + n * 2048 + k * 1024); } while (0)
#define PG8_MMA(ai, bj, At, Bt) do { __builtin_amdgcn_s_setprio(1); _Pragma("unroll") for (int m = 0; m < 4; ++m) _Pragma("unroll") for (int n = 0; n < 2; ++n) _Pragma("unroll") for (int k = 0; k < 2; ++k) \
        acc[ai][bj][m][n] = __builtin_amdgcn_mfma_f32_16x16x32_bf16(Bt[n][k], At[m][k], acc[ai][bj][m][n], 0, 0, 0); __builtin_amdgcn_s_setprio(0); } while (0)
#define PG8_WAIT_V(n) asm volatile("s_waitcnt vmcnt(" #n ")" ::: "memory")
#define PG8_WAIT_L(n) asm volatile("s_waitcnt lgkmcnt(" #n ")" ::: "memory")
#define PG8_BAR __builtin_amdgcn_s_barrier()
#define PG8_SCHED __builtin_amdgcn_sched_barrier(0)
    Unit cur, nxt; int ui = 0;
    if (!S.next(0, cur)) return;
    f32x4 acc[2][2][4][2];
#pragma unroll
    for (int a = 0; a < 2; ++a)
#pragma unroll
        for (int b = 0; b < 2; ++b)
#pragma unroll
            for (int m = 0; m < 4; ++m)
#pragma unroll
                for (int n = 0; n < 2; ++n) acc[a][b][m][n] = (f32x4){0.f, 0.f, 0.f, 0.f};
    bf16x8 At[4][2], B0[2][2], B1[2][2];
    const char* cA = (const char*)g.A + (size_t)cur.pm * tstep; const char* cB = (const char*)g.Bt + (size_t)cur.pn * tstep;
    S.a_ready(cur);
    if constexpr (SP2) {
        PG8_STAGE(PG8_SB(0, 0), cB, voffB); PG8_STAGE(PG8_SB(0, 1), cB + hstep, voffB); PG8_STAGE(PG8_SA(0, 0), cA, voffA); PG8_STAGE(PG8_SA(0, 1), cA + hstep, voffA);
        if (wr == 1) PG8_BAR;
        PG8_WAIT_V(2); PG8_BAR;
        PG8_STAGE(PG8_SB(1, 0), cB + kstep, voffB); PG8_STAGE(PG8_SA(1, 0), cA + kstep, voffA); PG8_STAGE(PG8_SB(1, 1), cB + hstep + kstep, voffB);
        PG8_WAIT_V(6); PG8_BAR;
    } else {
        PG8_STAGE(PG8_SB(0, 0), cB, voffB); PG8_STAGE(PG8_SA(0, 0), cA, voffA); PG8_STAGE(PG8_SB(0, 1), cB + hstep, voffB); PG8_STAGE(PG8_SA(0, 1), cA + hstep, voffA);
        if (wr == 1) PG8_BAR;
        PG8_WAIT_V(4); PG8_BAR;
        PG8_STAGE(PG8_SB(1, 0), cB + kstep, voffB); PG8_STAGE(PG8_SA(1, 0), cA + kstep, voffA); PG8_STAGE(PG8_SB(1, 1), cB + hstep + kstep, voffB);
        PG8_WAIT_V(6); PG8_BAR;
    }
    for (;;) {
        const bool has_next = S.next(ui + 1, nxt);
        const char* nA = has_next ? (const char*)g.A + (size_t)nxt.pm * tstep : cA; const char* nB = has_next ? (const char*)g.Bt + (size_t)nxt.pn * tstep : cB;
        for (int t = 0; t < nt; t += 2) {
            const bool last = (t == nt - 2);
            const char* a1 = cA + (size_t)(t + 1) * kstep;
            const char* a2 = last ? nA : cA + (size_t)(t + 2) * kstep; const char* b2 = last ? nB : cB + (size_t)(t + 2) * kstep;
            const char* a3 = a2 + kstep; const char* b3 = b2 + kstep;
            if (last && has_next) S.a_ready(nxt);
            if constexpr (SP2) {
            PG8_LDB(B0, 0, 0); PG8_LDB(B1, 0, 1); PG8_SCHED; PG8_LDA(At, 0, 0); PG8_STAGE(PG8_SA(1, 1), a1 + hstep, voffA);
            PG8_WAIT_V(8); PG8_WAIT_L(0); PG8_BAR; PG8_MMA(0, 0, At, B0); PG8_MMA(0, 1, At, B1); PG8_BAR; PG8_SCHED;
            PG8_LDA(At, 0, 1); PG8_STAGE(PG8_SB(0, 0), b2, voffB); PG8_STAGE(PG8_SB(0, 1), b2 + hstep, voffB); PG8_STAGE(PG8_SA(0, 0), a2, voffA);
            PG8_WAIT_V(8); PG8_WAIT_L(0); PG8_BAR; PG8_MMA(1, 0, At, B0); PG8_MMA(1, 1, At, B1); PG8_BAR; PG8_SCHED;
            PG8_LDB(B0, 1, 0); PG8_LDB(B1, 1, 1); PG8_SCHED; PG8_LDA(At, 1, 0); PG8_STAGE(PG8_SA(0, 1), a2 + hstep, voffA);
            PG8_WAIT_V(8); PG8_WAIT_L(0); PG8_BAR; PG8_MMA(0, 0, At, B0); PG8_MMA(0, 1, At, B1); PG8_BAR; PG8_SCHED;
            PG8_LDA(At, 1, 1); PG8_STAGE(PG8_SB(1, 0), b3, voffB); PG8_STAGE(PG8_SB(1, 1), b3 + hstep, voffB); PG8_STAGE(PG8_SA(1, 0), a3, voffA);
            PG8_WAIT_V(8); PG8_WAIT_L(0); PG8_BAR; PG8_MMA(1, 0, At, B0); PG8_MMA(1, 1, At, B1); PG8_BAR; PG8_SCHED;
            } else {
            PG8_LDB(B0, 0, 0); PG8_SCHED; PG8_LDA(At, 0, 0); PG8_STAGE(PG8_SA(1, 1), a1 + hstep, voffA);
            PG8_WAIT_L(8); PG8_BAR; PG8_WAIT_L(0); PG8_MMA(0, 0, At, B0); PG8_BAR; PG8_SCHED;
            PG8_LDB(B1, 0, 1); PG8_STAGE(PG8_SB(0, 0), b2, voffB);
            PG8_BAR; PG8_WAIT_L(0); PG8_MMA(0, 1, At, B1); PG8_BAR;
            PG8_LDA(At, 0, 1); PG8_STAGE(PG8_SA(0, 0), a2, voffA);
            PG8_BAR; PG8_WAIT_L(0); PG8_MMA(1, 0, At, B0); PG8_BAR; PG8_SCHED;
            PG8_STAGE(PG8_SB(0, 1), b2 + hstep, voffB);
            PG8_WAIT_V(6); PG8_BAR; PG8_MMA(1, 1, At, B1); PG8_BAR;
            PG8_LDB(B0, 1, 0); PG8_SCHED; PG8_LDA(At, 1, 0); PG8_STAGE(PG8_SA(0, 1), a2 + hstep, voffA);
            PG8_WAIT_L(8); PG8_BAR; PG8_WAIT_L(0); PG8_MMA(0, 0, At, B0); PG8_BAR; PG8_SCHED;
            PG8_LDB(B1, 1, 1); PG8_STAGE(PG8_SB(1, 0), b3, voffB);
            PG8_BAR; PG8_WAIT_L(0); PG8_MMA(0, 1, At, B1); PG8_BAR;
            PG8_LDA(At, 1, 1); PG8_STAGE(PG8_SA(1, 0), a3, voffA);
            PG8_BAR; PG8_WAIT_L(0); PG8_MMA(1, 0, At, B0); PG8_BAR; PG8_SCHED;
            PG8_STAGE(PG8_SB(1, 1), b3 + hstep, voffB);
            PG8_WAIT_V(6); PG8_BAR; PG8_MMA(1, 1, At, B1); PG8_BAR;
            }
        }
        if constexpr (ALIGN_EPI) { if (wr == 0) PG8_BAR; }
        if constexpr (!Epi::AFTER_DRAIN) { E(acc, cur, wr, wc, fr, fq); S.done(cur); }
        if (!has_next) break;
#pragma unroll
        for (int a = 0; a < 2; ++a)
#pragma unroll
            for (int b = 0; b < 2; ++b)
#pragma unroll
                for (int m = 0; m < 4; ++m)
#pragma unroll
                    for (int n = 0; n < 2; ++n) acc[a][b][m][n] = (f32x4){0.f, 0.f, 0.f, 0.f};
        cur = nxt; cA = nA; cB = nB; ++ui;
        if constexpr (ALIGN_EPI) { if (wr == 1) PG8_BAR; }
    }
    PG8_WAIT_V(0);
    if constexpr (!ALIGN_EPI) { if (wr == 0) PG8_BAR; }
    PG8_BAR;
    if constexpr (Epi::AFTER_DRAIN) { E.fused(acc, cur, wr, wc, fr, fq, lds, wid, lane); S.done(cur); }
#undef PG8_SA
#undef PG8_SB
#undef PG8_STAGE
#undef PG8_LDA
#undef PG8_LDB
#undef PG8_MMA
#undef PG8_WAIT_V
#undef PG8_WAIT_L
#undef PG8_BAR
#undef PG8_SCHED
}

struct EpiRelu2 {
    static constexpr bool PERM = true, AFTER_DRAIN = false;
    bf16_t* O; int ldc;
    __device__ __forceinline__ void operator()(const f32x4 (&acc)[2][2][4][2], const Unit& u, int wr, int wc, int fr, int fq) const {
#pragma unroll
        for (int ai = 0; ai < 2; ++ai)
#pragma unroll
            for (int m = 0; m < 4; ++m) {
                bf16_t* rowp = O + (size_t)(u.pm * BM + ai * HALF + wr * 64 + m * 16 + fr) * ldc + u.pn * BM + wc * 32 + 8 * fq;
#pragma unroll
                for (int bj = 0; bj < 2; ++bj) {
                    f32x4 v0 = acc[ai][bj][m][0], v1 = acc[ai][bj][m][1];
#pragma unroll
                    for (int r = 0; r < 4; ++r) { const float a = fmaxf(v0[r], 0.f); v0[r] = a * a; const float c = fmaxf(v1[r], 0.f); v1[r] = c * c; }
                    u32x4 w = {::pk2(v0[0], v0[1]), ::pk2(v0[2], v0[3]), ::pk2(v1[0], v1[1]), ::pk2(v1[2], v1[3])};
                    *(u32x4*)(rowp + bj * HALF) = w;
                }
            }
    }
};
struct EpiGatedRes {
    static constexpr bool PERM = true, AFTER_DRAIN = false;
    const float* base; float* out; const float* gate; int gate_bstride; int ldc;
    __device__ __forceinline__ void operator()(const f32x4 (&acc)[2][2][4][2], const Unit& u, int wr, int wc, int fr, int fq) const {
        const float* g = gate + ((u.pm * BM) >> 13) * gate_bstride;
        const int col0 = u.pn * BM + wc * 32 + 8 * fq;
        f32x4 gv[2][2];
#pragma unroll
        for (int bj = 0; bj < 2; ++bj)
#pragma unroll
            for (int n = 0; n < 2; ++n) gv[bj][n] = *(const f32x4*)(g + col0 + bj * HALF + n * 4);
#pragma unroll
        for (int ai = 0; ai < 2; ++ai)
#pragma unroll
            for (int m = 0; m < 4; ++m) {
                const size_t off = (size_t)(u.pm * BM + ai * HALF + wr * 64 + m * 16 + fr) * ldc + col0;
#pragma unroll
                for (int bj = 0; bj < 2; ++bj)
#pragma unroll
                    for (int n = 0; n < 2; ++n) {
                        const f32x4 xv = *(const f32x4*)(base + off + bj * HALF + n * 4);
                        *(f32x4*)(out + off + bj * HALF + n * 4) = xv + gv[bj][n] * acc[ai][bj][m][n];
                    }
            }
    }
};
struct EpiInProj {
    static constexpr bool PERM = true, AFTER_DRAIN = false;
    bf16_t* MIX; bf16_t* Kb; bf16_t* Vt; bf16_t* DQ; float* GT; const float* a_log; const float* dt_bias;
    __device__ __forceinline__ void operator()(const f32x4 (&acc)[2][2][4][2], const Unit& u, int wr, int wc, int fr, int fq) const {
        const int pn = u.pn; const bool lat = u.pm < 64;
#pragma unroll
        for (int ai = 0; ai < 2; ++ai)
#pragma unroll
            for (int m = 0; m < 4; ++m) {
                const int gr = u.pm * BM + ai * HALF + wr * 64 + m * 16 + fr;
                int bb, kvpos;
                if (lat) { bb = gr >> 13; kvpos = 256 + (gr & 8191); } else { const int cr = gr - 16384; bb = cr >> 8; kvpos = cr & 255; }
#pragma unroll
                for (int bj = 0; bj < 2; ++bj) {
                    const int cl = bj * HALF + wc * 32 + 8 * fq;
                    const f32x4 v0 = acc[ai][bj][m][0], v1 = acc[ai][bj][m][1];
                    const u32x4 w = {::pk2(v0[0], v0[1]), ::pk2(v0[2], v0[3]), ::pk2(v1[0], v1[1]), ::pk2(v1[2], v1[3])};
                    if (pn < 2) { if (lat) *(u32x4*)(MIX + (size_t)gr * 1024 + pn * 256 + cl) = w; }
                    else if (pn == 2) {
                        if (bj == 0) { const int kvh = cl >> 6, d = cl & 63; *(u32x4*)(Kb + ((size_t)(bb * 2 + kvh) * 8448 + kvpos) * 64 + d) = w; }
                        else { const int c2 = cl - HALF, kvh = c2 >> 6, d = c2 & 63; bf16_t* vp = Vt + ((size_t)(bb * 2 + kvh) * 64 + d) * 8448 + kvpos;
#pragma unroll
                            for (int e = 0; e < 4; ++e) { vp[(2 * e) * 8448] = (bf16_t)(w[e] & 0xffffu); vp[(2 * e + 1) * 8448] = (bf16_t)(w[e] >> 16); } }
                    }
                    else if (pn < 9) *(u32x4*)(DQ + (size_t)gr * 1536 + (pn - 3) * 256 + cl) = w;
                    else { if (lat) *(u32x4*)(MIX + (size_t)gr * 1024 + 512 + (pn - 9) * 256 + cl) = w; }
                }
            }
    }
};
}

#define XB_TMO      128
#define XB_XCNT(j)  (256  + 64 * (j))
#define XB_XSUB(j)  (1280 + 64 * (j))
#define XB_XGEN(j)  (2304 + 64 * (j))
#define XB_TOP      3328
#define XB_TOPGEN   3392
#define XCD_BAR_WORDS 3456
#define XB_SPIN_CAP (1u << 22)
#define LAS __attribute__((address_space(3)))
DI unsigned xb_ld(unsigned* p)              { return __hip_atomic_load(p, __ATOMIC_RELAXED, __HIP_MEMORY_SCOPE_AGENT); }
DI unsigned xb_add(unsigned* p, unsigned v) { return __hip_atomic_fetch_add(p, v, __ATOMIC_RELAXED, __HIP_MEMORY_SCOPE_AGENT); }
DI unsigned xb_xcc_id() { return (unsigned)__builtin_amdgcn_s_getreg((3 << 11) | 20) & 0xFu; }
#define XB_SPIN(cond, bar) do { unsigned _sp = 0; while (cond) { __builtin_amdgcn_s_sleep(1); \
    if ((++_sp & 255u) == 0u) { if (xb_ld(&(bar)[XB_TMO])) break; if (_sp > XB_SPIN_CAP) { atomicAdd(&(bar)[XB_TMO], 1u); break; } } } } while (0)
struct XcdBarrier { unsigned* bar; unsigned x; volatile LAS unsigned* st; };
DI XcdBarrier xcd_barrier_post(unsigned* bar, volatile LAS unsigned* st) {
    XcdBarrier b; b.bar = bar; b.x = xb_xcc_id(); b.st = st;
    if (threadIdx.x == 0) (void)xb_add(&bar[XB_XCNT(b.x)], 1u);
    return b;
}
DI void xcd_barrier_complete(unsigned* bar, unsigned x, unsigned& nloc, unsigned& nx) {
    const unsigned G = gridDim.x * gridDim.y * gridDim.z;
    unsigned sum, cnt, mine, sp = 0u;
    for (;;) {
        sum = 0u; cnt = 0u; mine = 0u;
#pragma unroll
        for (unsigned j = 0; j < 16; ++j) { const unsigned c = xb_ld(&bar[XB_XCNT(j)]); sum += c; cnt += (c > 0u) ? 1u : 0u; mine = (j == x) ? c : mine; }
        if (sum == G) break;
        __builtin_amdgcn_s_sleep(1);
        if ((++sp & 255u) == 0u) { if (xb_ld(&bar[XB_TMO])) break; if (sp > XB_SPIN_CAP) { atomicAdd(&bar[XB_TMO], 1u); break; } }
    }
    nloc = mine > 0u ? mine : 1u; nx = cnt > 0u ? cnt : 1u;
}
DI void xcd_barrier(const XcdBarrier& b) {
    asm volatile("s_waitcnt vmcnt(0)" ::: "memory");
    __syncthreads();
    if (threadIdx.x == 0) {
        unsigned* bar = b.bar;
        __builtin_amdgcn_s_waitcnt(0);
        unsigned nloc = b.st[0], nx = b.st[1];
        if (nloc == 0u) { xcd_barrier_complete(bar, b.x, nloc, nx); b.st[0] = nloc; b.st[1] = nx; }
        const unsigned old = xb_add(&bar[XB_XSUB(b.x)], 1u);
        const unsigned gen = old / nloc;
        if (old + 1u == (gen + 1u) * nloc) {
            __builtin_amdgcn_fence(__ATOMIC_RELEASE, "agent");
            asm volatile("s_waitcnt vmcnt(0)" ::: "memory");
            const unsigned og = xb_add(&bar[XB_TOP], 1u);
            const unsigned tg = og / nx;
            if (og + 1u == (tg + 1u) * nx) xb_add(&bar[XB_TOPGEN], 1u);
            else XB_SPIN(xb_ld(&bar[XB_TOPGEN]) == tg, bar);
            __builtin_amdgcn_fence(__ATOMIC_ACQUIRE, "agent");
            xb_add(&bar[XB_XGEN(b.x)], 1u);
            asm volatile("s_waitcnt vmcnt(0)" ::: "memory");
        } else {
            XB_SPIN(xb_ld(&bar[XB_XGEN(b.x)]) == gen, bar);
            __builtin_amdgcn_fence(__ATOMIC_ACQUIRE, "agent");
            asm volatile("s_waitcnt vmcnt(0)" ::: "memory");
        }
    }
    __syncthreads();
}

__global__ void __launch_bounds__(512, 2) mega(Params p) {
    extern __shared__ __attribute__((aligned(16))) unsigned char lds_raw[];
    const int half = __builtin_amdgcn_readfirstlane(threadIdx.x >> 8);
    const int tid = threadIdx.x & 255, lane = tid & 63, wid = tid >> 6;
    const int nblk = gridDim.x * 2, bid = blockIdx.x * 2 + half;
    auto lwid = [&]() { int w_ = (int)((threadIdx.x & 255) >> 6); asm volatile("" : "+v"(w_)); return w_; };
    unsigned char* const lds_base = lds_raw; unsigned char* const lds = lds_raw + half * 73728;
    unsigned char* ws = p.ws;
    const int lo = p.ph_lo, hi = p.ph_hi;
#ifndef PH_MASK
#define PH_MASK 0x3ff
#endif
#define IN_PH(k) ((((PH_MASK) >> (k)) & 1) && lo <= (k) && (k) <= hi)
#define SEAM(k) do { if ((k) < hi) { xcd_barrier(xb); } } while (0)
    if (threadIdx.x < 4) ((volatile LAS unsigned*)(lds_base + 147456))[threadIdx.x] = 0u;
    __syncthreads();
    XcdBarrier xb = xcd_barrier_post((unsigned*)(ws + OFF_BAR), (volatile LAS unsigned*)(lds_base + 147456));
    if (hi > 1000) cg::this_grid().sync();
    float* MOD = (float*)(ws + OFF_MODZ);
    int* CNT = (int*)(ws + OFF_MISC);

    if (IN_PH(0)) {
        constexpr int T_MOD = 96 * 4;
        for (int t = bid; t < T_MOD + 2; t += nblk) {
            if (t < T_MOD) {
                const int j = t >> 2, kq = t & 3; float* sv = (float*)lds; float* red = sv + 768;
                __syncthreads();
                for (int i = tid; i < 768; i += 256) { const int which = i >> 8, k = kq * 256 + (i & 255); const float cv = which < 2 ? p.c[which * 1024 + k] : p.c_ctx[k]; sv[i] = silu_f(cv); }
                __syncthreads();
                const int col = j * 64 + lane; float a0 = 0.f, a1 = 0.f, a2 = 0.f;
#pragma unroll 8
                for (int k = 64 * wid; k < 64 * wid + 64; ++k) { const float wv = p.w_mod[(size_t)(kq * 256 + k) * 6144 + col]; a0 += sv[k] * wv; a1 += sv[256 + k] * wv; a2 += sv[512 + k] * wv; }
                red[(wid * 3 + 0) * 64 + lane] = a0; red[(wid * 3 + 1) * 64 + lane] = a1; red[(wid * 3 + 2) * 64 + lane] = a2;
                __syncthreads();
                if (tid < 192) { const int which = tid >> 6, cl = tid & 63; float sacc = kq == 0 ? p.b_mod[j * 64 + cl] : 0.f; for (int w = 0; w < 4; ++w) sacc += red[(w * 3 + which) * 64 + cl]; atomicAdd(&MOD[which * 6144 + j * 64 + cl], sacc); }
            } else if (t == T_MOD) {
                f2_t* RT = (f2_t*)(ws + OFF_ROPE);
                for (int i = tid; i < 2048; i += 256) {
                    const int pos = i >> 4, j = i & 15;
                    const float inv = exp2f(-(float)j * 0.8304820237218406f);
                    const float ang = (float)pos * inv;
                    const float n = rintf(ang * 0.15915494309189535f);
                    float r = fmaf(-n, 6.28125f, ang); r = fmaf(-n, 1.9353071795864769e-3f, r);
                    RT[i] = (f2_t){cosf(r), sinf(r)};
                }
            } else { if (tid == 0) CNT[0] = 0; }
        }
        for (int t = bid; t < 16 * (INP / 64); t += nblk) wconv_tile(p.w_in, DM, INC, INP, (u16*)(ws + OFF_WIN), t, (float*)lds);
        SEAM(0);
    }
    if (IN_PH(1)) {
        u16* H = (u16*)(ws + OFF_H);
        norm_rows([&](int r) { return r < NLAT ? p.x + (size_t)r * DM : p.ctx + (size_t)(r - NLAT) * DM; }, NROW, bid * 4 + lwid(), nblk * 4, p.norm1_w, MOD, 0, 1, H, lane);
        SEAM(1);
    }
    if (IN_PH(2)) {
        pg8::Gemm g{(const u16*)(ws + OFF_H), (const u16*)(ws + OFF_WIN), NROW, 2816, DM}; pg8::StaticOrder S; S.init(NROW, 2816, (int)gridDim.x, (int)blockIdx.x);
        pg8::EpiInProj E{(u16*)(ws + OFF_MIX), (u16*)(ws + OFF_K), (u16*)(ws + OFF_VT), (u16*)(ws + OFF_DQKV), (float*)(ws + OFF_GATE), p.a_log, p.dt_bias};
        pg8::gemm_phase<pg8::EpiInProj, pg8::StaticOrder, true, true>((PG8_LAS unsigned char*)lds_base, g, S, E);
        {
            const u16* H = (const u16*)(ws + OFF_H); const u16* Wg = (const u16*)(ws + OFF_WIN) + (size_t)2816 * DM; float* GT = (float*)(ws + OFF_GATE);
            const int l15 = lane & 15, quad = lane >> 4;
            for (int rb = (int)blockIdx.x * 8 + (int)(threadIdx.x >> 6); rb < NROW / 16; rb += (int)gridDim.x * 8) {
                f32x4 acc = {0.f, 0.f, 0.f, 0.f};
                const u16* ap = H + (size_t)(rb * 16 + l15) * DM + 8 * quad; const u16* bp = Wg + (size_t)l15 * DM + 8 * quad;
#pragma unroll 8
                for (int ks = 0; ks < 32; ++ks) acc = MFMA16(*(const bf16x8*)(ap + 32 * ks), *(const bf16x8*)(bp + 32 * ks), acc);
                const int ci = l15;
#pragma unroll
                for (int r = 0; r < 4; ++r) {
                    const float x = acc[r]; float o;
                    if (ci < 8) o = 1.f / (1.f + __expf(-x));
                    else { const float xx = x + p.dt_bias[ci - 8]; const float sp = xx > 20.f ? xx : log1pf(__expf(xx)); o = -__expf(p.a_log[ci - 8]) * sp; }
                    GT[(size_t)(rb * 16 + 4 * quad + r) * 16 + ci] = o;
                }
            }
        }
        SEAM(2);
    }
    if (IN_PH(3)) {
        if (bid < 32) { gdn_prep_unit(p, ((bid >> 4) * NCK + ((bid >> 2) & 3)) * 4 + (bid & 3), lds); } else {
        {
            u16* MIX = (u16*)(ws + OFF_MIX); u16* Kb = (u16*)(ws + OFF_K); const f2_t* RT = (const f2_t*)(ws + OFF_ROPE);
            const int l8 = lane & 7, sub = lane >> 3;
            for (int it = (bid - 32) * 4 + wid; it < NLAT + (NB * 2 * SKV) / 8; it += (nblk - 32) * 4) {
                u16* ptr; int t; bool rope; const float* nw; float scale;
                if (it < NLAT) { ptr = MIX + (size_t)it * DM + sub * 64 + l8 * 8; t = it & (SEQ - 1); rope = true; nw = p.q_norm_w; scale = QSCALE; }
                else { const int j = (it - NLAT) * 8 + sub, bk = j / SKV, pos = j - bk * SKV; ptr = Kb + ((size_t)bk * SKV + pos) * 64 + l8 * 8; rope = pos >= CTXL; t = pos >= CTXL ? pos - CTXL : 0; nw = p.k_norm_w; scale = 1.f; }
                const u32x4 raw = *(const u32x4*)ptr;
                float y[8];
#pragma unroll
                for (int e = 0; e < 4; ++e) { y[2 * e] = bflo(raw[e]); y[2 * e + 1] = bfhi(raw[e]); }
                float ss = 0.f;
#pragma unroll
                for (int e = 0; e < 8; ++e) ss += y[e] * y[e];
                ss += __shfl_xor(ss, 1); ss += __shfl_xor(ss, 2); ss += __shfl_xor(ss, 4);
                const float rinv = rsqrtf(ss * (1.f / 64.f) + EPS);
                const f32x4 wa = *(const f32x4*)(nw + 8 * l8), wb = *(const f32x4*)(nw + 8 * l8 + 4);
                const int ppos = (l8 & 4) ? (t & 63) : (t >> 6); const float sgn = (l8 & 2) ? 1.f : -1.f;
#pragma unroll
                for (int e = 0; e < 8; ++e) {
                    const float v = y[e] * rinv * (e < 4 ? wa[e] : wb[e - 4]);
                    const float pv = __shfl_xor(v, 2);
                    const f2_t cs = RT[ppos * 16 + 8 * (l8 & 1) + e];
                    const float vr = v * cs.x + sgn * pv * cs.y;
                    y[e] = (rope ? vr : v) * scale;
                }
                const u32x4 w = {pk2(y[0], y[1]), pk2(y[2], y[3]), pk2(y[4], y[5]), pk2(y[6], y[7])};
                *(u32x4*)ptr = w;
            }
        }
        constexpr int T_WO = 16 * 16, T_W1 = 16 * 64, T_W2 = 64 * 16;
        for (int t = bid - 32; t < T_WO + T_W1 + T_W2; t += nblk - 32) {
            if (t < T_WO) wconv_tile(p.w_out, DM, DM, DM, (u16*)(ws + OFF_WOUT), t, (float*)lds);
            else if (t < T_WO + T_W1) wconv_tile(p.w_mlp1, DM, DFF, DFF, (u16*)(ws + OFF_WM1), t - T_WO, (float*)lds);
            else wconv_tile(p.w_mlp2, DFF, DM, DM, (u16*)(ws + OFF_WM2), t - T_WO - T_W1, (float*)lds);
        }
        }
        for (int j = bid; j < 1024; j += nblk) gdn_prep_unit(p, ((j >> 9) * NCK + 4 + ((j & 511) >> 2)) * 4 + (j & 3), lds);
        SEAM(3);
    }
    if (IN_PH(4)) {
        if (blockIdx.x < 32) {
            gdn_scan_block(p, (int)blockIdx.x, lds_base, lds_base + 73728, half);
        }
        float Mb;
        { const float a = wave_max(fabsf(p.q_norm_w[lane])), bq = wave_max(fabsf(p.k_norm_w[lane])); Mb = 8.f * a * bq * 1.4426950408889634f; }
        int* su = (int*)(lds_base + 147456 + 8);
        __syncthreads();
        if (threadIdx.x == 0) *su = atomicAdd(CNT, 2);
        __syncthreads();
        int u0 = *su;
        while (u0 < 2048) {
            int nxt = 0;
            if (threadIdx.x == 0) nxt = atomicAdd(CNT, 2);
            if (Mb > 64.f) attn_unit<true>(p, u0 >> 1, half, lds_base, Mb); else attn_unit<false>(p, u0 >> 1, half, lds_base, Mb);
            if (threadIdx.x == 0) *su = nxt;
            __syncthreads();
            u0 = *su;
        }
        SEAM(4);
    }
    if (IN_PH(5)) {
        const u16* O0 = (const u16*)(ws + OFF_O01); const u16* O1 = O0 + (size_t)NLAT * 512; u16* MIX = (u16*)(ws + OFF_MIX);
        const int e0 = (8 * lane) & 127;
        const f32x4 nwa = *(const f32x4*)(p.dn_norm_w + e0), nwb = *(const f32x4*)(p.dn_norm_w + e0 + 4);
        {
            const u16* PP = (const u16*)p.out; const float* LL = (const float*)(ws + OFF_LP);
            for (int r = bid * 4 + lwid(); r < NLAT; r += nblk * 4) {
                const size_t off = (size_t)r * 512 + 8 * lane;
                float acc[8] = {0.f, 0.f, 0.f, 0.f, 0.f, 0.f, 0.f, 0.f}; float lsum = 0.f;
#pragma unroll
                for (int q = 0; q < 4; ++q) {
                    const u32x4 a = *(const u32x4*)(PP + (size_t)q * NLAT * 512 + off);
                    lsum += LL[(size_t)q * NLAT * 8 + (size_t)r * 8 + (lane >> 3)];
#pragma unroll
                    for (int i = 0; i < 4; ++i) { acc[2 * i] += bflo(a[i]); acc[2 * i + 1] += bfhi(a[i]); }
                }
                const float inv = 1.f / lsum;
                u32x4 w = {pk2(acc[0] * inv, acc[1] * inv), pk2(acc[2] * inv, acc[3] * inv), pk2(acc[4] * inv, acc[5] * inv), pk2(acc[6] * inv, acc[7] * inv)};
                *(u32x4*)(MIX + (size_t)r * DM + 8 * lane) = w;
            }
        }
        int r = bid * 4 + lwid(); const int rs = nblk * 4;
        u32x4 na = {0u, 0u, 0u, 0u}, nc = na, nz = na;
        if (r < NLAT) { na = *(const u32x4*)(O0 + (size_t)r * 512 + 8 * lane); nc = *(const u32x4*)(O1 + (size_t)r * 512 + 8 * lane); nz = *(const u32x4*)(MIX + (size_t)r * DM + 512 + 8 * lane); }
        for (; r < NLAT; r += rs) {
            const u32x4 a = na, c = nc, z = nz;
            if (r + rs < NLAT) { const int r2 = r + rs; na = *(const u32x4*)(O0 + (size_t)r2 * 512 + 8 * lane); nc = *(const u32x4*)(O1 + (size_t)r2 * 512 + 8 * lane); nz = *(const u32x4*)(MIX + (size_t)r2 * DM + 512 + 8 * lane); }
            float o[8], zz[8];
#pragma unroll
            for (int i = 0; i < 4; ++i) { o[2 * i] = bflo(a[i]) + bflo(c[i]); o[2 * i + 1] = bfhi(a[i]) + bfhi(c[i]); zz[2 * i] = bflo(z[i]); zz[2 * i + 1] = bfhi(z[i]); }
            float ss = 0.f;
#pragma unroll
            for (int i = 0; i < 8; ++i) ss += o[i] * o[i];
            ss += __shfl_xor(ss, 1); ss += __shfl_xor(ss, 2); ss += __shfl_xor(ss, 4); ss += __shfl_xor(ss, 8);
            const float rinv = rsqrtf(ss * (1.f / 128.f) + EPS);
            float y[8];
#pragma unroll
            for (int i = 0; i < 8; ++i) y[i] = o[i] * rinv * (i < 4 ? nwa[i] : nwb[i - 4]) * silu_f(zz[i]);
            u32x4 w = {pk2(y[0], y[1]), pk2(y[2], y[3]), pk2(y[4], y[5]), pk2(y[6], y[7])};
            *(u32x4*)(MIX + (size_t)r * DM + 512 + 8 * lane) = w;
        }
        SEAM(5);
    }
    if (IN_PH(6)) {
        pg8::Gemm g{(const u16*)(ws + OFF_MIX), (const u16*)(ws + OFF_WOUT), NLAT, DM, DM}; pg8::StaticOrder S; S.init(NLAT, DM, (int)gridDim.x, (int)blockIdx.x);
        pg8::EpiGatedRes E{p.x, p.out, MOD + 2 * 1024, 6144, DM};
        pg8::gemm_phase<pg8::EpiGatedRes, pg8::StaticOrder, true, true>((PG8_LAS unsigned char*)lds_base, g, S, E);
        SEAM(6);
    }
    if (IN_PH(7)) {
        u16* H2 = (u16*)(ws + OFF_H2);
        norm_rows([&](int r) { return (const float*)p.out + (size_t)r * DM; }, NLAT, bid * 4 + lwid(), nblk * 4, p.norm2_w, MOD, 3, 4, H2, lane);
        SEAM(7);
    }
    if (IN_PH(8)) {
        pg8::Gemm g{(const u16*)(ws + OFF_H2), (const u16*)(ws + OFF_WM1), NLAT, DFF, DM}; pg8::StaticOrder S; S.init(NLAT, DFF, (int)gridDim.x, (int)blockIdx.x);
        pg8::EpiRelu2 E{(u16*)(ws + OFF_HID), DFF};
        pg8::gemm_phase<pg8::EpiRelu2, pg8::StaticOrder, true, true>((PG8_LAS unsigned char*)lds_base, g, S, E);
        SEAM(8);
    }
    if (IN_PH(9)) {
        pg8::Gemm g{(const u16*)(ws + OFF_HID), (const u16*)(ws + OFF_WM2), NLAT, DM, DFF}; pg8::StaticOrder S; S.init(NLAT, DM, (int)gridDim.x, (int)blockIdx.x);
        pg8::EpiGatedRes E{p.out, p.out, MOD + 5 * 1024, 6144, DM};
        pg8::gemm_phase<pg8::EpiGatedRes, pg8::StaticOrder, true, true>((PG8_LAS unsigned char*)lds_base, g, S, E);
    }
}

extern "C" void kernel_launch(void* const* d_in, const int* in_sizes, int n_in, void* d_out, int out_size, void* d_ws, size_t ws_size, hipStream_t stream) {
    static int grid = 0;
    if (grid == 0) {
        if (ws_size < WS_NEED) { fprintf(stderr, "kernel_launch: workspace too small (%zu < %zu)\n", ws_size, (size_t)WS_END); grid = -1; return; }
        int dev = 0, cus = 0, per_cu = 0;
        hipGetDevice(&dev);
        hipDeviceGetAttribute(&cus, hipDeviceAttributeMultiprocessorCount, dev);
        hipFuncSetAttribute((const void*)mega, hipFuncAttributeMaxDynamicSharedMemorySize, LDS_BYTES);
        hipOccupancyMaxActiveBlocksPerMultiprocessor(&per_cu, (const void*)mega, 512, LDS_BYTES);
        if (per_cu < 1) per_cu = 1;
        if (per_cu > 1) per_cu = 1;
        grid = cus * per_cu;
        fprintf(stderr, "kernel_launch: cus %d per_cu %d grid %d ws %zu need %zu\n", cus, per_cu, grid, ws_size, (size_t)WS_END);
    }
    if (grid < 0) return;
    if (hipMemsetAsync((unsigned char*)d_ws + OFF_BAR, 0, ZERO_BYTES, stream) != hipSuccess) { fprintf(stderr, "kernel_launch: memset of barrier words failed\n"); return; }
    Params p{};
    const float** pp = (const float**)&p;
    for (int i = 0; i < 18; ++i) pp[i] = (const float*)d_in[i];
    p.out = (float*)d_out; p.ws = (unsigned char*)d_ws;
#if ONE_LAUNCH
    p.ph_lo = 0; p.ph_hi = 9;
    void* args[] = {&p};
    hipError_t e = hipLaunchCooperativeKernel((const void*)mega, dim3(grid), dim3(512), args, LDS_BYTES, stream);
    if (e != hipSuccess) fprintf(stderr, "cooperative launch failed: %s (grid %d)\n", hipGetErrorString(e), grid);
#else
#ifndef DUP_PH
#define DUP_PH -1
#endif
    for (int ph = 0; ph <= 9; ++ph) {
        p.ph_lo = ph; p.ph_hi = ph;
        hipLaunchKernelGGL(mega, dim3(grid), dim3(512), LDS_BYTES, stream, p);
        if (ph == DUP_PH) hipLaunchKernelGGL(mega, dim3(grid), dim3(512), LDS_BYTES, stream, p);
    }
#endif
}
```
